# Optimizing an MI355X kernel written in HIP

```python
import math
import jax, jax.numpy as jnp
from jax import lax
import numpy as np

D_MODEL = 1024
BATCH = 8
SEQ = 4096
DEPTH = 1
DEC_BATCH = 4
DEC_SEQ = 8192
PAST_LEN = 128

D_HYENA = D_MODEL // 2
D_HGRN = D_MODEL // 2
HGRN_DK = 128
HGRN_HEADS = D_HGRN // HGRN_DK
HGRN_DV = D_HGRN // HGRN_HEADS
CHUNK = 64
D_FF = 4 * D_MODEL
SHORT_CONV = 3
FILTER_EMB = 33
FILTER_BANDS = (FILTER_EMB - 1) // 2
FILTER_HIDDEN = 64
DECAY_TARGET = 1e-2
FAST_DECAY_PCT = 0.3
SLOW_DECAY_PCT = 1.5
EPS = 1e-6
D_IN = 3 * D_HYENA + 5 * D_HGRN + 2 * D_MODEL

kernel_name = 'hyena_hgrn2_gated_merge_encoder'


def rmsnorm(x, g):
    xf = x.astype(jnp.float32)
    y = xf * lax.rsqrt(jnp.mean(xf * xf, axis=-1, keepdims=True) + EPS)
    return (y * g.astype(jnp.float32)).astype(x.dtype)


def adaln(h, shift, scale):
    return h * (1 + scale[:, None, :]) + shift[:, None, :]


def short_conv3(u, w, b):
    up = jnp.pad(u, ((0, 0), (1, 1), (0, 0)))
    return up[:, :-2] * w[0] + up[:, 1:-1] * w[1] + up[:, 2:] * w[2] + b


def hyena_filters(L, w1, b1, w2, b2, w3, b3, wo, freq):
    f32 = jnp.float32
    t = jnp.linspace(0.0, 1.0, L, dtype=f32)[:, None]
    w = 2 * math.pi * jnp.arange(L, dtype=f32)[:, None] / L
    fb = jnp.linspace(1e-4, FILTER_BANDS - 1, FILTER_BANDS, dtype=f32)[None, :]
    z = jnp.concatenate([t, jnp.cos(fb * w), -jnp.sin(fb * w)], axis=-1)
    freq = freq.astype(f32)
    h = jnp.sin(freq[0] * (z @ w1.astype(f32) + b1.astype(f32)))
    h = jnp.sin(freq[1] * (h @ w2.astype(f32) + b2.astype(f32)))
    h = jnp.sin(freq[2] * (h @ w3.astype(f32) + b3.astype(f32)))
    h = h @ wo.astype(f32)
    max_decay = math.log(DECAY_TARGET) / FAST_DECAY_PCT
    min_decay = math.log(DECAY_TARGET) / SLOW_DECAY_PCT
    deltas = jnp.abs(jnp.linspace(min_decay, max_decay, D_HYENA, dtype=f32))[None, :]
    window = jnp.exp(-t * deltas)
    h_f = h[:, :D_HYENA] * window
    h_b = h[:, D_HYENA:] * window
    norm = jnp.sum(jnp.abs(h_f), axis=0) + jnp.sum(jnp.abs(h_b[1:]), axis=0) + EPS
    return h_f / norm, h_b / norm


def bidir_long_conv(v, h_f, h_b):
    L = v.shape[1]
    k = jnp.concatenate([h_f, jnp.zeros((1, h_f.shape[1]), h_f.dtype), h_b[1:][::-1]], axis=0)
    v_f = jnp.fft.rfft(v, n=2 * L, axis=1)
    k_f = jnp.fft.rfft(k, n=2 * L, axis=0)
    return jnp.fft.irfft(v_f * k_f[None], n=2 * L, axis=1)[:, :L]


def hyena_branch(u, conv_w, conv_b, w1, b1, w2, b2, w3, b3, wo, freq, fbias):
    f32 = jnp.float32
    u = short_conv3(u, conv_w, conv_b)
    x0, x1, v = jnp.split(u, 3, axis=-1)
    h_f, h_b = hyena_filters(u.shape[1], w1, b1, w2, b2, w3, b3, wo, freq)
    v = (v * x1).astype(f32)
    y = bidir_long_conv(v, h_f, h_b) + v * fbias.astype(f32)
    return (y * x0.astype(f32)).astype(u.dtype)


def chunk_scan(q, k, g, v):
    B, L, H, dk = q.shape
    dv = v.shape[-1]
    N = L // CHUNK

    def to_chunks(a):
        return a.reshape(B, N, CHUNK, H, a.shape[-1]).transpose(1, 0, 3, 2, 4)

    mask = jnp.tril(jnp.ones((CHUNK, CHUNK), dtype=bool))[None, None, :, :, None]

    def step(S, inp):
        q_, k_, g_, v_ = inp
        G = jnp.cumsum(g_, axis=2)
        diff = G[:, :, :, None, :] - G[:, :, None, :, :]
        decay = jnp.exp(jnp.where(mask, diff, -jnp.inf))
        A = jnp.einsum('bhtsk,bhsk->bhts', decay * q_[:, :, :, None, :], k_)
        o = jnp.einsum('bhts,bhsv->bhtv', A, v_) + jnp.einsum('bhtk,bhkv->bhtv', q_ * jnp.exp(G), S)
        G_last = G[:, :, -1:, :]
        S_new = jnp.exp(G_last[:, :, 0, :])[..., None] * S + jnp.einsum(
            'bhsk,bhsv->bhkv', k_ * jnp.exp(G_last - G), v_)
        return S_new, o

    S0 = jnp.zeros((B, H, dk, dv), jnp.float32)
    _, o = lax.scan(step, S0, (to_chunks(q), to_chunks(k), to_chunks(g), to_chunks(v)))
    return o.transpose(1, 0, 3, 2, 4).reshape(B, L, H, dv)


def hgrn2_branch(p, lb_f, lb_b, gnorm_g):
    f32 = jnp.float32
    B, L, _ = p.shape
    q, i, ff, fb, og = jnp.split(p, 5, axis=-1)
    heads = lambda a: a.reshape(B, L, HGRN_HEADS, -1)
    q = heads(jax.nn.silu(q.astype(f32)))
    i = heads(i.astype(f32))

    def gate(fr, lb):
        f = lb + (1 - lb) * jax.nn.sigmoid(fr.astype(f32))
        return heads(1 - f), heads(jnp.log(f))

    k_f, g_f = gate(ff, lb_f)
    k_b, g_b = gate(fb, lb_b)
    flip = lambda a: a[:, ::-1]
    o = chunk_scan(jnp.concatenate([q, flip(q)], axis=2),
                   jnp.concatenate([k_f, flip(k_b)], axis=2),
                   jnp.concatenate([g_f, flip(g_b)], axis=2),
                   jnp.concatenate([i, flip(i)], axis=2))
    o = o[:, :, :HGRN_HEADS] + flip(o[:, :, HGRN_HEADS:])
    o = o * lax.rsqrt(jnp.mean(o * o, axis=-1, keepdims=True) + EPS)
    o = o.reshape(B, L, D_HGRN) * gnorm_g.astype(f32) * jax.nn.silu(og.astype(f32))
    return o.astype(p.dtype)


def encoder(x, c, params):
    (ada_w, ada_b, norm1_g, w_in, conv_w, conv_b, filt_w1, filt_b1, filt_w2, filt_b2,
     filt_w3, filt_b3, filt_wo, filt_freq, filt_bias, hgrn_lb, gnorm_g, w_branch, w_out,
     norm2_g, w_ff1, w_ff2, final_g) = params
    lb_all = jnp.cumsum(jax.nn.softmax(hgrn_lb.astype(jnp.float32), axis=0), axis=0)
    sc = jax.nn.silu(c)
    for l in range(DEPTH):
        mod = sc @ ada_w[l] + ada_b[l]
        sh1, sc1, gt1, sh2, sc2, gt2 = jnp.split(mod, 6, axis=-1)
        h = adaln(rmsnorm(x, norm1_g[l]), sh1, sc1)
        proj = h @ w_in[l]
        p_hy = proj[..., :3 * D_HYENA]
        p_hg = proj[..., 3 * D_HYENA:3 * D_HYENA + 5 * D_HGRN]
        p_gt = proj[..., 3 * D_HYENA + 5 * D_HGRN:]
        y_a = hyena_branch(p_hy, conv_w[l], conv_b[l], filt_w1[l], filt_b1[l], filt_w2[l],
                           filt_b2[l], filt_w3[l], filt_b3[l], filt_wo[l], filt_freq[l], filt_bias[l])
        y_b = hgrn2_branch(p_hg, lb_all[l, 0], lb_all[l, 1], gnorm_g[l])
        g_a, g_b = jnp.split(jax.nn.sigmoid(p_gt), 2, axis=-1)
        m = g_a * (y_a @ w_branch[l][:D_HYENA]) + g_b * (y_b @ w_branch[l][D_HYENA:])
        x = x + gt1[:, None, :] * (m @ w_out[l])
        h2 = adaln(rmsnorm(x, norm2_g[l]), sh2, sc2)
        x = x + gt2[:, None, :] * (jnp.square(jax.nn.relu(h2 @ w_ff1[l])) @ w_ff2[l])
    return rmsnorm(x, final_g)


def setup_inputs(seed: int = 0) -> dict:
    key = jax.random.key(seed)
    ks = list(jax.random.split(key, 32))

    def nrm(shape, scale):
        return jax.random.normal(ks.pop(), shape, jnp.float32) * scale

    D = D_MODEL
    return {
        'x_prompt': nrm((BATCH, SEQ, D), 1.0),
        'x_sample': nrm((DEC_BATCH, DEC_SEQ, D), 1.0),
        'c_prompt': nrm((BATCH, D), 1.0),
        'c_sample': nrm((DEC_BATCH, D), 1.0),
        'ada_w': nrm((DEPTH, D, 6 * D), D ** -0.5),
        'ada_b': nrm((DEPTH, 6 * D), 0.02),
        'norm1_g': 1.0 + nrm((DEPTH, D), 0.02),
        'w_in': nrm((DEPTH, D, D_IN), D ** -0.5),
        'conv_w': nrm((DEPTH, SHORT_CONV, 3 * D_HYENA), SHORT_CONV ** -0.5),
        'conv_b': nrm((DEPTH, 3 * D_HYENA), 0.02),
        'filt_w1': nrm((DEPTH, FILTER_EMB, FILTER_HIDDEN), FILTER_EMB ** -0.5),
        'filt_b1': nrm((DEPTH, FILTER_HIDDEN), 0.02),
        'filt_w2': nrm((DEPTH, FILTER_HIDDEN, FILTER_HIDDEN), FILTER_HIDDEN ** -0.5),
        'filt_b2': nrm((DEPTH, FILTER_HIDDEN), 0.02),
        'filt_w3': nrm((DEPTH, FILTER_HIDDEN, FILTER_HIDDEN), FILTER_HIDDEN ** -0.5),
        'filt_b3': nrm((DEPTH, FILTER_HIDDEN), 0.02),
        'filt_wo': nrm((DEPTH, FILTER_HIDDEN, 2 * D_HYENA), FILTER_HIDDEN ** -0.5),
        'filt_freq': 1.0 + nrm((DEPTH, 3, FILTER_HIDDEN), 0.05),
        'filt_bias': nrm((DEPTH, D_HYENA), 1.0),
        'hgrn_lb': 1.0 + nrm((DEPTH + 1, 2, D_HGRN), 0.1),
        'gnorm_g': 1.0 + nrm((DEPTH, D_HGRN), 0.02),
        'w_branch': nrm((DEPTH, D_HYENA + D_HGRN, D), D_HYENA ** -0.5),
        'w_out': nrm((DEPTH, D, D), D ** -0.5),
        'norm2_g': 1.0 + nrm((DEPTH, D), 0.02),
        'w_ff1': nrm((DEPTH, D, D_FF), D ** -0.5),
        'w_ff2': nrm((DEPTH, D_FF, D), D_FF ** -0.5),
        'final_g': 1.0 + nrm((D,), 0.02),
    }


def reference(x_prompt, x_sample, c_prompt, c_sample, ada_w, ada_b, norm1_g, w_in, conv_w, conv_b,
              filt_w1, filt_b1, filt_w2, filt_b2, filt_w3, filt_b3, filt_wo, filt_freq, filt_bias,
              hgrn_lb, gnorm_g, w_branch, w_out, norm2_g, w_ff1, w_ff2, final_g):
    params = (ada_w, ada_b, norm1_g, w_in, conv_w, conv_b, filt_w1, filt_b1, filt_w2, filt_b2,
              filt_w3, filt_b3, filt_wo, filt_freq, filt_bias, hgrn_lb, gnorm_g, w_branch, w_out,
              norm2_g, w_ff1, w_ff2, final_g)
    y_prompt = encoder(x_prompt, c_prompt, params)
    y_sample = encoder(x_sample, c_sample, params)
    return (y_prompt, y_sample)
```

```cpp
#include <hip/hip_runtime.h>
#include <hip/hip_cooperative_groups.h>
#include <cstdio>
namespace cg = cooperative_groups;

typedef unsigned short u16;
typedef __attribute__((ext_vector_type(8))) short bf16x8;
typedef __attribute__((ext_vector_type(16))) float f32x16;

#define DEV __device__ __forceinline__

constexpr int D = 1024;
constexpr int NTOK = 32768;
constexpr int DIN = 6144;
constexpr float EPSF = 1e-6f;

enum { I_XP = 0, I_XS, I_CP, I_CS, I_ADAW, I_ADAB, I_N1G, I_WIN, I_CONVW, I_CONVB, I_FW1, I_FB1, I_FW2, I_FB2,
       I_FW3, I_FB3, I_FWO, I_FFREQ, I_FBIAS, I_LB, I_GNG, I_WBR, I_WOUT, I_N2G, I_WFF1, I_WFF2, I_FING };

constexpr size_t OFF_WIN = 0;
constexpr size_t OFF_WBR = OFF_WIN + (size_t)6144 * 1024 * 2;
constexpr size_t OFF_WOUT = OFF_WBR + (size_t)1024 * 1024 * 2;
constexpr size_t OFF_WFF1 = OFF_WOUT + (size_t)1024 * 1024 * 2;
constexpr size_t OFF_WFF2 = OFF_WFF1 + (size_t)4096 * 1024 * 2;
constexpr size_t OFF_MOD = OFF_WFF2 + (size_t)4096 * 1024 * 2;
constexpr size_t OFF_CNT = OFF_MOD + (size_t)12 * 6144 * 4;
constexpr size_t OFF_XBAR = OFF_CNT + 256;
constexpr size_t OFF_PART = OFF_XBAR + 16384;
constexpr size_t OFF_KK = OFF_PART + (size_t)768 * 1024 * 4;
constexpr size_t OFF_DEC = OFF_KK + (size_t)512 * (8192 + 16384) * 2;
constexpr size_t OFF_KT = OFF_DEC + (size_t)2 * 512 * 512 * 4;
constexpr size_t OFF_P = OFF_KT + (size_t)512 * 2 * 512 * 64 * 2;
constexpr size_t OFF_UHY = OFF_P;
constexpr size_t OFF_PHG = OFF_UHY + (size_t)NTOK * 1536 * 2;
constexpr size_t OFF_GT = OFF_PHG + (size_t)NTOK * 2560 * 2;
constexpr size_t WS_NEED = OFF_GT + (size_t)NTOK * 2048 * 2;
constexpr size_t OFF_HRAW = OFF_P;
constexpr size_t OFF_ABUF = OFF_UHY;
constexpr size_t OFF_H2 = OFF_GT;

struct Params {
  const float* in[27];
  float* out;
  char* ws;
};

DEV unsigned pack2(float a, float b) {
  unsigned r;
  asm("v_cvt_pk_bf16_f32 %0, %1, %2" : "=v"(r) : "v"(a), "v"(b));
  return r;
}
DEV u16 f2bf(float f) { return (u16)(pack2(f, f) & 0xffffu); }
DEV float bf2f(u16 h) { return __uint_as_float(((unsigned)h) << 16); }
DEV float bflo(unsigned w) { return __uint_as_float(w << 16); }
DEV float bfhi(unsigned w) { return __uint_as_float(w & 0xffff0000u); }
DEV float silu_f(float x) { return x / (1.f + __expf(-x)); }
DEV float sigmoid_f(float x) { return 1.f / (1.f + __expf(-x)); }
DEV int tidx_full() {
  int t = threadIdx.x;
  asm volatile("" : "+v"(t));
  return t;
}
DEV int tidx() { return tidx_full() & 255; }
DEV int vhalf() { return __builtin_amdgcn_readfirstlane((int)(threadIdx.x >> 8)); }
#define VBID ((int)blockIdx.x * 2 + vhalf())
#define NVB ((int)gridDim.x * 2)
DEV float wave_sum(float v) {
#pragma unroll
  for (int o = 32; o > 0; o >>= 1) v += __shfl_xor(v, o);
  return v;
}

#define XB_TMO      128
#define XB_XCNT(j)  (256  + 64 * (j))
#define XB_XSUB(j)  (1280 + 64 * (j))
#define XB_XGEN(j)  (2304 + 64 * (j))
#define XB_TOP      3328
#define XB_TOPGEN   3392
#define XCD_BAR_WORDS 3456
#define XB_SPIN_CAP (1u << 18)
#define LAS __attribute__((address_space(3)))

__device__ __forceinline__ unsigned xb_ld(unsigned* p)              { return __hip_atomic_load(p, __ATOMIC_RELAXED, __HIP_MEMORY_SCOPE_AGENT); }
__device__ __forceinline__ unsigned xb_add(unsigned* p, unsigned v) { return __hip_atomic_fetch_add(p, v, __ATOMIC_RELAXED, __HIP_MEMORY_SCOPE_AGENT); }
__device__ __forceinline__ unsigned xb_xcc_id() { return (unsigned)__builtin_amdgcn_s_getreg((3 << 11) | 20) & 0xFu; }
#define XB_SPIN(cond, bar) do { unsigned _sp = 0; while (cond) { __builtin_amdgcn_s_sleep(1); \
    if ((++_sp & 255u) == 0u) { if (xb_ld(&(bar)[XB_TMO])) break; if (_sp > XB_SPIN_CAP) { atomicAdd(&(bar)[XB_TMO], 1u); break; } } } } while (0)

struct XcdBarrier {
    unsigned* bar; unsigned x;
    volatile LAS unsigned* st;
};

__device__ __forceinline__ XcdBarrier xcd_barrier_post(unsigned* bar, volatile LAS unsigned* st) {
    XcdBarrier b; b.bar = bar; b.x = xb_xcc_id(); b.st = st;
    if (threadIdx.x == 0) (void)xb_add(&bar[XB_XCNT(b.x)], 1u);
    return b;
}
__device__ __forceinline__ void xcd_barrier_complete(unsigned* bar, unsigned x, unsigned& nloc, unsigned& nx) {
    const unsigned G = gridDim.x * gridDim.y * gridDim.z;
    unsigned sum, cnt, mine, sp = 0u;
    for (;;) {
        sum = 0u; cnt = 0u; mine = 0u;
#pragma unroll
        for (unsigned j = 0; j < 16; ++j) { const unsigned c = xb_ld(&bar[XB_XCNT(j)]); sum += c; cnt += (c > 0u) ? 1u : 0u; mine = (j == x) ? c : mine; }
        if (sum == G) break;
        __builtin_amdgcn_s_sleep(1);
        if ((++sp & 255u) == 0u) { if (xb_ld(&bar[XB_TMO])) break; if (sp > XB_SPIN_CAP) { atomicAdd(&bar[XB_TMO], 1u); break; } }
    }
    nloc = mine > 0u ? mine : 1u; nx = cnt > 0u ? cnt : 1u;
}

__device__ __forceinline__ void xcd_barrier(const XcdBarrier& b) {
    asm volatile("s_waitcnt vmcnt(0)" ::: "memory");
    __syncthreads();
    if (threadIdx.x == 0) {
        unsigned* bar = b.bar;
        __builtin_amdgcn_s_waitcnt(0);
        unsigned nloc = b.st[0], nx = b.st[1];
        if (nloc == 0u) { xcd_barrier_complete(bar, b.x, nloc, nx); b.st[0] = nloc; b.st[1] = nx; }
        const unsigned old = xb_add(&bar[XB_XSUB(b.x)], 1u);
        const unsigned gen = old / nloc;
        if (old + 1u == (gen + 1u) * nloc) {
            __builtin_amdgcn_fence(__ATOMIC_RELEASE, "agent");
            asm volatile("s_waitcnt vmcnt(0)" ::: "memory");
            const unsigned og = xb_add(&bar[XB_TOP], 1u);
            const unsigned tg = og / nx;
            if (og + 1u == (tg + 1u) * nx) xb_add(&bar[XB_TOPGEN], 1u);
            else XB_SPIN(xb_ld(&bar[XB_TOPGEN]) == tg, bar);
            __builtin_amdgcn_fence(__ATOMIC_ACQUIRE, "agent");
            xb_add(&bar[XB_XGEN(b.x)], 1u);
            asm volatile("s_waitcnt vmcnt(0)" ::: "memory");
        } else {
            XB_SPIN(xb_ld(&bar[XB_XGEN(b.x)]) == gen, bar);
            __builtin_amdgcn_fence(__ATOMIC_ACQUIRE, "agent");
            asm volatile("s_waitcnt vmcnt(0)" ::: "memory");
        }
    }
    __syncthreads();
}


constexpr int BK = 64;
constexpr int LDSROW = 144;
constexpr int TILE_BYTES = 256 * LDSROW;
constexpr int HALF_BYTES = 76800;
constexpr int SMEM_BYTES = 2 * HALF_BYTES;

struct R4 { uint4 a, b, c, d; };

struct RowLoader {
  const u16* base;
  long ld;
  DEV R4 load(int tid, int r0, int k0) const {
    const int tr = tid >> 3, tc = tid & 7;
    const u16* p = base + (long)(r0 + tr) * ld + k0 + tc * 8;
    R4 r;
    r.a = *(const uint4*)(p);
    r.b = *(const uint4*)(p + 64 * ld);
    r.c = *(const uint4*)(p + 128 * ld);
    r.d = *(const uint4*)(p + 192 * ld);
    return r;
  }
  DEV void store(int tid, char* lds, const R4& r) const {
    const int tr = tid >> 3, tc = tid & 7;
    char* q = lds + tr * LDSROW + tc * 16;
    *(uint4*)(q) = r.a;
    *(uint4*)(q + 64 * LDSROW) = r.b;
    *(uint4*)(q + 128 * LDSROW) = r.c;
    *(uint4*)(q + 192 * LDSROW) = r.d;
  }
};

DEV void st8t(char* q, const uint4& v) {
  *(u16*)(q + 0 * LDSROW) = (u16)(v.x & 0xffff);
  *(u16*)(q + 1 * LDSROW) = (u16)(v.x >> 16);
  *(u16*)(q + 2 * LDSROW) = (u16)(v.y & 0xffff);
  *(u16*)(q + 3 * LDSROW) = (u16)(v.y >> 16);
  *(u16*)(q + 4 * LDSROW) = (u16)(v.z & 0xffff);
  *(u16*)(q + 5 * LDSROW) = (u16)(v.z >> 16);
  *(u16*)(q + 6 * LDSROW) = (u16)(v.w & 0xffff);
  *(u16*)(q + 7 * LDSROW) = (u16)(v.w >> 16);
}

struct TransLoader {
  const u16* U;
  int L;
  DEV R4 load(int tid, int m0, int k0) const {
    const int b = m0 / L, t0 = m0 - b * L;
    const int k = k0 + (tid & 63), tg = tid >> 6;
    const u16* p = U + ((long)(b * 1536 + 1024 + k)) * L + t0 + tg * 8;
    R4 r;
    r.a = *(const uint4*)(p);
    r.b = *(const uint4*)(p + 64);
    r.c = *(const uint4*)(p + 128);
    r.d = *(const uint4*)(p + 192);
    return r;
  }
  DEV void store(int tid, char* lds, const R4& r) const {
    const int kl = tid & 63, tg = tid >> 6;
    char* q = lds + (tg * 8) * LDSROW + kl * 2;
    st8t(q, r.a);
    st8t(q + 64 * LDSROW, r.b);
    st8t(q + 128 * LDSROW, r.c);
    st8t(q + 192 * LDSROW, r.d);
  }
};

typedef f32x16 Acc[4][2];

template <class AL, class BL>
DEV void gemm_ktile(Acc& acc, const char* A, const char* B, int wm, int wn, int lr, int lh, const AL& al, const BL& bl,
                    int tid, int m0, int n0, int knext, char* nxt, R4& ra, R4& rb) {
  bf16x8 a[2][4], b[2][2];
  const char* pa = A + (wm + lr) * LDSROW + lh * 16;
  const char* pb = B + (wn + lr) * LDSROW + lh * 16;
#pragma unroll
  for (int i = 0; i < 4; ++i) a[0][i] = *(const bf16x8*)(pa + 32 * i * LDSROW);
#pragma unroll
  for (int j = 0; j < 2; ++j) b[0][j] = *(const bf16x8*)(pb + 32 * j * LDSROW);
#pragma unroll
  for (int ks = 0; ks < 4; ++ks) {
    const int cur = ks & 1, nx = cur ^ 1;
    if (ks < 3) {
#pragma unroll
      for (int i = 0; i < 4; ++i) a[nx][i] = *(const bf16x8*)(pa + 32 * i * LDSROW + (ks + 1) * 32);
#pragma unroll
      for (int j = 0; j < 2; ++j) b[nx][j] = *(const bf16x8*)(pb + 32 * j * LDSROW + (ks + 1) * 32);
    }
    __builtin_amdgcn_sched_barrier(0);
#pragma unroll
    for (int i = 0; i < 4; ++i)
#pragma unroll
      for (int j = 0; j < 2; ++j)
        acc[i][j] = __builtin_amdgcn_mfma_f32_32x32x16_bf16(a[cur][i], b[cur][j], acc[i][j], 0, 0, 0);
    __builtin_amdgcn_sched_barrier(0);
    if (ks == 1) {
      al.store(tid, nxt, ra);
      bl.store(tid, nxt + TILE_BYTES, rb);
      __builtin_amdgcn_sched_barrier(0);
      ra = al.load(tid, m0, knext);
      rb = bl.load(tid, n0, knext);
      __builtin_amdgcn_sched_barrier(0);
    }
  }
}

template <class AL, class BL>
DEV void gemm_mainloop(Acc& acc, const AL& al, const BL& bl, int m0, int n0, int kbeg, int kend, char* lds) {
  const int tid = tidx_full();
  const int wave = tid >> 6, lane = tid & 63;
  const int wm = (wave >> 2) * 128, wn = (wave & 3) * 64;
  const int lr = lane & 31, lh = lane >> 5;
  const int nk = (kend - kbeg) / BK;
  R4 a0 = al.load(tid, m0, kbeg);
  R4 b0 = bl.load(tid, n0, kbeg);
  __syncthreads();
  al.store(tid, lds, a0);
  bl.store(tid, lds + TILE_BYTES, b0);
  a0 = al.load(tid, m0, kbeg + BK);
  b0 = bl.load(tid, n0, kbeg + BK);
  __syncthreads();
  for (int kt = 0; kt < nk; ++kt) {
    const char* cur = lds + (kt & 1) * 2 * TILE_BYTES;
    char* nxt = lds + ((kt + 1) & 1) * 2 * TILE_BYTES;
    const int t2 = (kt + 2 < nk) ? kt + 2 : nk - 1;
    __builtin_amdgcn_sched_barrier(0);
    gemm_ktile(acc, cur, cur + TILE_BYTES, wm, wn, lr, lh, al, bl, tid, m0, n0, kbeg + t2 * BK, nxt, a0, b0);
    __builtin_amdgcn_sched_barrier(0);
    __syncthreads();
  }
}

struct GemmPipe {
  R4 ra, rb;
  bool primed;
};
template <class AL, class BL>
DEV void gemm_mainloop_p(Acc& acc, const AL& al, const BL& bl, int m0, int n0, int m0n, int n0n, int K, char* lds,
                         GemmPipe& gp) {
  const int tid = tidx_full();
  const int wave = tid >> 6, lane = tid & 63;
  const int wm = (wave >> 2) * 128, wn = (wave & 3) * 64;
  const int lr = lane & 31, lh = lane >> 5;
  const int nk = K / BK;
  if (!gp.primed) {
    gp.ra = al.load(tid, m0, 0);
    gp.rb = bl.load(tid, n0, 0);
    __syncthreads();
    al.store(tid, lds, gp.ra);
    bl.store(tid, lds + TILE_BYTES, gp.rb);
    gp.ra = al.load(tid, m0, BK);
    gp.rb = bl.load(tid, n0, BK);
    __syncthreads();
  }
  for (int kt = 0; kt < nk; ++kt) {
    const char* cur = lds + (kt & 1) * 2 * TILE_BYTES;
    char* nxt = lds + ((kt + 1) & 1) * 2 * TILE_BYTES;
    const bool wrap = (kt + 2 >= nk);
    const int kk = (wrap ? kt + 2 - nk : kt + 2) * BK;
    const int mr = wrap ? m0n : m0, nr = wrap ? n0n : n0;
    __builtin_amdgcn_sched_barrier(0);
    gemm_ktile(acc, cur, cur + TILE_BYTES, wm, wn, lr, lh, al, bl, tid, mr, nr, kk, nxt, gp.ra, gp.rb);
    __builtin_amdgcn_sched_barrier(0);
    __syncthreads();
  }
}

DEV void acc_zero(Acc& acc) {
#pragma unroll
  for (int i = 0; i < 4; ++i)
#pragma unroll
    for (int j = 0; j < 2; ++j)
#pragma unroll
      for (int r = 0; r < 16; ++r) acc[i][j][r] = 0.f;
}

template <class F>
DEV void acc_foreach(Acc& acc, int m0, int n0, F f) {
  const int tid = tidx_full();
  const int wave = tid >> 6, lane = tid & 63;
  const int wm = (wave >> 2) * 128, wn = (wave & 3) * 64;
  const int lr = lane & 31, lh = lane >> 5;
#pragma unroll
  for (int i = 0; i < 4; ++i)
#pragma unroll
    for (int j = 0; j < 2; ++j)
#pragma unroll
      for (int r = 0; r < 16; ++r) {
        const int m = m0 + wm + 32 * i + (r & 3) + 8 * (r >> 2) + 4 * lh;
        const int n = n0 + wn + 32 * j + lr;
        float v = acc[i][j][r];
        f(m, n, v);
        acc[i][j][r] = v;
      }
}

DEV bool tile_map(int iter, int ntm, int ntn, int& mt, int& nt) {
  int PM = 0, PN = 0;
  if (ntn == 18) { PM = 16; PN = 2; }
  else if (ntn == 128) { PM = 2; PN = 16; }
  else if (ntn == 16 || ntn == 4) { PM = 8; PN = 4; }
  if (gridDim.x == 256 && PM > 0 && (ntm % PM) == 0) {
    const int xcd = blockIdx.x & 7, slot = blockIdx.x >> 3;
    const int nsn = ntn / PN, nsuper = (ntm / PM) * nsn;
    const int s_ = iter * 8 + xcd;
    if (s_ >= nsuper) return false;
    const int sm = s_ / nsn, sn = s_ - sm * nsn;
    mt = sm * PM + slot / PN;
    nt = sn * PN + slot % PN;
    return true;
  }
  const int tile = blockIdx.x + iter * gridDim.x;
  if (tile >= ntm * ntn) return false;
  mt = tile / ntn;
  nt = tile - mt * ntn;
  return true;
}

DEV void prep_transpose_tile(const float* __restrict__ W, int K, int N, u16* __restrict__ WT, int tile, char* smem) {
  u16(*T)[66] = (u16(*)[66])smem;
  const int ntn = N / 64;
  const int k0 = (tile / ntn) * 64, n0 = (tile % ntn) * 64;
  const int tid = tidx();
  const int kr = tid >> 4, nc = (tid & 15) * 4;
  __syncthreads();
#pragma unroll
  for (int i = 0; i < 4; ++i) {
    const int k = kr + 16 * i;
    const float4 v = *(const float4*)(W + (long)(k0 + k) * N + n0 + nc);
    T[nc + 0][k] = f2bf(v.x);
    T[nc + 1][k] = f2bf(v.y);
    T[nc + 2][k] = f2bf(v.z);
    T[nc + 3][k] = f2bf(v.w);
  }
  __syncthreads();
  const int n = tid >> 2, kc = (tid & 3) * 16;
  unsigned o[8];
#pragma unroll
  for (int i = 0; i < 8; ++i) o[i] = (unsigned)T[n][kc + 2 * i] | ((unsigned)T[n][kc + 2 * i + 1] << 16);
  uint4* dst = (uint4*)(WT + (long)(n0 + n) * K + k0 + kc);
  dst[0] = make_uint4(o[0], o[1], o[2], o[3]);
  dst[1] = make_uint4(o[4], o[5], o[6], o[7]);
}

DEV void prep_mod_item(const Params& p, int item, char* smem) {
  float* sc = (float*)smem;
  float* red = (float*)(smem + 12 * 1024 * 4);
  __syncthreads();
  const int tid = tidx();
  for (int e = tid; e < 12 * 1024; e += 256) {
    const int b = e >> 10, k = e & 1023;
    const float c = (b < 8) ? p.in[I_CP][b * 1024 + k] : p.in[I_CS][(b - 8) * 1024 + k];
    sc[e] = silu_f(c);
  }
  __syncthreads();
  const int col = tid & 31, kg = tid >> 5;
  const int j = item * 32 + col;
  float acc[12];
#pragma unroll
  for (int b = 0; b < 12; ++b) acc[b] = 0.f;
  const float* W = p.in[I_ADAW];
  for (int kk = 0; kk < 128; ++kk) {
    const int k = kg * 128 + kk;
    const float w = W[(long)k * DIN + j];
#pragma unroll
    for (int b = 0; b < 12; ++b) acc[b] += sc[b * 1024 + k] * w;
  }
#pragma unroll
  for (int b = 0; b < 12; ++b) red[(kg * 12 + b) * 32 + col] = acc[b];
  __syncthreads();
  for (int e = tid; e < 12 * 32; e += 256) {
    const int b = e >> 5, c = e & 31;
    float s = p.in[I_ADAB][item * 32 + c];
#pragma unroll
    for (int g = 0; g < 8; ++g) s += red[(g * 12 + b) * 32 + c];
    ((float*)(p.ws + OFF_MOD))[b * DIN + item * 32 + c] = s;
  }
}

DEV void phase_prep(const Params& p, char* smem) {
  if (blockIdx.x == 0 && threadIdx.x < 64) ((unsigned*)(p.ws + OFF_CNT))[threadIdx.x] = 0u;
  for (int it = VBID; it < 4096 + 192; it += NVB) {
    if (it < 1536) prep_transpose_tile(p.in[I_WIN], 1024, 6144, (u16*)(p.ws + OFF_WIN), it, smem);
    else if (it < 1792) prep_transpose_tile(p.in[I_WBR], 1024, 1024, (u16*)(p.ws + OFF_WBR), it - 1536, smem);
    else if (it < 2048) prep_transpose_tile(p.in[I_WOUT], 1024, 1024, (u16*)(p.ws + OFF_WOUT), it - 1792, smem);
    else if (it < 3072) prep_transpose_tile(p.in[I_WFF1], 1024, 4096, (u16*)(p.ws + OFF_WFF1), it - 2048, smem);
    else if (it < 4096) prep_transpose_tile(p.in[I_WFF2], 4096, 1024, (u16*)(p.ws + OFF_WFF2), it - 3072, smem);
    else prep_mod_item(p, it - 4096, smem);
  }
}

DEV void phase_filter_mlp(const Params& p, char* smem) {
  float* z = (float*)smem;
  float* h1 = z + 4 * 36;
  float* h2 = h1 + 256;
  float* h3 = h2 + 256;
  const float* w1 = p.in[I_FW1];
  const float* b1 = p.in[I_FB1];
  const float* w2 = p.in[I_FW2];
  const float* b2 = p.in[I_FB2];
  const float* w3 = p.in[I_FW3];
  const float* b3 = p.in[I_FB3];
  const float* wo = p.in[I_FWO];
  const float* fr = p.in[I_FFREQ];
  float* hraw = (float*)(p.ws + OFF_HRAW);
  float* part = (float*)(p.ws + OFF_PART);
  const int tid = tidx();
  for (int it = VBID; it < 768; it += NVB) {
    const int g = (it < 256) ? 0 : 1;
    const int L = g ? 8192 : 4096;
    const int tbase = (g ? (it - 256) : it) * 16;
    const long rowbase = g ? 4096 : 0;
    float psum[4] = {0.f, 0.f, 0.f, 0.f};
    for (int rnd = 0; rnd < 4; ++rnd) {
      const int t0 = tbase + rnd * 4;
      __syncthreads();
      if (tid < 4 * 33) {
        const int pp = tid / 33, f = tid % 33;
        const int t = t0 + pp;
        float val;
        if (f == 0) val = (float)t / (float)(L - 1);
        else {
          const int j = (f - 1) & 15;
          const float fb = 1e-4f + (float)j * ((15.0f - 1e-4f) / 15.0f);
          const float w = 6.283185307179586f * (float)t / (float)L;
          val = (f <= 16) ? cosf(fb * w) : -sinf(fb * w);
        }
        z[pp * 36 + f] = val;
      }
      __syncthreads();
      const int pp = tid >> 6, u = tid & 63;
      {
        float s = b1[u];
        for (int k = 0; k < 33; ++k) s += z[pp * 36 + k] * w1[k * 64 + u];
        h1[pp * 64 + u] = sinf(fr[u] * s);
      }
      __syncthreads();
      {
        float s = b2[u];
        for (int k = 0; k < 64; ++k) s += h1[pp * 64 + k] * w2[k * 64 + u];
        h2[pp * 64 + u] = sinf(fr[64 + u] * s);
      }
      __syncthreads();
      {
        float s = b3[u];
        for (int k = 0; k < 64; ++k) s += h2[pp * 64 + k] * w3[k * 64 + u];
        h3[pp * 64 + u] = sinf(fr[128 + u] * s);
      }
      __syncthreads();
      float acc[4][4];
#pragma unroll
      for (int a = 0; a < 4; ++a)
#pragma unroll
        for (int q = 0; q < 4; ++q) acc[a][q] = 0.f;
      for (int k = 0; k < 64; ++k) {
        float wv[4];
#pragma unroll
        for (int q = 0; q < 4; ++q) wv[q] = wo[k * 1024 + tid + 256 * q];
#pragma unroll
        for (int a = 0; a < 4; ++a) {
          const float hv = h3[a * 64 + k];
#pragma unroll
          for (int q = 0; q < 4; ++q) acc[a][q] += hv * wv[q];
        }
      }
#pragma unroll
      for (int q = 0; q < 4; ++q) {
        const int c = tid + 256 * q;
        const int ch = c & 511;
        const float mind = -3.0701134573253943f, maxd = -15.350567286626972f;
        const float delta = fabsf(mind + (float)ch * ((maxd - mind) / 511.0f));
#pragma unroll
        for (int a = 0; a < 4; ++a) {
          const int t = t0 + a;
          const float tt = (float)t / (float)(L - 1);
          const float val = acc[a][q] * __expf(-tt * delta);
          hraw[(rowbase + t) * 1024 + c] = val;
          if (!(c >= 512 && t == 0)) psum[q] += fabsf(val);
        }
      }
    }
#pragma unroll
    for (int q = 0; q < 4; ++q) part[(long)it * 1024 + tid + 256 * q] = psum[q];
  }
}

DEV void phase_filter_norm(const Params& p, char* smem) {
  float* Tf = (float*)smem;
  float* Tb = Tf + 64 * 65;
  float* red = Tb + 64 * 65;
  float* nrm = red + 256;
  const float* hraw = (const float*)(p.ws + OFF_HRAW);
  const float* part = (const float*)(p.ws + OFF_PART);
  const int tid = tidx();
  for (int it = VBID; it < 512 + 1024; it += NVB) {
    const int g = (it < 512) ? 0 : 1;
    const int L = g ? 8192 : 4096;
    const int li = g ? it - 512 : it;
    const int ntt = L / 64;
    const int ct = li / ntt, tt = li % ntt;
    const long rowbase = g ? 4096 : 0;
    const int prow0 = g ? 256 : 0, nprow = g ? 512 : 256;
    u16* KK = (u16*)(p.ws + OFF_KK) + (g ? (size_t)512 * 8192 : 0);
    __syncthreads();
    {
      const int c = tid & 63, ph = tid >> 6;
      float s = 0.f;
      for (int r = ph; r < nprow; r += 4) {
        s += part[(long)(prow0 + r) * 1024 + ct * 64 + c];
        s += part[(long)(prow0 + r) * 1024 + 512 + ct * 64 + c];
      }
      red[ph * 64 + c] = s;
#pragma unroll
      for (int i = 0; i < 16; ++i) {
        const int r = ph + 4 * i;
        const long row = rowbase + tt * 64 + r;
        Tf[c * 65 + r] = hraw[row * 1024 + ct * 64 + c];
        Tb[c * 65 + r] = hraw[row * 1024 + 512 + ct * 64 + c];
      }
    }
    __syncthreads();
    if (tid < 64) nrm[tid] = red[tid] + red[64 + tid] + red[128 + tid] + red[192 + tid] + EPSF;
    __syncthreads();
    {
      const int c = tid >> 2, rq = (tid & 3) * 16;
      const float inv = 1.f / nrm[c];
      u16* row = KK + (size_t)(ct * 64 + c) * (2 * L);
#pragma unroll
      for (int i = 0; i < 16; ++i) {
        const int r = rq + i;
        const int t = tt * 64 + r;
        row[L - t] = f2bf(Tf[c * 65 + r] * inv);
        if (t >= 1) row[L + t] = f2bf(Tb[c * 65 + r] * inv);
      }
      if (tt == 0 && (tid & 3) == 0) row[0] = 0;
    }
  }
}

DEV void phase_norm_adaln(const float* __restrict__ X, const float* __restrict__ gvec, const float* __restrict__ mod,
                          int bg0, int L, int sh_off, int sc_off, u16* __restrict__ H) {
  const int tid = tidx();
  const int wave = tid >> 6, lane = tid & 63;
  constexpr int RB = 4;
  const int stride = NVB * 4;
  for (int row0 = VBID * 4 + wave; row0 < NTOK; row0 += stride * RB) {
    float4 v[RB][4];
    float ss[RB];
#pragma unroll
    for (int j = 0; j < RB; ++j) {
      const int row = row0 + j * stride;
      const float* x = X + (long)(row < NTOK ? row : row0) * D;
#pragma unroll
      for (int i = 0; i < 4; ++i) v[j][i] = *(const float4*)(x + lane * 4 + 256 * i);
    }
#pragma unroll
    for (int j = 0; j < RB; ++j) {
      float t = 0.f;
#pragma unroll
      for (int i = 0; i < 4; ++i) t += v[j][i].x * v[j][i].x + v[j][i].y * v[j][i].y + v[j][i].z * v[j][i].z + v[j][i].w * v[j][i].w;
      ss[j] = wave_sum(t);
    }
#pragma unroll
    for (int j = 0; j < RB; ++j) {
      const int row = row0 + j * stride;
      if (row < NTOK) {
        const float rstd = rsqrtf(ss[j] * (1.f / 1024.f) + EPSF);
        const float* mrow = mod + (long)(bg0 + row / L) * DIN;
#pragma unroll
        for (int i = 0; i < 4; ++i) {
          const int k = lane * 4 + 256 * i;
          const float4 g = *(const float4*)(gvec + k);
          const float4 sc = *(const float4*)(mrow + sc_off + k);
          const float4 sh = *(const float4*)(mrow + sh_off + k);
          const float o0 = v[j][i].x * rstd * g.x * (1.f + sc.x) + sh.x;
          const float o1 = v[j][i].y * rstd * g.y * (1.f + sc.y) + sh.y;
          const float o2 = v[j][i].z * rstd * g.z * (1.f + sc.z) + sh.z;
          const float o3 = v[j][i].w * rstd * g.w * (1.f + sc.w) + sh.w;
          *(uint2*)(H + (long)row * D + k) = make_uint2(pack2(o0, o1), pack2(o2, o3));
        }
      }
    }
  }
}

DEV void phase_final_norm(float* __restrict__ X, const float* __restrict__ gvec) {
  const int tid = tidx();
  const int wave = tid >> 6, lane = tid & 63;
  constexpr int RB = 4;
  const int stride = NVB * 4;
  for (int row0 = VBID * 4 + wave; row0 < NTOK; row0 += stride * RB) {
    float4 v[RB][4];
    float ss[RB];
#pragma unroll
    for (int j = 0; j < RB; ++j) {
      const int row = row0 + j * stride;
      const float* x = X + (long)(row < NTOK ? row : row0) * D;
#pragma unroll
      for (int i = 0; i < 4; ++i) v[j][i] = *(const float4*)(x + lane * 4 + 256 * i);
    }
#pragma unroll
    for (int j = 0; j < RB; ++j) {
      float t = 0.f;
#pragma unroll
      for (int i = 0; i < 4; ++i) t += v[j][i].x * v[j][i].x + v[j][i].y * v[j][i].y + v[j][i].z * v[j][i].z + v[j][i].w * v[j][i].w;
      ss[j] = wave_sum(t);
    }
#pragma unroll
    for (int j = 0; j < RB; ++j) {
      const int row = row0 + j * stride;
      if (row < NTOK) {
        const float rstd = rsqrtf(ss[j] * (1.f / 1024.f) + EPSF);
        float* x = X + (long)row * D;
#pragma unroll
        for (int i = 0; i < 4; ++i) {
          const int k = lane * 4 + 256 * i;
          const float4 g = *(const float4*)(gvec + k);
          *(float4*)(x + k) = make_float4(v[j][i].x * rstd * g.x, v[j][i].y * rstd * g.y, v[j][i].z * rstd * g.z, v[j][i].w * rstd * g.w);
        }
      }
    }
  }
}

DEV void norm_adaln_rows(const float* __restrict__ X, const float* __restrict__ gvec, const float* __restrict__ mod,
                         int bg0, int L, int sh_off, int sc_off, u16* __restrict__ H, int rbeg) {
  const int tid = tidx();
  const int wave = tid >> 6, lane = tid & 63;
  for (int jb = 0; jb < 16; jb += 4) {
    float4 v[4][4];
    float ss[4];
#pragma unroll
    for (int j = 0; j < 4; ++j) {
      const float* x = X + (long)(rbeg + wave + 4 * (jb + j)) * D;
#pragma unroll
      for (int i = 0; i < 4; ++i) v[j][i] = *(const float4*)(x + lane * 4 + 256 * i);
    }
#pragma unroll
    for (int j = 0; j < 4; ++j) {
      float t = 0.f;
#pragma unroll
      for (int i = 0; i < 4; ++i) t += v[j][i].x * v[j][i].x + v[j][i].y * v[j][i].y + v[j][i].z * v[j][i].z + v[j][i].w * v[j][i].w;
      ss[j] = wave_sum(t);
    }
#pragma unroll
    for (int j = 0; j < 4; ++j) {
      const int row = rbeg + wave + 4 * (jb + j);
      const float rstd = rsqrtf(ss[j] * (1.f / 1024.f) + EPSF);
      const float* mrow = mod + (long)(bg0 + row / L) * DIN;
#pragma unroll
      for (int i = 0; i < 4; ++i) {
        const int k = lane * 4 + 256 * i;
        const float4 g = *(const float4*)(gvec + k);
        const float4 sc = *(const float4*)(mrow + sc_off + k);
        const float4 sh = *(const float4*)(mrow + sh_off + k);
        const float o0 = v[j][i].x * rstd * g.x * (1.f + sc.x) + sh.x;
        const float o1 = v[j][i].y * rstd * g.y * (1.f + sc.y) + sh.y;
        const float o2 = v[j][i].z * rstd * g.z * (1.f + sc.z) + sh.z;
        const float o3 = v[j][i].w * rstd * g.w * (1.f + sc.w) + sh.w;
        *(uint2*)(H + (long)row * D + k) = make_uint2(pack2(o0, o1), pack2(o2, o3));
      }
    }
  }
}

DEV void final_norm_rows(float* __restrict__ X, const float* __restrict__ gvec, int rbeg) {
  const int tid = tidx();
  const int wave = tid >> 6, lane = tid & 63;
  for (int jb = 0; jb < 16; jb += 4) {
    float4 v[4][4];
    float ss[4];
#pragma unroll
    for (int j = 0; j < 4; ++j) {
      const float* x = X + (long)(rbeg + wave + 4 * (jb + j)) * D;
#pragma unroll
      for (int i = 0; i < 4; ++i) v[j][i] = *(const float4*)(x + lane * 4 + 256 * i);
    }
#pragma unroll
    for (int j = 0; j < 4; ++j) {
      float t = 0.f;
#pragma unroll
      for (int i = 0; i < 4; ++i) t += v[j][i].x * v[j][i].x + v[j][i].y * v[j][i].y + v[j][i].z * v[j][i].z + v[j][i].w * v[j][i].w;
      ss[j] = wave_sum(t);
    }
#pragma unroll
    for (int j = 0; j < 4; ++j) {
      float* x = X + (long)(rbeg + wave + 4 * (jb + j)) * D;
      const float rstd = rsqrtf(ss[j] * (1.f / 1024.f) + EPSF);
#pragma unroll
      for (int i = 0; i < 4; ++i) {
        const int k = lane * 4 + 256 * i;
        const float4 g = *(const float4*)(gvec + k);
        *(float4*)(x + k) = make_float4(v[j][i].x * rstd * g.x, v[j][i].y * rstd * g.y, v[j][i].z * rstd * g.z, v[j][i].w * rstd * g.w);
      }
    }
  }
}

DEV void phase_p1(const Params& p, int g, char* smem) {
  const int L = g ? 8192 : 4096;
  const u16* H = (const u16*)(p.out + (size_t)g * NTOK * D);
  const u16* WinT = (const u16*)(p.ws + OFF_WIN);
  u16* PHG = (u16*)(p.ws + OFF_PHG);
  u16* GT = (u16*)(p.ws + OFF_GT);
  u16* UHY = (u16*)(p.ws + OFF_UHY);
  {
    GemmPipe gp;
    gp.primed = false;
    for (int iter = 0;; ++iter) {
      int mt, nt, mtn, ntn;
      if (!tile_map(iter, 128, 18, mt, nt)) break;
      const bool more = tile_map(iter + 1, 128, 18, mtn, ntn);
      if (!more) { mtn = mt; ntn = nt; }
      Acc acc;
      acc_zero(acc);
      const int m0 = mt * 256, n0 = nt * 256;
      RowLoader al{H, 1024}, bl{WinT + (size_t)1536 * 1024, 1024};
      gemm_mainloop_p(acc, al, bl, m0, n0, mtn * 256, ntn * 256, 1024, smem, gp);
      gp.primed = more;
      if (n0 < 2560) {
        const bool dosilu = (n0 < 512) || (n0 >= 2048);
        acc_foreach(acc, m0, n0, [&](int m, int n, float& v) {
          const float o = dosilu ? silu_f(v) : v;
          PHG[(size_t)m * 2560 + n] = f2bf(o);
        });
      } else {
        acc_foreach(acc, m0, n0, [&](int m, int n, float& v) { GT[(size_t)m * 2048 + (n - 2560)] = f2bf(sigmoid_f(v)); });
      }
    }
  }
  {
    GemmPipe gp;
    gp.primed = false;
    for (int iter = 0;; ++iter) {
      int cm, tn, cmn, tnn;
      if (!tile_map(iter, 6, 128, cm, tn)) break;
      const bool more = tile_map(iter + 1, 6, 128, cmn, tnn);
      if (!more) { cmn = cm; tnn = tn; }
      Acc acc;
      acc_zero(acc);
      const int m0 = cm * 256, n0 = tn * 256;
      RowLoader al{WinT, 1024}, bl{H, 1024};
      gemm_mainloop_p(acc, al, bl, m0, n0, cmn * 256, tnn * 256, 1024, smem, gp);
      gp.primed = more;
      const int b = n0 / L, tb = n0 - b * L;
      u16* dst = UHY + (size_t)b * 1536 * L + tb - n0;
      acc_foreach(acc, m0, n0, [&](int m, int n, float& v) { dst[(size_t)m * L + n] = f2bf(v); });
    }
  }
}

DEV void phase_p15(const Params& p, int g) {
  const u16* PHG = (const u16*)(p.ws + OFF_PHG);
  u16* QK = (u16*)(p.out + (size_t)g * NTOK * D);
  u16* KT = (u16*)(p.ws + OFF_KT);
  float* DEC = (float*)(p.ws + OFF_DEC);
  for (int it = VBID; it < 1024; it += NVB) {
    const int tid = tidx();
    const int cidx = it >> 1, dir = it & 1;
    u16* Qp = QK + (size_t)(2 * dir) * NTOK * 512;
    u16* Kp = Qp + (size_t)NTOK * 512;
    float lb[2], G[2];
#pragma unroll
    for (int cc = 0; cc < 2; ++cc) {
      const int c = tid + 256 * cc;
      const float a0 = p.in[I_LB][(0 * 2 + dir) * 512 + c];
      const float a1 = p.in[I_LB][(1 * 2 + dir) * 512 + c];
      lb[cc] = 1.f / (1.f + __expf(a1 - a0));
      G[cc] = 0.f;
    }
    u16 xr[3][2][8], qr[3][2][8];
#define P15_LOAD(st_, j8_)                                                          \
    _Pragma("unroll") for (int e = 0; e < 8; ++e) {                                 \
      const int jj = (j8_) * 8 + e;                                                 \
      const int j = dir ? 63 - jj : jj;                                             \
      const size_t tok = (size_t)cidx * 64 + j;                                     \
      _Pragma("unroll") for (int cc = 0; cc < 2; ++cc) {                            \
        xr[st_][cc][e] = PHG[tok * 2560 + 1024 + 512 * dir + tid + 256 * cc];       \
        qr[st_][cc][e] = PHG[tok * 2560 + tid + 256 * cc];                          \
      }                                                                             \
    }
    P15_LOAD(0, 0);
    P15_LOAD(1, 1);
#pragma unroll
    for (int j8 = 0; j8 < 8; ++j8) {
      const int st = j8 % 3;
      if (j8 < 6) { P15_LOAD((j8 + 2) % 3, j8 + 2); }
#pragma unroll
      for (int cc = 0; cc < 2; ++cc) {
        const int c = tid + 256 * cc;
        unsigned kb[8];
#pragma unroll
        for (int e = 0; e < 8; ++e) {
          const int jj = j8 * 8 + e;
          const int j = dir ? 63 - jj : jj;
          const size_t tok = (size_t)cidx * 64 + j;
          const float f = lb[cc] + (1.f - lb[cc]) * sigmoid_f(bf2f(xr[st][cc][e]));
          G[cc] += __logf(f);
          const float eg = __expf(G[cc]), ig = __expf(-G[cc]);
          Qp[tok * 512 + c] = f2bf(bf2f(qr[st][cc][e]) * eg);
          const u16 kk = f2bf((1.f - f) * ig);
          Kp[tok * 512 + c] = kk;
          kb[e] = kk;
        }
        const int s0 = dir ? 56 - 8 * j8 : 8 * j8;
        uint4 w;
        w.x = dir ? (kb[7] | (kb[6] << 16)) : (kb[0] | (kb[1] << 16));
        w.y = dir ? (kb[5] | (kb[4] << 16)) : (kb[2] | (kb[3] << 16));
        w.z = dir ? (kb[3] | (kb[2] << 16)) : (kb[4] | (kb[5] << 16));
        w.w = dir ? (kb[1] | (kb[0] << 16)) : (kb[6] | (kb[7] << 16));
        *(uint4*)(KT + (((size_t)cidx * 2 + dir) * 512 + c) * 64 + s0) = w;
      }
    }
#undef P15_LOAD
#pragma unroll
    for (int cc = 0; cc < 2; ++cc) DEC[((size_t)dir * 512 + cidx) * 512 + tid + 256 * cc] = __expf(G[cc]);
  }
}

DEV void scan_item_mfma(const Params& p, int g, int item, char* smem) {
  const int L = g ? 8192 : 4096;
  const int NC = L / 64;
  const int vs = item & 3, dir = (item >> 2) & 1, h = (item >> 3) & 3, b = item >> 5;
  char* Qs = smem;
  char* Ks = Qs + 17408;
  char* KTs = Ks + 17408;
  char* Vts = KTs + 18432;
  char* Ps = Vts + 4608;
  char* Sts = Ps + 9216;
  float* decs = (float*)(Sts + 8704);
  u16* PHG = (u16*)(p.ws + OFF_PHG);
  const u16* QK = (const u16*)(p.out + (size_t)g * NTOK * D);
  const u16* Qp = QK + (size_t)(2 * dir) * NTOK * 512;
  const u16* Kp = Qp + (size_t)NTOK * 512;
  const u16* KT = (const u16*)(p.ws + OFF_KT);
  const float* DEC = (const float*)(p.ws + OFF_DEC);
  const int tid = tidx();
  const int wave = __builtin_amdgcn_readfirstlane(tid >> 6);
  const int lane = tid & 63, r = lane & 31, hh = lane >> 5;
  __syncthreads();
  for (int e = tid; e < 8704 / 16; e += 256) ((uint4*)Sts)[e] = make_uint4(0, 0, 0, 0);
  f32x16 accS[2];
#pragma unroll
  for (int t = 0; t < 2; ++t)
#pragma unroll
    for (int i = 0; i < 16; ++i) accS[t][i] = 0.f;
  const int ocol = (dir ? 1024 : 0) + h * 128 + vs * 32;

  uint4 q0, q1, q2, q3, k0, k1, k2, k3, t0, t1, t2, t3, vv;
  float dd = 0.f;
  const int qrow = tid >> 4, qc = tid & 15;
  const int trow = tid >> 3, tc = tid & 7;
  const int vrow = tid >> 2, vc = tid & 3;
#define SCAN_ISSUE(n_)                                                                                   \
  {                                                                                                      \
    const size_t cidx_ = (size_t)b * NC + (n_);                                                          \
    const size_t tok_ = cidx_ * 64;                                                                      \
    const u16* gq = Qp + (tok_ + qrow) * 512 + h * 128 + qc * 8;                                         \
    const u16* gk = Kp + (tok_ + qrow) * 512 + h * 128 + qc * 8;                                         \
    q0 = *(const uint4*)(gq); q1 = *(const uint4*)(gq + 16 * 512);                                       \
    q2 = *(const uint4*)(gq + 32 * 512); q3 = *(const uint4*)(gq + 48 * 512);                            \
    k0 = *(const uint4*)(gk); k1 = *(const uint4*)(gk + 16 * 512);                                       \
    k2 = *(const uint4*)(gk + 32 * 512); k3 = *(const uint4*)(gk + 48 * 512);                            \
    const u16* gt = KT + ((cidx_ * 2 + dir) * 512 + h * 128 + trow) * 64 + tc * 8;                       \
    t0 = *(const uint4*)(gt); t1 = *(const uint4*)(gt + 32 * 64);                                        \
    t2 = *(const uint4*)(gt + 64 * 64); t3 = *(const uint4*)(gt + 96 * 64);                              \
    vv = *(const uint4*)(PHG + (tok_ + vrow) * 2560 + 512 + h * 128 + vs * 32 + vc * 8);                 \
    dd = DEC[((size_t)dir * 512 + cidx_) * 512 + h * 128 + (tid & 127)];                                 \
  }
#define SCAN_BAR()                                        \
  {                                                       \
    asm volatile("s_waitcnt lgkmcnt(0)" ::: "memory");     \
    __builtin_amdgcn_s_barrier();                         \
    asm volatile("" ::: "memory");                         \
  }
  unsigned opk[8] = {0u, 0u, 0u, 0u, 0u, 0u, 0u, 0u};
  size_t otok = 0;
  SCAN_ISSUE(dir ? NC - 1 : 0);
  for (int ci = 0; ci < NC; ++ci) {
    const int n = dir ? NC - 1 - ci : ci;
    const size_t tok0 = ((size_t)b * NC + n) * 64;
    {
      char* d = Qs + qrow * 272 + qc * 16;
      *(uint4*)(d) = q0; *(uint4*)(d + 16 * 272) = q1; *(uint4*)(d + 32 * 272) = q2; *(uint4*)(d + 48 * 272) = q3;
      d = Ks + qrow * 272 + qc * 16;
      *(uint4*)(d) = k0; *(uint4*)(d + 16 * 272) = k1; *(uint4*)(d + 32 * 272) = k2; *(uint4*)(d + 48 * 272) = k3;
      d = KTs + trow * 144 + tc * 16;
      *(uint4*)(d) = t0; *(uint4*)(d + 32 * 144) = t1; *(uint4*)(d + 64 * 144) = t2; *(uint4*)(d + 96 * 144) = t3;
      st8t(Vts + (vc * 8) * 144 + vrow * 2, vv);
      if (tid < 128) decs[tid] = dd;
      if (wave < 2 && ci > 0) {
        u16* og = PHG + (otok + 32 * wave + 4 * hh) * 2560 + ocol + r;
#pragma unroll
        for (int i = 0; i < 8; ++i) {
          og[(size_t)(((2 * i) & 3) + 8 * ((2 * i) >> 2)) * 2560] = (u16)(opk[i] & 0xffffu);
          og[(size_t)(((2 * i + 1) & 3) + 8 * ((2 * i + 1) >> 2)) * 2560] = (u16)(opk[i] >> 16);
        }
      }
      if (wave >= 2 && ci > 0) {
#pragma unroll
        for (int t = 0; t < 2; ++t) {
          const int kt = 2 * (wave - 2) + t;
#pragma unroll
          for (int rg = 0; rg < 4; ++rg) {
            const int kk0 = 32 * kt + 8 * rg + 4 * hh;
            *(uint2*)(Sts + r * 272 + kk0 * 2) = make_uint2(pack2(accS[t][4 * rg + 0], accS[t][4 * rg + 1]),
                                                            pack2(accS[t][4 * rg + 2], accS[t][4 * rg + 3]));
          }
        }
      }
    }
    SCAN_BAR();
    {
      const int nn = (ci + 1 < NC) ? (dir ? NC - 2 - ci : ci + 1) : n;
      SCAN_ISSUE(nn);
    }
    __builtin_amdgcn_sched_barrier(0);
    {
      const int jt = wave >> 1, st = wave & 1;
      const bool active = dir ? (st >= jt) : (st <= jt);
      f32x16 pa;
#pragma unroll
      for (int i = 0; i < 16; ++i) pa[i] = 0.f;
      if (active) {
        bf16x8 qa[8], kb[8];
#pragma unroll
        for (int ks = 0; ks < 8; ++ks) {
          qa[ks] = *(const bf16x8*)(Qs + (32 * jt + r) * 272 + ks * 32 + hh * 16);
          kb[ks] = *(const bf16x8*)(Ks + (32 * st + r) * 272 + ks * 32 + hh * 16);
        }
        __builtin_amdgcn_sched_barrier(0);
        f32x16 p1;
#pragma unroll
        for (int i = 0; i < 16; ++i) p1[i] = 0.f;
#pragma unroll
        for (int ks = 0; ks < 4; ++ks) {
          pa = __builtin_amdgcn_mfma_f32_32x32x16_bf16(qa[2 * ks], kb[2 * ks], pa, 0, 0, 0);
          p1 = __builtin_amdgcn_mfma_f32_32x32x16_bf16(qa[2 * ks + 1], kb[2 * ks + 1], p1, 0, 0, 0);
        }
#pragma unroll
        for (int i = 0; i < 16; ++i) pa[i] += p1[i];
      }
#pragma unroll
      for (int i = 0; i < 16; ++i) {
        const int j = 32 * jt + (i & 3) + 8 * (i >> 2) + 4 * hh;
        const int s_ = 32 * st + r;
        const bool keep = dir ? (s_ >= j) : (s_ <= j);
        *(u16*)(Ps + j * 144 + s_ * 2) = keep ? f2bf(pa[i]) : (u16)0;
      }
    }
    SCAN_BAR();
    if (wave < 2) {
      const int jt = wave;
      bf16x8 pp[4], vb[4], qa[4], sb[4];
#pragma unroll
      for (int ks = 0; ks < 4; ++ks) {
        pp[ks] = *(const bf16x8*)(Ps + (32 * jt + r) * 144 + ks * 32 + hh * 16);
        vb[ks] = *(const bf16x8*)(Vts + r * 144 + ks * 32 + hh * 16);
        qa[ks] = *(const bf16x8*)(Qs + (32 * jt + r) * 272 + ks * 32 + hh * 16);
        sb[ks] = *(const bf16x8*)(Sts + r * 272 + ks * 32 + hh * 16);
      }
      __builtin_amdgcn_sched_barrier(0);
      f32x16 o, o1;
#pragma unroll
      for (int i = 0; i < 16; ++i) { o[i] = 0.f; o1[i] = 0.f; }
#pragma unroll
      for (int ks = 0; ks < 4; ++ks) {
        o = __builtin_amdgcn_mfma_f32_32x32x16_bf16(pp[ks], vb[ks], o, 0, 0, 0);
        o1 = __builtin_amdgcn_mfma_f32_32x32x16_bf16(qa[ks], sb[ks], o1, 0, 0, 0);
      }
      __builtin_amdgcn_sched_barrier(0);
#pragma unroll
      for (int ks = 0; ks < 4; ++ks) {
        qa[ks] = *(const bf16x8*)(Qs + (32 * jt + r) * 272 + (ks + 4) * 32 + hh * 16);
        sb[ks] = *(const bf16x8*)(Sts + r * 272 + (ks + 4) * 32 + hh * 16);
      }
      __builtin_amdgcn_sched_barrier(0);
      o = __builtin_amdgcn_mfma_f32_32x32x16_bf16(qa[0], sb[0], o, 0, 0, 0);
      o1 = __builtin_amdgcn_mfma_f32_32x32x16_bf16(qa[1], sb[1], o1, 0, 0, 0);
      o = __builtin_amdgcn_mfma_f32_32x32x16_bf16(qa[2], sb[2], o, 0, 0, 0);
      o1 = __builtin_amdgcn_mfma_f32_32x32x16_bf16(qa[3], sb[3], o1, 0, 0, 0);
      f32x16 o2;
#pragma unroll
      for (int i = 0; i < 16; ++i) o2[i] = 0.f;
#pragma unroll
      for (int i = 0; i < 8; ++i)
        opk[i] = pack2(o[2 * i] + o1[2 * i] + o2[2 * i], o[2 * i + 1] + o1[2 * i + 1] + o2[2 * i + 1]);
      otok = tok0;
    } else {
      const int kt0 = 2 * (wave - 2);
      bf16x8 ka[2][4], vb[4];
#pragma unroll
      for (int ks = 0; ks < 4; ++ks) {
        vb[ks] = *(const bf16x8*)(Vts + r * 144 + ks * 32 + hh * 16);
        ka[0][ks] = *(const bf16x8*)(KTs + (32 * kt0 + r) * 144 + ks * 32 + hh * 16);
        ka[1][ks] = *(const bf16x8*)(KTs + (32 * (kt0 + 1) + r) * 144 + ks * 32 + hh * 16);
      }
      __builtin_amdgcn_sched_barrier(0);
#pragma unroll
      for (int ks = 0; ks < 4; ++ks) {
        accS[0] = __builtin_amdgcn_mfma_f32_32x32x16_bf16(ka[0][ks], vb[ks], accS[0], 0, 0, 0);
        accS[1] = __builtin_amdgcn_mfma_f32_32x32x16_bf16(ka[1][ks], vb[ks], accS[1], 0, 0, 0);
      }
#pragma unroll
      for (int t = 0; t < 2; ++t)
#pragma unroll
        for (int i = 0; i < 16; ++i) accS[t][i] *= decs[32 * (kt0 + t) + (i & 3) + 8 * (i >> 2) + 4 * hh];
    }
    SCAN_BAR();
  }
  if (wave < 2) {
    u16* og = PHG + (otok + 32 * wave + 4 * hh) * 2560 + ocol + r;
#pragma unroll
    for (int i = 0; i < 8; ++i) {
      og[(size_t)(((2 * i) & 3) + 8 * ((2 * i) >> 2)) * 2560] = (u16)(opk[i] & 0xffffu);
      og[(size_t)(((2 * i + 1) & 3) + 8 * ((2 * i + 1) >> 2)) * 2560] = (u16)(opk[i] >> 16);
    }
  }
#undef SCAN_ISSUE
#undef SCAN_BAR
}

DEV float conv3_at(const u16* __restrict__ row, int t, int L, float w0, float w1, float w2, float bb) {
  const float um = (t > 0) ? bf2f(row[t - 1]) : 0.f;
  const float u0 = bf2f(row[t]);
  const float up = (t < L - 1) ? bf2f(row[t + 1]) : 0.f;
  return um * w0 + u0 * w1 + up * w2 + bb;
}

struct F8 { float v[8]; };
DEV F8 conv8(const u16* __restrict__ row, int t, int L, float w0, float w1, float w2, float bb) {
  const uint4 u = *(const uint4*)(row + t);
  const float um = (t > 0) ? bf2f(row[t - 1]) : 0.f;
  const float up = (t + 8 < L) ? bf2f(row[t + 8]) : 0.f;
  float x[10];
  x[0] = um;
  x[1] = bflo(u.x); x[2] = bfhi(u.x); x[3] = bflo(u.y); x[4] = bfhi(u.y);
  x[5] = bflo(u.z); x[6] = bfhi(u.z); x[7] = bflo(u.w); x[8] = bfhi(u.w);
  x[9] = up;
  F8 o;
#pragma unroll
  for (int j = 0; j < 8; ++j) o.v[j] = x[j] * w0 + x[j + 1] * w1 + x[j + 2] * w2 + bb;
  return o;
}

template <int BG>
DEV void hyena_item_mfma(const Params& p, int g, int item, char* smem, int half) {
  constexpr int NT = 256 / BG;
  constexpr int L = NT * 64;
  constexpr int VROW = 144;
  constexpr int RK1 = 4 * L + 64;
  constexpr int VBASE = 2 * (4 * L + 64);
  const int c = item >> 1, bgi = item & 1;
  char* Vl = smem + VBASE + half * (257 * VROW);
  u16* UHY = (u16*)(p.ws + OFF_UHY);
  const u16* RK = (const u16*)(p.ws + OFF_KK) + (g ? (size_t)512 * 8192 : 0) + (size_t)c * 2 * L;
  const float* cw = p.in[I_CONVW];
  const float* cb = p.in[I_CONVB];
  const int tid = tidx();
  __syncthreads();
  if (half == 0) {
#pragma unroll 8
    for (int e = tid; e < 2 * L / 8; e += 256) ((uint4*)smem)[e] = ((const uint4*)RK)[e];
  } else {
#pragma unroll 4
    for (int e = tid; e < 2 * L / 8; e += 256) {
      const uint4 v = ((const uint4*)RK)[e];
      const unsigned nx = (8 * e + 8 < 2 * L) ? (unsigned)RK[8 * e + 8] : 0u;
      uint4 o;
      o.x = (v.x >> 16) | (v.y << 16);
      o.y = (v.y >> 16) | (v.z << 16);
      o.z = (v.z >> 16) | (v.w << 16);
      o.w = (v.w >> 16) | (nx << 16);
      ((uint4*)(smem + RK1))[e] = o;
    }
  }
  {
    const float wx1_0 = cw[0 * 1536 + 512 + c], wx1_1 = cw[1 * 1536 + 512 + c], wx1_2 = cw[2 * 1536 + 512 + c], bx1 = cb[512 + c];
    const float wv_0 = cw[0 * 1536 + 1024 + c], wv_1 = cw[1 * 1536 + 1024 + c], wv_2 = cw[2 * 1536 + 1024 + c], bv = cb[1024 + c];
#pragma unroll 4
    for (int e = tid; e < BG * L / 8; e += 256) {
      const int bl = e / (L / 8), t = (e % (L / 8)) * 8;
      const int b = bgi * BG + bl;
      const F8 a = conv8(UHY + ((size_t)b * 1536 + 1024 + c) * L, t, L, wv_0, wv_1, wv_2, bv);
      const F8 x = conv8(UHY + ((size_t)b * 1536 + 512 + c) * L, t, L, wx1_0, wx1_1, wx1_2, bx1);
      *(uint4*)(Vl + ((t >> 6) * BG + bl) * VROW + (t & 63) * 2) =
          make_uint4(pack2(a.v[0] * x.v[0], a.v[1] * x.v[1]), pack2(a.v[2] * x.v[2], a.v[3] * x.v[3]),
                     pack2(a.v[4] * x.v[4], a.v[5] * x.v[5]), pack2(a.v[6] * x.v[6], a.v[7] * x.v[7]));
    }
  }
  if (tid < 9) *(uint4*)(Vl + 256 * VROW + tid * 16) = make_uint4(0u, 0u, 0u, 0u);
  __syncthreads();
  const int wave = tid >> 6, lane = tid & 63;
  const int n = lane & 31, hh = lane >> 5;
  Acc acc;
  acc_zero(acc);
  const int colw = wave * 64;
  {
    typedef __attribute__((ext_vector_type(2))) unsigned u32x2;
    typedef __attribute__((ext_vector_type(4))) unsigned u32x4;
    struct HySet {
      u32x2 wlo[6], whi[6];
      u32x4 bv[2][4];
      bool valid[2];
    };
    const int Tw0 = colw / BG;
    const int dlo = Tw0 - NT + 1, dhi = Tw0 + 64 / BG - 1;
    const int par = n & 1;
    const unsigned pkb = (unsigned)(size_t)smem + (par ? RK1 : 0) + 2u * (unsigned)(L - n + 8 * hh - 32 - par);
    const unsigned vlb = (unsigned)(size_t)Vl;
#define HY_PREP(Y_, dl_)                                              \
    const unsigned pabY_ = pkb - 128u * (unsigned)(dl_);               \
    unsigned pbY0_;                                                    \
    {                                                                  \
      const int col = colw + 0 + n;                                   \
      const int S = col / BG - (dl_);                                  \
      Y_.valid[0] = (unsigned)S < (unsigned)NT;                        \
      const int scol = Y_.valid[0] ? col - (dl_) * BG : 256;           \
      pbY0_ = vlb + (unsigned)(scol * VROW + hh * 16);                 \
    }                                                                  \
    unsigned pbY1_;                                                    \
    {                                                                  \
      const int col = colw + 32 + n;                                   \
      const int S = col / BG - (dl_);                                  \
      Y_.valid[1] = (unsigned)S < (unsigned)NT;                        \
      const int scol = Y_.valid[1] ? col - (dl_) * BG : 256;           \
      pbY1_ = vlb + (unsigned)(scol * VROW + hh * 16);                 \
    }                                                                  \

#define HY_ISSUE0(Y_, dl_)                                            \
    {                                                                  \
      HY_PREP(Y_, dl_)                                                 \
      asm volatile("ds_read2_b32 %0, %1 offset0:0 offset1:1" : "=v"(Y_.wlo[0]) : "v"(pabY_));  \
      asm volatile("ds_read2_b32 %0, %1 offset0:2 offset1:3" : "=v"(Y_.whi[0]) : "v"(pabY_));  \
      asm volatile("ds_read2_b32 %0, %1 offset0:8 offset1:9" : "=v"(Y_.wlo[1]) : "v"(pabY_));  \
      asm volatile("ds_read2_b32 %0, %1 offset0:10 offset1:11" : "=v"(Y_.whi[1]) : "v"(pabY_));  \
      asm volatile("ds_read2_b32 %0, %1 offset0:16 offset1:17" : "=v"(Y_.wlo[2]) : "v"(pabY_));  \
      asm volatile("ds_read2_b32 %0, %1 offset0:18 offset1:19" : "=v"(Y_.whi[2]) : "v"(pabY_));  \
      asm volatile("ds_read2_b32 %0, %1 offset0:24 offset1:25" : "=v"(Y_.wlo[3]) : "v"(pabY_));  \
      asm volatile("ds_read2_b32 %0, %1 offset0:26 offset1:27" : "=v"(Y_.whi[3]) : "v"(pabY_));  \
      asm volatile("ds_read2_b32 %0, %1 offset0:32 offset1:33" : "=v"(Y_.wlo[4]) : "v"(pabY_));  \
      asm volatile("ds_read2_b32 %0, %1 offset0:34 offset1:35" : "=v"(Y_.whi[4]) : "v"(pabY_));  \
      asm volatile("ds_read2_b32 %0, %1 offset0:40 offset1:41" : "=v"(Y_.wlo[5]) : "v"(pabY_));  \
      asm volatile("ds_read2_b32 %0, %1 offset0:42 offset1:43" : "=v"(Y_.whi[5]) : "v"(pabY_));  \
      asm volatile("ds_read_b128 %0, %1 offset:0" : "=v"(Y_.bv[0][0]) : "v"(pbY0_));  \
      asm volatile("ds_read_b128 %0, %1 offset:32" : "=v"(Y_.bv[0][1]) : "v"(pbY0_));  \
      asm volatile("ds_read_b128 %0, %1 offset:64" : "=v"(Y_.bv[0][2]) : "v"(pbY0_));  \
      asm volatile("ds_read_b128 %0, %1 offset:96" : "=v"(Y_.bv[0][3]) : "v"(pbY0_));  \
      asm volatile("ds_read_b128 %0, %1 offset:0" : "=v"(Y_.bv[1][0]) : "v"(pbY1_));  \
      asm volatile("ds_read_b128 %0, %1 offset:32" : "=v"(Y_.bv[1][1]) : "v"(pbY1_));  \
      asm volatile("ds_read_b128 %0, %1 offset:64" : "=v"(Y_.bv[1][2]) : "v"(pbY1_));  \
      asm volatile("ds_read_b128 %0, %1 offset:96" : "=v"(Y_.bv[1][3]) : "v"(pbY1_));  \
    }

#define HY_STEP(X_, Y_, dl_)                                          \
    {                                                                  \
      HY_PREP(Y_, dl_)                                                 \
      bf16x8 a[6];                                                     \
      _Pragma("unroll") for (int q = 0; q < 6; ++q) {                  \
        const u32x4 t = {X_.wlo[q][0], X_.wlo[q][1], X_.whi[q][0], X_.whi[q][1]}; \
        a[q] = __builtin_bit_cast(bf16x8, t);                          \
      }                                                                \
      {                                                                \
        u32x4 bq = X_.bv[0][0];                                        \
        const bf16x8 bb = __builtin_bit_cast(bf16x8, bq);              \
        __builtin_amdgcn_sched_barrier(0);                             \
        asm volatile("ds_read2_b32 %0, %1 offset0:0 offset1:1" : "=v"(Y_.wlo[0]) : "v"(pabY_));  \
        asm volatile("ds_read2_b32 %0, %1 offset0:2 offset1:3" : "=v"(Y_.whi[0]) : "v"(pabY_));  \
        __builtin_amdgcn_sched_barrier(0);                             \
        asm volatile("s_nop 1\n\tv_mfma_f32_32x32x16_bf16 %0, %1, %2, %0" : "+v"(acc[0][0]) : "v"(a[2]), "v"(bb)); \
        __builtin_amdgcn_sched_barrier(0);                             \
        asm volatile("ds_read2_b32 %0, %1 offset0:8 offset1:9" : "=v"(Y_.wlo[1]) : "v"(pabY_));  \
        asm volatile("ds_read2_b32 %0, %1 offset0:10 offset1:11" : "=v"(Y_.whi[1]) : "v"(pabY_));  \
        __builtin_amdgcn_sched_barrier(0);                             \
        asm volatile("s_nop 1\n\tv_mfma_f32_32x32x16_bf16 %0, %1, %2, %0" : "+v"(acc[0][1]) : "v"(a[0]), "v"(bb)); \
      }                                                                \
      {                                                                \
        u32x4 bq = X_.bv[0][1];                                        \
        const bf16x8 bb = __builtin_bit_cast(bf16x8, bq);              \
        __builtin_amdgcn_sched_barrier(0);                             \
        asm volatile("ds_read2_b32 %0, %1 offset0:16 offset1:17" : "=v"(Y_.wlo[2]) : "v"(pabY_));  \
        asm volatile("ds_read2_b32 %0, %1 offset0:18 offset1:19" : "=v"(Y_.whi[2]) : "v"(pabY_));  \
        __builtin_amdgcn_sched_barrier(0);                             \
        asm volatile("s_nop 1\n\tv_mfma_f32_32x32x16_bf16 %0, %1, %2, %0" : "+v"(acc[0][0]) : "v"(a[3]), "v"(bb)); \
        __builtin_amdgcn_sched_barrier(0);                             \
        asm volatile("ds_read2_b32 %0, %1 offset0:24 offset1:25" : "=v"(Y_.wlo[3]) : "v"(pabY_));  \
        asm volatile("ds_read2_b32 %0, %1 offset0:26 offset1:27" : "=v"(Y_.whi[3]) : "v"(pabY_));  \
        __builtin_amdgcn_sched_barrier(0);                             \
        asm volatile("s_nop 1\n\tv_mfma_f32_32x32x16_bf16 %0, %1, %2, %0" : "+v"(acc[0][1]) : "v"(a[1]), "v"(bb)); \
      }                                                                \
      {                                                                \
        u32x4 bq = X_.bv[0][2];                                        \
        const bf16x8 bb = __builtin_bit_cast(bf16x8, bq);              \
        __builtin_amdgcn_sched_barrier(0);                             \
        asm volatile("ds_read2_b32 %0, %1 offset0:32 offset1:33" : "=v"(Y_.wlo[4]) : "v"(pabY_));  \
        asm volatile("ds_read2_b32 %0, %1 offset0:34 offset1:35" : "=v"(Y_.whi[4]) : "v"(pabY_));  \
        __builtin_amdgcn_sched_barrier(0);                             \
        asm volatile("s_nop 1\n\tv_mfma_f32_32x32x16_bf16 %0, %1, %2, %0" : "+v"(acc[0][0]) : "v"(a[4]), "v"(bb)); \
        __builtin_amdgcn_sched_barrier(0);                             \
        asm volatile("ds_read2_b32 %0, %1 offset0:40 offset1:41" : "=v"(Y_.wlo[5]) : "v"(pabY_));  \
        asm volatile("ds_read2_b32 %0, %1 offset0:42 offset1:43" : "=v"(Y_.whi[5]) : "v"(pabY_));  \
        __builtin_amdgcn_sched_barrier(0);                             \
        asm volatile("s_nop 1\n\tv_mfma_f32_32x32x16_bf16 %0, %1, %2, %0" : "+v"(acc[0][1]) : "v"(a[2]), "v"(bb)); \
      }                                                                \
      {                                                                \
        u32x4 bq = X_.bv[0][3];                                        \
        const bf16x8 bb = __builtin_bit_cast(bf16x8, bq);              \
        __builtin_amdgcn_sched_barrier(0);                             \
        asm volatile("ds_read_b128 %0, %1 offset:0" : "=v"(Y_.bv[0][0]) : "v"(pbY0_));  \
        asm volatile("ds_read_b128 %0, %1 offset:32" : "=v"(Y_.bv[0][1]) : "v"(pbY0_));  \
        __builtin_amdgcn_sched_barrier(0);                             \
        asm volatile("s_nop 1\n\tv_mfma_f32_32x32x16_bf16 %0, %1, %2, %0" : "+v"(acc[0][0]) : "v"(a[5]), "v"(bb)); \
        __builtin_amdgcn_sched_barrier(0);                             \
        asm volatile("ds_read_b128 %0, %1 offset:64" : "=v"(Y_.bv[0][2]) : "v"(pbY0_));  \
        asm volatile("ds_read_b128 %0, %1 offset:96" : "=v"(Y_.bv[0][3]) : "v"(pbY0_));  \
        __builtin_amdgcn_sched_barrier(0);                             \
        asm volatile("s_nop 1\n\tv_mfma_f32_32x32x16_bf16 %0, %1, %2, %0" : "+v"(acc[0][1]) : "v"(a[3]), "v"(bb)); \
      }                                                                \
      {                                                                \
        u32x4 bq = X_.bv[1][0];                                        \
        const bf16x8 bb = __builtin_bit_cast(bf16x8, bq);              \
        __builtin_amdgcn_sched_barrier(0);                             \
        asm volatile("ds_read_b128 %0, %1 offset:0" : "=v"(Y_.bv[1][0]) : "v"(pbY1_));  \
        asm volatile("ds_read_b128 %0, %1 offset:32" : "=v"(Y_.bv[1][1]) : "v"(pbY1_));  \
        __builtin_amdgcn_sched_barrier(0);                             \
        asm volatile("s_nop 1\n\tv_mfma_f32_32x32x16_bf16 %0, %1, %2, %0" : "+v"(acc[1][0]) : "v"(a[2]), "v"(bb)); \
        __builtin_amdgcn_sched_barrier(0);                             \
        asm volatile("ds_read_b128 %0, %1 offset:64" : "=v"(Y_.bv[1][2]) : "v"(pbY1_));  \
        asm volatile("ds_read_b128 %0, %1 offset:96" : "=v"(Y_.bv[1][3]) : "v"(pbY1_));  \
        __builtin_amdgcn_sched_barrier(0);                             \
        asm volatile("s_nop 1\n\tv_mfma_f32_32x32x16_bf16 %0, %1, %2, %0" : "+v"(acc[1][1]) : "v"(a[0]), "v"(bb)); \
      }                                                                \
      {                                                                \
        u32x4 bq = X_.bv[1][1];                                        \
        const bf16x8 bb = __builtin_bit_cast(bf16x8, bq);              \
        __builtin_amdgcn_sched_barrier(0);                             \
        __builtin_amdgcn_sched_barrier(0);                             \
        asm volatile("s_nop 1\n\tv_mfma_f32_32x32x16_bf16 %0, %1, %2, %0" : "+v"(acc[1][0]) : "v"(a[3]), "v"(bb)); \
        __builtin_amdgcn_sched_barrier(0);                             \
        __builtin_amdgcn_sched_barrier(0);                             \
        asm volatile("s_nop 1\n\tv_mfma_f32_32x32x16_bf16 %0, %1, %2, %0" : "+v"(acc[1][1]) : "v"(a[1]), "v"(bb)); \
      }                                                                \
      {                                                                \
        u32x4 bq = X_.bv[1][2];                                        \
        const bf16x8 bb = __builtin_bit_cast(bf16x8, bq);              \
        __builtin_amdgcn_sched_barrier(0);                             \
        __builtin_amdgcn_sched_barrier(0);                             \
        asm volatile("s_nop 1\n\tv_mfma_f32_32x32x16_bf16 %0, %1, %2, %0" : "+v"(acc[1][0]) : "v"(a[4]), "v"(bb)); \
        __builtin_amdgcn_sched_barrier(0);                             \
        __builtin_amdgcn_sched_barrier(0);                             \
        asm volatile("s_nop 1\n\tv_mfma_f32_32x32x16_bf16 %0, %1, %2, %0" : "+v"(acc[1][1]) : "v"(a[2]), "v"(bb)); \
      }                                                                \
      {                                                                \
        u32x4 bq = X_.bv[1][3];                                        \
        const bf16x8 bb = __builtin_bit_cast(bf16x8, bq);              \
        __builtin_amdgcn_sched_barrier(0);                             \
        __builtin_amdgcn_sched_barrier(0);                             \
        asm volatile("s_nop 1\n\tv_mfma_f32_32x32x16_bf16 %0, %1, %2, %0" : "+v"(acc[1][0]) : "v"(a[5]), "v"(bb)); \
        __builtin_amdgcn_sched_barrier(0);                             \
        __builtin_amdgcn_sched_barrier(0);                             \
        asm volatile("s_nop 1\n\tv_mfma_f32_32x32x16_bf16 %0, %1, %2, %0" : "+v"(acc[1][1]) : "v"(a[3]), "v"(bb)); \
      }                                                                \
    }

#define HY_COMPUTE(X_)                                                \
    {                                                                  \
      bf16x8 a[6];                                                     \
      _Pragma("unroll") for (int q = 0; q < 6; ++q) {                  \
        const u32x4 t = {X_.wlo[q][0], X_.wlo[q][1], X_.whi[q][0], X_.whi[q][1]}; \
        a[q] = __builtin_bit_cast(bf16x8, t);                          \
      }                                                                \
      _Pragma("unroll") for (int nt = 0; nt < 2; ++nt) {               \
        _Pragma("unroll") for (int ks = 0; ks < 4; ++ks) {             \
          u32x4 bq = X_.bv[nt][ks];                                    \
          const bf16x8 bb = __builtin_bit_cast(bf16x8, bq);            \
          acc[nt][0] = __builtin_amdgcn_mfma_f32_32x32x16_bf16(a[ks + 2], bb, acc[nt][0], 0, 0, 0); \
          acc[nt][1] = __builtin_amdgcn_mfma_f32_32x32x16_bf16(a[ks], bb, acc[nt][1], 0, 0, 0);     \
        }                                                              \
      }                                                                \
    }
#define HY_WAIT(S_) asm volatile("s_waitcnt lgkmcnt(0)" : "+v"(S_.wlo[0]), "+v"(S_.whi[0]), "+v"(S_.wlo[1]), "+v"(S_.whi[1]), "+v"(S_.wlo[2]), "+v"(S_.whi[2]), "+v"(S_.wlo[3]), "+v"(S_.whi[3]), "+v"(S_.wlo[4]), "+v"(S_.whi[4]), "+v"(S_.wlo[5]), "+v"(S_.whi[5]), "+v"(S_.bv[0][0]), "+v"(S_.bv[0][1]), "+v"(S_.bv[0][2]), "+v"(S_.bv[0][3]), "+v"(S_.bv[1][0]), "+v"(S_.bv[1][1]), "+v"(S_.bv[1][2]), "+v"(S_.bv[1][3]) :: "memory")
    HySet s0, s1;
    HY_ISSUE0(s0, dlo);
    int dl = dlo;
    for (; dl + 1 <= dhi; dl += 2) {
      HY_WAIT(s0);
      HY_STEP(s0, s1, dl + 1);
      __builtin_amdgcn_sched_barrier(0);
      HY_WAIT(s1);
      {
        const int d2 = (dl + 2 <= dhi) ? dl + 2 : dhi;
        HY_STEP(s1, s0, d2);
      }
      __builtin_amdgcn_sched_barrier(0);
    }
    if (dl == dhi) {
      HY_WAIT(s0);
      HY_COMPUTE(s0);
    }
    asm volatile("s_waitcnt lgkmcnt(0)" ::: "memory");
#undef HY_PREP
#undef HY_ISSUE0
#undef HY_STEP
#undef HY_COMPUTE
#undef HY_WAIT
  }
  __syncthreads();
  {
    const float fbias = p.in[I_FBIAS][c];
#pragma unroll
    for (int nt = 0; nt < 2; ++nt)
#pragma unroll
      for (int mi = 0; mi < 2; ++mi)
#pragma unroll
        for (int rg = 0; rg < 4; ++rg) {
          const int col = colw + 32 * nt + n, i0 = 32 * mi + 8 * rg + 4 * hh;
          char* pv = Vl + col * VROW + i0 * 2;
          const uint2 w = *(const uint2*)pv;
          const float t0 = acc[nt][mi][4 * rg + 0] + bflo(w.x) * fbias;
          const float t1 = acc[nt][mi][4 * rg + 1] + bfhi(w.x) * fbias;
          const float t2 = acc[nt][mi][4 * rg + 2] + bflo(w.y) * fbias;
          const float t3 = acc[nt][mi][4 * rg + 3] + bfhi(w.y) * fbias;
          *(uint2*)pv = make_uint2(pack2(t0, t1), pack2(t2, t3));
        }
  }
  __syncthreads();
  {
    const float wx0_0 = cw[0 * 1536 + c], wx0_1 = cw[1 * 1536 + c], wx0_2 = cw[2 * 1536 + c], bx0 = cb[c];
    for (int e0 = tid; e0 < BG * L / 8; e0 += 256 * 4) {
      F8 x[4];
      uint4 y[4];
#pragma unroll
      for (int u = 0; u < 4; ++u) {
        const int e = e0 + 256 * u;
        const int bl = e / (L / 8), t = (e % (L / 8)) * 8;
        const int b = bgi * BG + bl;
        x[u] = conv8(UHY + ((size_t)b * 1536 + c) * L, t, L, wx0_0, wx0_1, wx0_2, bx0);
        y[u] = *(const uint4*)(Vl + ((t >> 6) * BG + bl) * VROW + (t & 63) * 2);
      }
#pragma unroll
      for (int u = 0; u < 4; ++u) {
        const int e = e0 + 256 * u;
        const int bl = e / (L / 8), t = (e % (L / 8)) * 8;
        const int b = bgi * BG + bl;
        *(uint4*)(UHY + ((size_t)b * 1536 + 1024 + c) * L + t) =
            make_uint4(pack2(bflo(y[u].x) * x[u].v[0], bfhi(y[u].x) * x[u].v[1]), pack2(bflo(y[u].y) * x[u].v[2], bfhi(y[u].y) * x[u].v[3]),
                       pack2(bflo(y[u].z) * x[u].v[4], bfhi(y[u].z) * x[u].v[5]), pack2(bflo(y[u].w) * x[u].v[6], bfhi(y[u].w) * x[u].v[7]));
      }
    }
  }
}

DEV void phase_p2_naive(const Params& p, int g, char* hsm) {
  __shared__ int s_item;
  const int nscan = g ? 128 : 256;
  const int nhy = 1024;
  unsigned* cnt = (unsigned*)(p.ws + OFF_CNT) + g;
  const int half = vhalf();
  if ((int)blockIdx.x * 2 < nscan) scan_item_mfma(p, g, blockIdx.x * 2 + half, hsm);
  for (;;) {
    __syncthreads();
    if (threadIdx.x == 0) s_item = (int)atomicAdd(cnt, 2u);
    __syncthreads();
    const int it = s_item + half;
    if (it >= nhy) break;
    if (g == 0) hyena_item_mfma<4>(p, g, it, hsm - half * HALF_BYTES, half);
    else hyena_item_mfma<2>(p, g, it, hsm - half * HALF_BYTES, half);
  }
  unsigned* cnt2 = (unsigned*)(p.ws + OFF_CNT) + 2 + g;
  const float* mod = (const float*)(p.ws + OFF_MOD);
  for (;;) {
    __syncthreads();
    if (threadIdx.x == 0) s_item = (int)atomicAdd(cnt2, 2u);
    __syncthreads();
    const int it = s_item + half;
    if (it >= 512) break;
    if (g == 0) norm_adaln_rows(p.in[I_XS], p.in[I_N1G], mod, 8, 8192, 0, 1024, (u16*)(p.out + (size_t)NTOK * D), it * 64);
    else final_norm_rows(p.out, p.in[I_FING], it * 64);
  }
}

DEV void phase_p2c(const Params& p, int g) {
  u16* PHG = (u16*)(p.ws + OFF_PHG);
  const float* gn = p.in[I_GNG];
  const int tid = tidx();
  const int wave = tid >> 6, lane = tid & 63;
  constexpr int RB = 4;
  const int stride = NVB * 4;
  const int c = lane * 8;
  for (int tok0 = VBID * 4 + wave; tok0 < NTOK; tok0 += stride * RB) {
    uint4 a[RB], bq[RB], og[RB];
#pragma unroll
    for (int j = 0; j < RB; ++j) {
      const int t_ = tok0 + j * stride;
      const size_t tok = (size_t)(t_ < NTOK ? t_ : tok0);
      a[j] = *(const uint4*)(PHG + tok * 2560 + c);
      bq[j] = *(const uint4*)(PHG + tok * 2560 + 1024 + c);
      og[j] = *(const uint4*)(PHG + tok * 2560 + 2048 + c);
    }
    const float4 g0 = *(const float4*)(gn + c), g1 = *(const float4*)(gn + c + 4);
#pragma unroll
    for (int j = 0; j < RB; ++j) {
      const int t_ = tok0 + j * stride;
      float o[8];
      o[0] = bflo(a[j].x) + bflo(bq[j].x); o[1] = bfhi(a[j].x) + bfhi(bq[j].x);
      o[2] = bflo(a[j].y) + bflo(bq[j].y); o[3] = bfhi(a[j].y) + bfhi(bq[j].y);
      o[4] = bflo(a[j].z) + bflo(bq[j].z); o[5] = bfhi(a[j].z) + bfhi(bq[j].z);
      o[6] = bflo(a[j].w) + bflo(bq[j].w); o[7] = bfhi(a[j].w) + bfhi(bq[j].w);
      float ss = 0.f;
#pragma unroll
      for (int i = 0; i < 8; ++i) ss += o[i] * o[i];
      ss += __shfl_xor(ss, 1);
      ss += __shfl_xor(ss, 2);
      ss += __shfl_xor(ss, 4);
      ss += __shfl_xor(ss, 8);
      const float rstd = rsqrtf(ss * (1.f / 128.f) + EPSF);
      const float y0 = o[0] * rstd * g0.x * bflo(og[j].x), y1 = o[1] * rstd * g0.y * bfhi(og[j].x);
      const float y2 = o[2] * rstd * g0.z * bflo(og[j].y), y3 = o[3] * rstd * g0.w * bfhi(og[j].y);
      const float y4 = o[4] * rstd * g1.x * bflo(og[j].z), y5 = o[5] * rstd * g1.y * bfhi(og[j].z);
      const float y6 = o[6] * rstd * g1.z * bflo(og[j].w), y7 = o[7] * rstd * g1.w * bfhi(og[j].w);
      if (t_ < NTOK)
        *(uint4*)(PHG + (size_t)t_ * 2560 + c) = make_uint4(pack2(y0, y1), pack2(y2, y3), pack2(y4, y5), pack2(y6, y7));
    }
  }
}

DEV void tile_order(int tile, int ntn, int& mt, int& nt) {
  const int grp = tile / (16 * ntn), rem = tile % (16 * ntn);
  mt = grp * 16 + (rem & 15);
  nt = rem >> 4;
}

DEV void phase_p3a(const Params& p, int g, char* smem) {
  const int L = g ? 8192 : 4096;
  u16* PHG = (u16*)(p.ws + OFF_PHG);
  const u16* GT = (const u16*)(p.ws + OFF_GT);
  const u16* UHY = (const u16*)(p.ws + OFF_UHY);
  const u16* WbrT = (const u16*)(p.ws + OFF_WBR);
  for (int iter = 0;; ++iter) {
    int mt, nt;
    if (!tile_map(iter, 128, 4, mt, nt)) break;
    const int m0 = mt * 256, n0 = nt * 256;
    Acc acc;
    acc_zero(acc);
    {
      TransLoader al{UHY, L};
      RowLoader bl{WbrT, 1024};
      gemm_mainloop(acc, al, bl, m0, n0, 0, 512, smem);
    }
    acc_foreach(acc, m0, n0, [&](int m, int n, float& v) {
      const float ga = bf2f(GT[(size_t)m * 2048 + n]);
      const float gb = bf2f(GT[(size_t)m * 2048 + 1024 + n]);
      v *= ga / fmaxf(gb, 1e-30f);
    });
    {
      RowLoader al{PHG - 512, 2560};
      RowLoader bl{WbrT, 1024};
      gemm_mainloop(acc, al, bl, m0, n0, 512, 1024, smem);
    }
    acc_foreach(acc, m0, n0, [&](int m, int n, float& v) {
      const float gb = bf2f(GT[(size_t)m * 2048 + 1024 + n]);
      PHG[(size_t)m * 2560 + 1024 + n] = f2bf(gb * v);
    });
  }
}

DEV void phase_p3b(const Params& p, int g, char* smem) {
  const int L = g ? 8192 : 4096;
  const int bg0 = g ? 8 : 0;
  const u16* PHG = (const u16*)(p.ws + OFF_PHG);
  const u16* WoutT = (const u16*)(p.ws + OFF_WOUT);
  const float* X = p.in[g ? I_XS : I_XP];
  const float* mod = (const float*)(p.ws + OFF_MOD);
  float* X1 = p.out + (size_t)g * NTOK * D;
  for (int iter = 0;; ++iter) {
    int mt, nt;
    if (!tile_map(iter, 128, 4, mt, nt)) break;
    const int m0 = mt * 256, n0 = nt * 256;
    Acc acc;
    acc_zero(acc);
    RowLoader al{PHG + 1024, 2560}, bl{WoutT, 1024};
    gemm_mainloop(acc, al, bl, m0, n0, 0, 1024, smem);
    const float* gt = mod + (size_t)(bg0 + m0 / L) * DIN + 2048;
    acc_foreach(acc, m0, n0, [&](int m, int n, float& v) {
      X1[(size_t)m * D + n] = X[(size_t)m * D + n] + gt[n] * v;
    });
  }
}

DEV void phase_ff1(const Params& p, int g, char* smem) {
  const u16* H2 = (const u16*)(p.ws + OFF_H2);
  const u16* W = (const u16*)(p.ws + OFF_WFF1);
  u16* AB = (u16*)(p.ws + OFF_ABUF);
  GemmPipe gp;
  gp.primed = false;
  for (int iter = 0;; ++iter) {
    int mt, nt, mtn, ntn;
    if (!tile_map(iter, 128, 16, mt, nt)) break;
    const bool more = tile_map(iter + 1, 128, 16, mtn, ntn);
    if (!more) { mtn = mt; ntn = nt; }
    const int m0 = mt * 256, n0 = nt * 256;
    Acc acc;
    acc_zero(acc);
    RowLoader al{H2, 1024}, bl{W, 1024};
    gemm_mainloop_p(acc, al, bl, m0, n0, mtn * 256, ntn * 256, 1024, smem, gp);
    gp.primed = more;
    acc_foreach(acc, m0, n0, [&](int m, int n, float& v) {
      const float r = fmaxf(v, 0.f);
      AB[(size_t)m * 4096 + n] = f2bf(r * r);
    });
  }
}

DEV void phase_ff2(const Params& p, int g, char* smem) {
  const int L = g ? 8192 : 4096;
  const int bg0 = g ? 8 : 0;
  const u16* AB = (const u16*)(p.ws + OFF_ABUF);
  const u16* W = (const u16*)(p.ws + OFF_WFF2);
  const float* mod = (const float*)(p.ws + OFF_MOD);
  float* X1 = p.out + (size_t)g * NTOK * D;
  for (int iter = 0;; ++iter) {
    int mt, nt;
    if (!tile_map(iter, 128, 4, mt, nt)) break;
    const int m0 = mt * 256, n0 = nt * 256;
    Acc acc;
    acc_zero(acc);
    RowLoader al{AB, 4096}, bl{W, 4096};
    gemm_mainloop(acc, al, bl, m0, n0, 0, 4096, smem);
    const float* gt = mod + (size_t)(bg0 + m0 / L) * DIN + 5120;
    acc_foreach(acc, m0, n0, [&](int m, int n, float& v) { X1[(size_t)m * D + n] += gt[n] * v; });
  }
}

__global__ void __launch_bounds__(512) mk(Params p) {
  cg::grid_group grid = cg::this_grid();
  __shared__ __attribute__((aligned(16))) char smem[SMEM_BYTES];
  __shared__ uint4 xb_words;
  if (threadIdx.x == 0) xb_words = make_uint4(0u, 0u, 0u, 0u);
  __syncthreads();
  const XcdBarrier xb = xcd_barrier_post((unsigned*)(p.ws + OFF_XBAR), (volatile LAS unsigned*)&xb_words);
  char* hsm = smem + vhalf() * HALF_BYTES;
  const float* mod = (const float*)(p.ws + OFF_MOD);
  phase_prep(p, hsm);
  phase_filter_mlp(p, hsm);
  xcd_barrier(xb);
  if (p.out == nullptr) grid.sync();
  phase_filter_norm(p, hsm);
  phase_norm_adaln(p.in[I_XP], p.in[I_N1G], mod, 0, 4096, 0, 1024, (u16*)p.out);
  xcd_barrier(xb);
#pragma unroll 1
  for (int gi = 0; gi < 2; ++gi) {
    int g = gi;
    asm volatile("" : "+s"(g));
    const int L = g ? 8192 : 4096;
    const int bg0 = g ? 8 : 0;
    float* OG = p.out + (size_t)g * NTOK * D;
    phase_p1(p, g, smem);
    xcd_barrier(xb);
    phase_p15(p, g);
    xcd_barrier(xb);
    phase_p2_naive(p, g, hsm);
    xcd_barrier(xb);
    phase_p2c(p, g);
    xcd_barrier(xb);
    phase_p3a(p, g, smem);
    xcd_barrier(xb);
    phase_p3b(p, g, smem);
    xcd_barrier(xb);
    phase_norm_adaln(OG, p.in[I_N2G], mod, bg0, L, 3072, 4096, (u16*)(p.ws + OFF_H2));
    xcd_barrier(xb);
    phase_ff1(p, g, smem);
    xcd_barrier(xb);
    phase_ff2(p, g, smem);
    xcd_barrier(xb);
  }
  phase_final_norm(p.out + (size_t)NTOK * D, p.in[I_FING]);
}

extern "C" void kernel_launch(void* const* d_in, const int* in_sizes, int n_in, void* d_out, int out_size,
                              void* d_ws, size_t ws_size, hipStream_t stream) {
  static int grid_blocks = 0;
  if (!grid_blocks) {
    int dev = 0, cus = 0, per_cu = 0;
    (void)hipGetDevice(&dev);
    (void)hipDeviceGetAttribute(&cus, hipDeviceAttributeMultiprocessorCount, dev);
    (void)hipOccupancyMaxActiveBlocksPerMultiprocessor(&per_cu, mk, 512, 0);
    if (per_cu > 1) per_cu = 1;
    if (per_cu < 1) per_cu = 1;
    grid_blocks = cus * per_cu;
  }
  if (ws_size < WS_NEED) fprintf(stderr, "workspace too small: %zu < %zu\n", ws_size, (size_t)WS_NEED);
  Params p{};
  for (int i = 0; i < 27; ++i) p.in[i] = (const float*)d_in[i];
  p.out = (float*)d_out;
  p.ws = (char*)d_ws;
  (void)hipMemsetAsync((char*)d_ws + OFF_XBAR, 0, 16384, stream);
  void* args[] = {&p};
  hipError_t e = hipLaunchCooperativeKernel((void*)mk, dim3(grid_blocks), dim3(512), args, 0, stream);
  if (e != hipSuccess) fprintf(stderr, "coop launch failed: %s (grid %d)\n", hipGetErrorString(e), grid_blocks);
}
```

```cpp
#include <hip/hip_runtime.h>
#include <hip/hip_cooperative_groups.h>
#include <cstdio>
namespace cg = cooperative_groups;

typedef unsigned short u16;
typedef __attribute__((ext_vector_type(8))) short bf16x8;
typedef __attribute__((ext_vector_type(16))) float f32x16;

#define DEV __device__ __forceinline__

constexpr int D = 1024;
constexpr int NTOK = 32768;
constexpr int DIN = 6144;
constexpr float EPSF = 1e-6f;

enum { I_XP = 0, I_XS, I_CP, I_CS, I_ADAW, I_ADAB, I_N1G, I_WIN, I_CONVW, I_CONVB, I_FW1, I_FB1, I_FW2, I_FB2,
       I_FW3, I_FB3, I_FWO, I_FFREQ, I_FBIAS, I_LB, I_GNG, I_WBR, I_WOUT, I_N2G, I_WFF1, I_WFF2, I_FING };

constexpr size_t OFF_WIN = 0;
constexpr size_t OFF_WBR = OFF_WIN + (size_t)6144 * 1024 * 2;
constexpr size_t OFF_WOUT = OFF_WBR + (size_t)1024 * 1024 * 2;
constexpr size_t OFF_WFF1 = OFF_WOUT + (size_t)1024 * 1024 * 2;
constexpr size_t OFF_WFF2 = OFF_WFF1 + (size_t)4096 * 1024 * 2;
constexpr size_t OFF_MOD = OFF_WFF2 + (size_t)4096 * 1024 * 2;
constexpr size_t OFF_CNT = OFF_MOD + (size_t)12 * 6144 * 4;
constexpr size_t OFF_XBAR = OFF_CNT + 256;
constexpr size_t OFF_PART = OFF_XBAR + 16384;
constexpr size_t OFF_KK = OFF_PART + (size_t)768 * 1024 * 4;
constexpr size_t OFF_DEC = OFF_KK + (size_t)512 * (8192 + 16384) * 2;
constexpr size_t OFF_KT = OFF_DEC + (size_t)2 * 512 * 512 * 4;
constexpr size_t OFF_P = OFF_KT + (size_t)512 * 2 * 512 * 64 * 2;
constexpr size_t OFF_UHY = OFF_P;
constexpr size_t OFF_PHG = OFF_UHY + (size_t)NTOK * 1536 * 2;
constexpr size_t OFF_GT = OFF_PHG + (size_t)NTOK * 2560 * 2;
constexpr size_t WS_NEED = OFF_GT + (size_t)NTOK * 2048 * 2;
constexpr size_t OFF_HRAW = OFF_P;
constexpr size_t OFF_ABUF = OFF_UHY;
constexpr size_t OFF_H2 = OFF_GT;

struct Params {
  const float* in[27];
  float* out;
  char* ws;
};

DEV unsigned pack2(float a, float b) {
  unsigned r;
  asm("s_nop 0\n\tv_cvt_pk_bf16_f32 %0, %1, %2" : "=v"(r) : "v"(a), "v"(b));
  return r;
}
DEV u16 f2bf(float f) { return (u16)(pack2(f, f) & 0xffffu); }
DEV float bf2f(u16 h) { return __uint_as_float(((unsigned)h) << 16); }
DEV float bflo(unsigned w) { return __uint_as_float(w << 16); }
DEV float bfhi(unsigned w) { return __uint_as_float(w & 0xffff0000u); }
DEV float silu_f(float x) { return x / (1.f + __expf(-x)); }
DEV float sigmoid_f(float x) { return __builtin_amdgcn_rcpf(1.f + __expf(-x)); }
DEV int tidx_full() {
  int t = threadIdx.x;
  asm volatile("" : "+v"(t));
  return t;
}
DEV int tidx() { return tidx_full() & 255; }
DEV int vhalf() { return __builtin_amdgcn_readfirstlane((int)(threadIdx.x >> 8)); }
#define VBID ((int)blockIdx.x * 2 + vhalf())
#define NVB ((int)gridDim.x * 2)
DEV float wave_sum(float v) {
#pragma unroll
  for (int o = 32; o > 0; o >>= 1) v += __shfl_xor(v, o);
  return v;
}

#define XB_TMO      128
#define XB_XCNT(j)  (256  + 64 * (j))
#define XB_XSUB(j)  (1280 + 64 * (j))
#define XB_XGEN(j)  (2304 + 64 * (j))
#define XB_TOP      3328
#define XB_TOPGEN   3392
#define XCD_BAR_WORDS 3456
#define XB_SPIN_CAP (1u << 18)
#define LAS __attribute__((address_space(3)))

__device__ __forceinline__ unsigned xb_ld(unsigned* p)              { return __hip_atomic_load(p, __ATOMIC_RELAXED, __HIP_MEMORY_SCOPE_AGENT); }
__device__ __forceinline__ unsigned xb_add(unsigned* p, unsigned v) { return __hip_atomic_fetch_add(p, v, __ATOMIC_RELAXED, __HIP_MEMORY_SCOPE_AGENT); }
__device__ __forceinline__ unsigned xb_xcc_id() { return (unsigned)__builtin_amdgcn_s_getreg((3 << 11) | 20) & 0xFu; }
#define XB_SPIN(cond, bar) do { unsigned _sp = 0; while (cond) { __builtin_amdgcn_s_sleep(1); \
    if ((++_sp & 255u) == 0u) { if (xb_ld(&(bar)[XB_TMO])) break; if (_sp > XB_SPIN_CAP) { atomicAdd(&(bar)[XB_TMO], 1u); break; } } } } while (0)

struct XcdBarrier {
    unsigned* bar; unsigned x;
    volatile LAS unsigned* st;
};

__device__ __forceinline__ XcdBarrier xcd_barrier_post(unsigned* bar, volatile LAS unsigned* st) {
    XcdBarrier b; b.bar = bar; b.x = xb_xcc_id(); b.st = st;
    if (threadIdx.x == 0) (void)xb_add(&bar[XB_XCNT(b.x)], 1u);
    return b;
}
__device__ __forceinline__ void xcd_barrier_complete(unsigned* bar, unsigned x, unsigned& nloc, unsigned& nx) {
    const unsigned G = gridDim.x * gridDim.y * gridDim.z;
    unsigned sum, cnt, mine, sp = 0u;
    for (;;) {
        sum = 0u; cnt = 0u; mine = 0u;
#pragma unroll
        for (unsigned j = 0; j < 16; ++j) { const unsigned c = xb_ld(&bar[XB_XCNT(j)]); sum += c; cnt += (c > 0u) ? 1u : 0u; mine = (j == x) ? c : mine; }
        if (sum == G) break;
        __builtin_amdgcn_s_sleep(1);
        if ((++sp & 255u) == 0u) { if (xb_ld(&bar[XB_TMO])) break; if (sp > XB_SPIN_CAP) { atomicAdd(&bar[XB_TMO], 1u); break; } }
    }
    nloc = mine > 0u ? mine : 1u; nx = cnt > 0u ? cnt : 1u;
}

__device__ __forceinline__ void xcd_barrier(const XcdBarrier& b) {
    asm volatile("s_waitcnt vmcnt(0)" ::: "memory");
    __syncthreads();
    if (threadIdx.x == 0) {
        unsigned* bar = b.bar;
        __builtin_amdgcn_s_waitcnt(0);
        unsigned nloc = b.st[0], nx = b.st[1];
        if (nloc == 0u) { xcd_barrier_complete(bar, b.x, nloc, nx); b.st[0] = nloc; b.st[1] = nx; }
        const unsigned old = xb_add(&bar[XB_XSUB(b.x)], 1u);
        const unsigned gen = old / nloc;
        if (old + 1u == (gen + 1u) * nloc) {
            __builtin_amdgcn_fence(__ATOMIC_RELEASE, "agent");
            asm volatile("s_waitcnt vmcnt(0)" ::: "memory");
            const unsigned og = xb_add(&bar[XB_TOP], 1u);
            const unsigned tg = og / nx;
            if (og + 1u == (tg + 1u) * nx) xb_add(&bar[XB_TOPGEN], 1u);
            else XB_SPIN(xb_ld(&bar[XB_TOPGEN]) == tg, bar);
            __builtin_amdgcn_fence(__ATOMIC_ACQUIRE, "agent");
            xb_add(&bar[XB_XGEN(b.x)], 1u);
            asm volatile("s_waitcnt vmcnt(0)" ::: "memory");
        } else {
            XB_SPIN(xb_ld(&bar[XB_XGEN(b.x)]) == gen, bar);
            __builtin_amdgcn_fence(__ATOMIC_ACQUIRE, "agent");
            asm volatile("s_waitcnt vmcnt(0)" ::: "memory");
        }
    }
    __syncthreads();
}


constexpr int BK = 64;
constexpr int LDSROW = 144;
constexpr int TILE_BYTES = 256 * LDSROW;
constexpr int HALF_BYTES = 76800;
constexpr int SMEM_BYTES = 2 * HALF_BYTES;

struct R4 { uint4 a, b, c, d; };

struct RowLoader {
  const u16* base;
  long ld;
  DEV R4 load(int tid, int r0, int k0) const {
    const int tr = tid >> 3, tc = tid & 7;
    const u16* p = base + (long)(r0 + tr) * ld + k0 + tc * 8;
    R4 r;
    r.a = *(const uint4*)(p);
    r.b = *(const uint4*)(p + 64 * ld);
    r.c = *(const uint4*)(p + 128 * ld);
    r.d = *(const uint4*)(p + 192 * ld);
    return r;
  }
  DEV void store(int tid, char* lds, const R4& r) const {
    const int tr = tid >> 3, tc = tid & 7;
    char* q = lds + tr * LDSROW + tc * 16;
    *(uint4*)(q) = r.a;
    *(uint4*)(q + 64 * LDSROW) = r.b;
    *(uint4*)(q + 128 * LDSROW) = r.c;
    *(uint4*)(q + 192 * LDSROW) = r.d;
  }
};

DEV void st8t(char* q, const uint4& v) {
  *(u16*)(q + 0 * LDSROW) = (u16)(v.x & 0xffff);
  *(u16*)(q + 1 * LDSROW) = (u16)(v.x >> 16);
  *(u16*)(q + 2 * LDSROW) = (u16)(v.y & 0xffff);
  *(u16*)(q + 3 * LDSROW) = (u16)(v.y >> 16);
  *(u16*)(q + 4 * LDSROW) = (u16)(v.z & 0xffff);
  *(u16*)(q + 5 * LDSROW) = (u16)(v.z >> 16);
  *(u16*)(q + 6 * LDSROW) = (u16)(v.w & 0xffff);
  *(u16*)(q + 7 * LDSROW) = (u16)(v.w >> 16);
}

struct TransLoader {
  const u16* U;
  int L;
  DEV R4 load(int tid, int m0, int k0) const {
    const int b = m0 / L, t0 = m0 - b * L;
    const int k = k0 + (tid & 63), tg = tid >> 6;
    const u16* p = U + ((long)(b * 1536 + 1024 + k)) * L + t0 + tg * 8;
    R4 r;
    r.a = *(const uint4*)(p);
    r.b = *(const uint4*)(p + 64);
    r.c = *(const uint4*)(p + 128);
    r.d = *(const uint4*)(p + 192);
    return r;
  }
  DEV void store(int tid, char* lds, const R4& r) const {
    const int kl = tid & 63, tg = tid >> 6;
    char* q = lds + (tg * 8) * LDSROW + kl * 2;
    st8t(q, r.a);
    st8t(q + 64 * LDSROW, r.b);
    st8t(q + 128 * LDSROW, r.c);
    st8t(q + 192 * LDSROW, r.d);
  }
};

typedef f32x16 Acc[4][2];

template <class AL, class BL>
DEV void gemm_ktile(Acc& acc, const char* A, const char* B, int wm, int wn, int lr, int lh, const AL& al, const BL& bl,
                    int tid, int m0, int n0, int knext, char* nxt, R4& ra, R4& rb) {
  bf16x8 a[2][4], b[2][2];
  const char* pa = A + (wm + lr) * LDSROW + lh * 16;
  const char* pb = B + (wn + lr) * LDSROW + lh * 16;
#pragma unroll
  for (int i = 0; i < 4; ++i) a[0][i] = *(const bf16x8*)(pa + 32 * i * LDSROW);
#pragma unroll
  for (int j = 0; j < 2; ++j) b[0][j] = *(const bf16x8*)(pb + 32 * j * LDSROW);
#pragma unroll
  for (int ks = 0; ks < 4; ++ks) {
    const int cur = ks & 1, nx = cur ^ 1;
    if (ks < 3) {
#pragma unroll
      for (int i = 0; i < 4; ++i) a[nx][i] = *(const bf16x8*)(pa + 32 * i * LDSROW + (ks + 1) * 32);
#pragma unroll
      for (int j = 0; j < 2; ++j) b[nx][j] = *(const bf16x8*)(pb + 32 * j * LDSROW + (ks + 1) * 32);
    }
    __builtin_amdgcn_sched_barrier(0);
#pragma unroll
    for (int i = 0; i < 4; ++i)
#pragma unroll
      for (int j = 0; j < 2; ++j)
        acc[i][j] = __builtin_amdgcn_mfma_f32_32x32x16_bf16(a[cur][i], b[cur][j], acc[i][j], 0, 0, 0);
    __builtin_amdgcn_sched_barrier(0);
    if (ks == 1) {
      al.store(tid, nxt, ra);
      bl.store(tid, nxt + TILE_BYTES, rb);
      __builtin_amdgcn_sched_barrier(0);
      ra = al.load(tid, m0, knext);
      rb = bl.load(tid, n0, knext);
      __builtin_amdgcn_sched_barrier(0);
    }
  }
}

template <class AL, class BL>
DEV void gemm_mainloop(Acc& acc, const AL& al, const BL& bl, int m0, int n0, int kbeg, int kend, char* lds) {
  const int tid = tidx_full();
  const int wave = tid >> 6, lane = tid & 63;
  const int wm = (wave >> 2) * 128, wn = (wave & 3) * 64;
  const int lr = lane & 31, lh = lane >> 5;
  const int nk = (kend - kbeg) / BK;
  R4 a0 = al.load(tid, m0, kbeg);
  R4 b0 = bl.load(tid, n0, kbeg);
  __syncthreads();
  al.store(tid, lds, a0);
  bl.store(tid, lds + TILE_BYTES, b0);
  a0 = al.load(tid, m0, kbeg + BK);
  b0 = bl.load(tid, n0, kbeg + BK);
  __syncthreads();
  for (int kt = 0; kt < nk; ++kt) {
    const char* cur = lds + (kt & 1) * 2 * TILE_BYTES;
    char* nxt = lds + ((kt + 1) & 1) * 2 * TILE_BYTES;
    const int t2 = (kt + 2 < nk) ? kt + 2 : nk - 1;
    __builtin_amdgcn_sched_barrier(0);
    gemm_ktile(acc, cur, cur + TILE_BYTES, wm, wn, lr, lh, al, bl, tid, m0, n0, kbeg + t2 * BK, nxt, a0, b0);
    __builtin_amdgcn_sched_barrier(0);
    __syncthreads();
  }
}

struct GemmPipe {
  R4 ra, rb;
  bool primed;
};
template <class AL, class BL>
DEV void gemm_mainloop_p(Acc& acc, const AL& al, const BL& bl, int m0, int n0, int m0n, int n0n, int K, char* lds,
                         GemmPipe& gp) {
  const int tid = tidx_full();
  const int wave = tid >> 6, lane = tid & 63;
  const int wm = (wave >> 2) * 128, wn = (wave & 3) * 64;
  const int lr = lane & 31, lh = lane >> 5;
  const int nk = K / BK;
  if (!gp.primed) {
    gp.ra = al.load(tid, m0, 0);
    gp.rb = bl.load(tid, n0, 0);
    __syncthreads();
    al.store(tid, lds, gp.ra);
    bl.store(tid, lds + TILE_BYTES, gp.rb);
    gp.ra = al.load(tid, m0, BK);
    gp.rb = bl.load(tid, n0, BK);
    __syncthreads();
  }
  for (int kt = 0; kt < nk; ++kt) {
    const char* cur = lds + (kt & 1) * 2 * TILE_BYTES;
    char* nxt = lds + ((kt + 1) & 1) * 2 * TILE_BYTES;
    const bool wrap = (kt + 2 >= nk);
    const int kk = (wrap ? kt + 2 - nk : kt + 2) * BK;
    const int mr = wrap ? m0n : m0, nr = wrap ? n0n : n0;
    __builtin_amdgcn_sched_barrier(0);
    gemm_ktile(acc, cur, cur + TILE_BYTES, wm, wn, lr, lh, al, bl, tid, mr, nr, kk, nxt, gp.ra, gp.rb);
    __builtin_amdgcn_sched_barrier(0);
    __syncthreads();
  }
}

DEV void acc_zero(Acc& acc) {
#pragma unroll
  for (int i = 0; i < 4; ++i)
#pragma unroll
    for (int j = 0; j < 2; ++j)
#pragma unroll
      for (int r = 0; r < 16; ++r) acc[i][j][r] = 0.f;
}

template <class F>
DEV void acc_foreach(Acc& acc, int m0, int n0, F f) {
  asm volatile("s_nop 7\n\ts_nop 7\n\ts_nop 3" ::: "memory");
  const int tid = tidx_full();
  const int wave = tid >> 6, lane = tid & 63;
  const int wm = (wave >> 2) * 128, wn = (wave & 3) * 64;
  const int lr = lane & 31, lh = lane >> 5;
#pragma unroll
  for (int i = 0; i < 4; ++i)
#pragma unroll
    for (int j = 0; j < 2; ++j)
#pragma unroll
      for (int r = 0; r < 16; ++r) {
        const int m = m0 + wm + 32 * i + (r & 3) + 8 * (r >> 2) + 4 * lh;
        const int n = n0 + wn + 32 * j + lr;
        float v = acc[i][j][r];
        f(m, n, v);
        acc[i][j][r] = v;
      }
}

DEV bool tile_map(int iter, int ntm, int ntn, int& mt, int& nt) {
  int PM = 0, PN = 0;
  if (ntn == 18) { PM = 16; PN = 2; }
  else if (ntn == 128) { PM = 2; PN = 16; }
  else if (ntn == 16 || ntn == 4) { PM = 8; PN = 4; }
  if (gridDim.x == 256 && PM > 0 && (ntm % PM) == 0) {
    const int xcd = blockIdx.x & 7, slot = blockIdx.x >> 3;
    const int nsn = ntn / PN, nsuper = (ntm / PM) * nsn;
    const int s_ = iter * 8 + xcd;
    if (s_ >= nsuper) return false;
    const int sm = s_ / nsn, sn = s_ - sm * nsn;
    mt = sm * PM + slot / PN;
    nt = sn * PN + slot % PN;
    return true;
  }
  const int tile = blockIdx.x + iter * gridDim.x;
  if (tile >= ntm * ntn) return false;
  mt = tile / ntn;
  nt = tile - mt * ntn;
  return true;
}

DEV void prep_transpose_tile(const float* __restrict__ W, int K, int N, u16* __restrict__ WT, int tile, char* smem) {
  u16(*T)[66] = (u16(*)[66])smem;
  const int ntn = N / 64;
  const int k0 = (tile / ntn) * 64, n0 = (tile % ntn) * 64;
  const int tid = tidx();
  const int kr = tid >> 4, nc = (tid & 15) * 4;
  __syncthreads();
#pragma unroll
  for (int i = 0; i < 4; ++i) {
    const int k = kr + 16 * i;
    const float4 v = *(const float4*)(W + (long)(k0 + k) * N + n0 + nc);
    T[nc + 0][k] = f2bf(v.x);
    T[nc + 1][k] = f2bf(v.y);
    T[nc + 2][k] = f2bf(v.z);
    T[nc + 3][k] = f2bf(v.w);
  }
  __syncthreads();
  const int n = tid >> 2, kc = (tid & 3) * 16;
  unsigned o[8];
#pragma unroll
  for (int i = 0; i < 8; ++i) o[i] = (unsigned)T[n][kc + 2 * i] | ((unsigned)T[n][kc + 2 * i + 1] << 16);
  uint4* dst = (uint4*)(WT + (long)(n0 + n) * K + k0 + kc);
  dst[0] = make_uint4(o[0], o[1], o[2], o[3]);
  dst[1] = make_uint4(o[4], o[5], o[6], o[7]);
}

DEV void prep_mod_item(const Params& p, int item, char* smem) {
  float* sc = (float*)smem;
  float* red = (float*)(smem + 12 * 1024 * 4);
  __syncthreads();
  const int tid = tidx();
  for (int e = tid; e < 12 * 1024; e += 256) {
    const int b = e >> 10, k = e & 1023;
    const float c = (b < 8) ? p.in[I_CP][b * 1024 + k] : p.in[I_CS][(b - 8) * 1024 + k];
    sc[e] = silu_f(c);
  }
  __syncthreads();
  const int col = tid & 31, kg = tid >> 5;
  const int j = item * 32 + col;
  float acc[12];
#pragma unroll
  for (int b = 0; b < 12; ++b) acc[b] = 0.f;
  const float* W = p.in[I_ADAW];
  for (int kk = 0; kk < 128; ++kk) {
    const int k = kg * 128 + kk;
    const float w = W[(long)k * DIN + j];
#pragma unroll
    for (int b = 0; b < 12; ++b) acc[b] += sc[b * 1024 + k] * w;
  }
#pragma unroll
  for (int b = 0; b < 12; ++b) red[(kg * 12 + b) * 32 + col] = acc[b];
  __syncthreads();
  for (int e = tid; e < 12 * 32; e += 256) {
    const int b = e >> 5, c = e & 31;
    float s = p.in[I_ADAB][item * 32 + c];
#pragma unroll
    for (int g = 0; g < 8; ++g) s += red[(g * 12 + b) * 32 + c];
    ((float*)(p.ws + OFF_MOD))[b * DIN + item * 32 + c] = s;
  }
}

DEV void phase_prep(const Params& p, char* smem) {
  if (blockIdx.x == 0 && threadIdx.x < 64) ((unsigned*)(p.ws + OFF_CNT))[threadIdx.x] = 0u;
  for (int it = VBID; it < 4096 + 192; it += NVB) {
    if (it < 1536) prep_transpose_tile(p.in[I_WIN], 1024, 6144, (u16*)(p.ws + OFF_WIN), it, smem);
    else if (it < 1792) prep_transpose_tile(p.in[I_WBR], 1024, 1024, (u16*)(p.ws + OFF_WBR), it - 1536, smem);
    else if (it < 2048) prep_transpose_tile(p.in[I_WOUT], 1024, 1024, (u16*)(p.ws + OFF_WOUT), it - 1792, smem);
    else if (it < 3072) prep_transpose_tile(p.in[I_WFF1], 1024, 4096, (u16*)(p.ws + OFF_WFF1), it - 2048, smem);
    else if (it < 4096) prep_transpose_tile(p.in[I_WFF2], 4096, 1024, (u16*)(p.ws + OFF_WFF2), it - 3072, smem);
    else prep_mod_item(p, it - 4096, smem);
  }
}

DEV void phase_filter_mlp(const Params& p, char* smem) {
  float* z = (float*)smem;
  float* h1 = z + 4 * 36;
  float* h2 = h1 + 256;
  float* h3 = h2 + 256;
  const float* w1 = p.in[I_FW1];
  const float* b1 = p.in[I_FB1];
  const float* w2 = p.in[I_FW2];
  const float* b2 = p.in[I_FB2];
  const float* w3 = p.in[I_FW3];
  const float* b3 = p.in[I_FB3];
  const float* wo = p.in[I_FWO];
  const float* fr = p.in[I_FFREQ];
  float* hraw = (float*)(p.ws + OFF_HRAW);
  float* part = (float*)(p.ws + OFF_PART);
  const int tid = tidx();
  for (int it = VBID; it < 768; it += NVB) {
    const int g = (it < 256) ? 0 : 1;
    const int L = g ? 8192 : 4096;
    const int tbase = (g ? (it - 256) : it) * 16;
    const long rowbase = g ? 4096 : 0;
    float psum[4] = {0.f, 0.f, 0.f, 0.f};
    for (int rnd = 0; rnd < 4; ++rnd) {
      const int t0 = tbase + rnd * 4;
      __syncthreads();
      if (tid < 4 * 33) {
        const int pp = tid / 33, f = tid % 33;
        const int t = t0 + pp;
        float val;
        if (f == 0) val = (float)t / (float)(L - 1);
        else {
          const int j = (f - 1) & 15;
          const float fb = 1e-4f + (float)j * ((15.0f - 1e-4f) / 15.0f);
          const float w = 6.283185307179586f * (float)t / (float)L;
          val = (f <= 16) ? cosf(fb * w) : -sinf(fb * w);
        }
        z[pp * 36 + f] = val;
      }
      __syncthreads();
      const int pp = tid >> 6, u = tid & 63;
      {
        float s = b1[u];
        for (int k = 0; k < 33; ++k) s += z[pp * 36 + k] * w1[k * 64 + u];
        h1[pp * 64 + u] = sinf(fr[u] * s);
      }
      __syncthreads();
      {
        float s = b2[u];
        for (int k = 0; k < 64; ++k) s += h1[pp * 64 + k] * w2[k * 64 + u];
        h2[pp * 64 + u] = sinf(fr[64 + u] * s);
      }
      __syncthreads();
      {
        float s = b3[u];
        for (int k = 0; k < 64; ++k) s += h2[pp * 64 + k] * w3[k * 64 + u];
        h3[pp * 64 + u] = sinf(fr[128 + u] * s);
      }
      __syncthreads();
      float acc[4][4];
#pragma unroll
      for (int a = 0; a < 4; ++a)
#pragma unroll
        for (int q = 0; q < 4; ++q) acc[a][q] = 0.f;
      for (int k = 0; k < 64; ++k) {
        float wv[4];
#pragma unroll
        for (int q = 0; q < 4; ++q) wv[q] = wo[k * 1024 + tid + 256 * q];
#pragma unroll
        for (int a = 0; a < 4; ++a) {
          const float hv = h3[a * 64 + k];
#pragma unroll
          for (int q = 0; q < 4; ++q) acc[a][q] += hv * wv[q];
        }
      }
#pragma unroll
      for (int q = 0; q < 4; ++q) {
        const int c = tid + 256 * q;
        const int ch = c & 511;
        const float mind = -3.0701134573253943f, maxd = -15.350567286626972f;
        const float delta = fabsf(mind + (float)ch * ((maxd - mind) / 511.0f));
#pragma unroll
        for (int a = 0; a < 4; ++a) {
          const int t = t0 + a;
          const float tt = (float)t / (float)(L - 1);
          const float val = acc[a][q] * __expf(-tt * delta);
          hraw[(rowbase + t) * 1024 + c] = val;
          if (!(c >= 512 && t == 0)) psum[q] += fabsf(val);
        }
      }
    }
#pragma unroll
    for (int q = 0; q < 4; ++q) part[(long)it * 1024 + tid + 256 * q] = psum[q];
  }
}

DEV void phase_filter_norm(const Params& p, char* smem) {
  float* Tf = (float*)smem;
  float* Tb = Tf + 64 * 65;
  float* red = Tb + 64 * 65;
  float* nrm = red + 256;
  const float* hraw = (const float*)(p.ws + OFF_HRAW);
  const float* part = (const float*)(p.ws + OFF_PART);
  const int tid = tidx();
  for (int it = VBID; it < 512 + 1024; it += NVB) {
    const int g = (it < 512) ? 0 : 1;
    const int L = g ? 8192 : 4096;
    const int li = g ? it - 512 : it;
    const int ntt = L / 64;
    const int ct = li / ntt, tt = li % ntt;
    const long rowbase = g ? 4096 : 0;
    const int prow0 = g ? 256 : 0, nprow = g ? 512 : 256;
    u16* KK = (u16*)(p.ws + OFF_KK) + (g ? (size_t)512 * 8192 : 0);
    __syncthreads();
    {
      const int c = tid & 63, ph = tid >> 6;
      float s = 0.f;
      for (int r = ph; r < nprow; r += 4) {
        s += part[(long)(prow0 + r) * 1024 + ct * 64 + c];
        s += part[(long)(prow0 + r) * 1024 + 512 + ct * 64 + c];
      }
      red[ph * 64 + c] = s;
#pragma unroll
      for (int i = 0; i < 16; ++i) {
        const int r = ph + 4 * i;
        const long row = rowbase + tt * 64 + r;
        Tf[c * 65 + r] = hraw[row * 1024 + ct * 64 + c];
        Tb[c * 65 + r] = hraw[row * 1024 + 512 + ct * 64 + c];
      }
    }
    __syncthreads();
    if (tid < 64) nrm[tid] = red[tid] + red[64 + tid] + red[128 + tid] + red[192 + tid] + EPSF;
    __syncthreads();
    {
      const int c = tid >> 2, rq = (tid & 3) * 16;
      const float inv = 1.f / nrm[c];
      u16* row = KK + (size_t)(ct * 64 + c) * (2 * L);
#pragma unroll
      for (int i = 0; i < 16; ++i) {
        const int r = rq + i;
        const int t = tt * 64 + r;
        row[L - t] = f2bf(Tf[c * 65 + r] * inv);
        if (t >= 1) row[L + t] = f2bf(Tb[c * 65 + r] * inv);
      }
      if (tt == 0 && (tid & 3) == 0) row[0] = 0;
    }
  }
}

DEV void phase_norm_adaln(const float* __restrict__ X, const float* __restrict__ gvec, const float* __restrict__ mod,
                          int bg0, int L, int sh_off, int sc_off, u16* __restrict__ H) {
  const int tid = tidx();
  const int wave = tid >> 6, lane = tid & 63;
  constexpr int RB = 4;
  const int stride = NVB * 4;
  for (int row0 = VBID * 4 + wave; row0 < NTOK; row0 += stride * RB) {
    float4 v[RB][4];
    float ss[RB];
#pragma unroll
    for (int j = 0; j < RB; ++j) {
      const int row = row0 + j * stride;
      const float* x = X + (long)(row < NTOK ? row : row0) * D;
#pragma unroll
      for (int i = 0; i < 4; ++i) v[j][i] = *(const float4*)(x + lane * 4 + 256 * i);
    }
#pragma unroll
    for (int j = 0; j < RB; ++j) {
      float t = 0.f;
#pragma unroll
      for (int i = 0; i < 4; ++i) t += v[j][i].x * v[j][i].x + v[j][i].y * v[j][i].y + v[j][i].z * v[j][i].z + v[j][i].w * v[j][i].w;
      ss[j] = wave_sum(t);
    }
#pragma unroll
    for (int j = 0; j < RB; ++j) {
      const int row = row0 + j * stride;
      if (row < NTOK) {
        const float rstd = rsqrtf(ss[j] * (1.f / 1024.f) + EPSF);
        const float* mrow = mod + (long)(bg0 + row / L) * DIN;
#pragma unroll
        for (int i = 0; i < 4; ++i) {
          const int k = lane * 4 + 256 * i;
          const float4 g = *(const float4*)(gvec + k);
          const float4 sc = *(const float4*)(mrow + sc_off + k);
          const float4 sh = *(const float4*)(mrow + sh_off + k);
          const float o0 = v[j][i].x * rstd * g.x * (1.f + sc.x) + sh.x;
          const float o1 = v[j][i].y * rstd * g.y * (1.f + sc.y) + sh.y;
          const float o2 = v[j][i].z * rstd * g.z * (1.f + sc.z) + sh.z;
          const float o3 = v[j][i].w * rstd * g.w * (1.f + sc.w) + sh.w;
          *(uint2*)(H + (long)row * D + k) = make_uint2(pack2(o0, o1), pack2(o2, o3));
        }
      }
    }
  }
}

DEV void phase_final_norm(float* __restrict__ X, const float* __restrict__ gvec) {
  const int tid = tidx();
  const int wave = tid >> 6, lane = tid & 63;
  constexpr int RB = 4;
  const int stride = NVB * 4;
  for (int row0 = VBID * 4 + wave; row0 < NTOK; row0 += stride * RB) {
    float4 v[RB][4];
    float ss[RB];
#pragma unroll
    for (int j = 0; j < RB; ++j) {
      const int row = row0 + j * stride;
      const float* x = X + (long)(row < NTOK ? row : row0) * D;
#pragma unroll
      for (int i = 0; i < 4; ++i) v[j][i] = *(const float4*)(x + lane * 4 + 256 * i);
    }
#pragma unroll
    for (int j = 0; j < RB; ++j) {
      float t = 0.f;
#pragma unroll
      for (int i = 0; i < 4; ++i) t += v[j][i].x * v[j][i].x + v[j][i].y * v[j][i].y + v[j][i].z * v[j][i].z + v[j][i].w * v[j][i].w;
      ss[j] = wave_sum(t);
    }
#pragma unroll
    for (int j = 0; j < RB; ++j) {
      const int row = row0 + j * stride;
      if (row < NTOK) {
        const float rstd = rsqrtf(ss[j] * (1.f / 1024.f) + EPSF);
        float* x = X + (long)row * D;
#pragma unroll
        for (int i = 0; i < 4; ++i) {
          const int k = lane * 4 + 256 * i;
          const float4 g = *(const float4*)(gvec + k);
          *(float4*)(x + k) = make_float4(v[j][i].x * rstd * g.x, v[j][i].y * rstd * g.y, v[j][i].z * rstd * g.z, v[j][i].w * rstd * g.w);
        }
      }
    }
  }
}

DEV void norm_adaln_rows(const float* __restrict__ X, const float* __restrict__ gvec, const float* __restrict__ mod,
                         int bg0, int L, int sh_off, int sc_off, u16* __restrict__ H, int rbeg) {
  const int tid = tidx();
  const int wave = tid >> 6, lane = tid & 63;
  for (int jb = 0; jb < 16; jb += 4) {
    float4 v[4][4];
    float ss[4];
#pragma unroll
    for (int j = 0; j < 4; ++j) {
      const float* x = X + (long)(rbeg + wave + 4 * (jb + j)) * D;
#pragma unroll
      for (int i = 0; i < 4; ++i) v[j][i] = *(const float4*)(x + lane * 4 + 256 * i);
    }
#pragma unroll
    for (int j = 0; j < 4; ++j) {
      float t = 0.f;
#pragma unroll
      for (int i = 0; i < 4; ++i) t += v[j][i].x * v[j][i].x + v[j][i].y * v[j][i].y + v[j][i].z * v[j][i].z + v[j][i].w * v[j][i].w;
      ss[j] = wave_sum(t);
    }
#pragma unroll
    for (int j = 0; j < 4; ++j) {
      const int row = rbeg + wave + 4 * (jb + j);
      const float rstd = rsqrtf(ss[j] * (1.f / 1024.f) + EPSF);
      const float* mrow = mod + (long)(bg0 + row / L) * DIN;
#pragma unroll
      for (int i = 0; i < 4; ++i) {
        const int k = lane * 4 + 256 * i;
        const float4 g = *(const float4*)(gvec + k);
        const float4 sc = *(const float4*)(mrow + sc_off + k);
        const float4 sh = *(const float4*)(mrow + sh_off + k);
        const float o0 = v[j][i].x * rstd * g.x * (1.f + sc.x) + sh.x;
        const float o1 = v[j][i].y * rstd * g.y * (1.f + sc.y) + sh.y;
        const float o2 = v[j][i].z * rstd * g.z * (1.f + sc.z) + sh.z;
        const float o3 = v[j][i].w * rstd * g.w * (1.f + sc.w) + sh.w;
        *(uint2*)(H + (long)row * D + k) = make_uint2(pack2(o0, o1), pack2(o2, o3));
      }
    }
  }
}

DEV void final_norm_rows(float* __restrict__ X, const float* __restrict__ gvec, int rbeg) {
  const int tid = tidx();
  const int wave = tid >> 6, lane = tid & 63;
  for (int jb = 0; jb < 16; jb += 4) {
    float4 v[4][4];
    float ss[4];
#pragma unroll
    for (int j = 0; j < 4; ++j) {
      const float* x = X + (long)(rbeg + wave + 4 * (jb + j)) * D;
#pragma unroll
      for (int i = 0; i < 4; ++i) v[j][i] = *(const float4*)(x + lane * 4 + 256 * i);
    }
#pragma unroll
    for (int j = 0; j < 4; ++j) {
      float t = 0.f;
#pragma unroll
      for (int i = 0; i < 4; ++i) t += v[j][i].x * v[j][i].x + v[j][i].y * v[j][i].y + v[j][i].z * v[j][i].z + v[j][i].w * v[j][i].w;
      ss[j] = wave_sum(t);
    }
#pragma unroll
    for (int j = 0; j < 4; ++j) {
      float* x = X + (long)(rbeg + wave + 4 * (jb + j)) * D;
      const float rstd = rsqrtf(ss[j] * (1.f / 1024.f) + EPSF);
#pragma unroll
      for (int i = 0; i < 4; ++i) {
        const int k = lane * 4 + 256 * i;
        const float4 g = *(const float4*)(gvec + k);
        *(float4*)(x + k) = make_float4(v[j][i].x * rstd * g.x, v[j][i].y * rstd * g.y, v[j][i].z * rstd * g.z, v[j][i].w * rstd * g.w);
      }
    }
  }
}

DEV void phase_p1(const Params& p, int g, char* smem) {
  const int L = g ? 8192 : 4096;
  const u16* H = (const u16*)(p.out + (size_t)g * NTOK * D);
  const u16* WinT = (const u16*)(p.ws + OFF_WIN);
  u16* PHG = (u16*)(p.ws + OFF_PHG);
  u16* GT = (u16*)(p.ws + OFF_GT);
  u16* UHY = (u16*)(p.ws + OFF_UHY);
  {
    GemmPipe gp;
    gp.primed = false;
    for (int iter = 0;; ++iter) {
      int mt, nt, mtn, ntn;
      if (!tile_map(iter, 128, 18, mt, nt)) break;
      const bool more = tile_map(iter + 1, 128, 18, mtn, ntn);
      if (!more) { mtn = mt; ntn = nt; }
      Acc acc;
      acc_zero(acc);
      const int m0 = mt * 256, n0 = nt * 256;
      RowLoader al{H, 1024}, bl{WinT + (size_t)1536 * 1024, 1024};
      gemm_mainloop_p(acc, al, bl, m0, n0, mtn * 256, ntn * 256, 1024, smem, gp);
      gp.primed = more;
      if (n0 < 2560) {
        const bool dosilu = (n0 < 512) || (n0 >= 2048);
        acc_foreach(acc, m0, n0, [&](int m, int n, float& v) {
          const float o = dosilu ? silu_f(v) : v;
          PHG[(size_t)m * 2560 + n] = f2bf(o);
        });
      } else {
        acc_foreach(acc, m0, n0, [&](int m, int n, float& v) { GT[(size_t)m * 2048 + (n - 2560)] = f2bf(sigmoid_f(v)); });
      }
    }
  }
  {
    GemmPipe gp;
    gp.primed = false;
    for (int iter = 0;; ++iter) {
      int cm, tn, cmn, tnn;
      if (!tile_map(iter, 6, 128, cm, tn)) break;
      const bool more = tile_map(iter + 1, 6, 128, cmn, tnn);
      if (!more) { cmn = cm; tnn = tn; }
      Acc acc;
      acc_zero(acc);
      const int m0 = cm * 256, n0 = tn * 256;
      RowLoader al{WinT, 1024}, bl{H, 1024};
      gemm_mainloop_p(acc, al, bl, m0, n0, cmn * 256, tnn * 256, 1024, smem, gp);
      gp.primed = more;
      const int b = n0 / L, tb = n0 - b * L;
      u16* dst = UHY + (size_t)b * 1536 * L + tb - n0;
      acc_foreach(acc, m0, n0, [&](int m, int n, float& v) { dst[(size_t)m * L + n] = f2bf(v); });
    }
  }
}

DEV void phase_p15(const Params& p, int g) {
  const u16* PHG = (const u16*)(p.ws + OFF_PHG);
  u16* QK = (u16*)(p.out + (size_t)g * NTOK * D);
  u16* KT = (u16*)(p.ws + OFF_KT);
  float* DEC = (float*)(p.ws + OFF_DEC);
  for (int it = VBID; it < 1024; it += NVB) {
    const int tid = tidx();
    const int cidx = it >> 1, dir = it & 1;
    u16* Qp = QK + (size_t)(2 * dir) * NTOK * 512;
    u16* Kp = Qp + (size_t)NTOK * 512;
    float lb[2], G[2];
#pragma unroll
    for (int cc = 0; cc < 2; ++cc) {
      const int c = tid + 256 * cc;
      const float a0 = p.in[I_LB][(0 * 2 + dir) * 512 + c];
      const float a1 = p.in[I_LB][(1 * 2 + dir) * 512 + c];
      lb[cc] = 1.f / (1.f + __expf(a1 - a0));
      G[cc] = 0.f;
    }
    u16 xr[3][2][8], qr[3][2][8];
#define P15_LOAD(st_, j8_)                                                          \
    _Pragma("unroll") for (int e = 0; e < 8; ++e) {                                 \
      const int jj = (j8_) * 8 + e;                                                 \
      const int j = dir ? 63 - jj : jj;                                             \
      const size_t tok = (size_t)cidx * 64 + j;                                     \
      _Pragma("unroll") for (int cc = 0; cc < 2; ++cc) {                            \
        xr[st_][cc][e] = PHG[tok * 2560 + 1024 + 512 * dir + tid + 256 * cc];       \
        qr[st_][cc][e] = PHG[tok * 2560 + tid + 256 * cc];                          \
      }                                                                             \
    }
    P15_LOAD(0, 0);
    P15_LOAD(1, 1);
#pragma unroll
    for (int j8 = 0; j8 < 8; ++j8) {
      const int st = j8 % 3;
      if (j8 < 6) { P15_LOAD((j8 + 2) % 3, j8 + 2); }
#pragma unroll
      for (int cc = 0; cc < 2; ++cc) {
        const int c = tid + 256 * cc;
        unsigned kb[8];
#pragma unroll
        for (int e = 0; e < 8; ++e) {
          const int jj = j8 * 8 + e;
          const int j = dir ? 63 - jj : jj;
          const size_t tok = (size_t)cidx * 64 + j;
          const float f = lb[cc] + (1.f - lb[cc]) * sigmoid_f(bf2f(xr[st][cc][e]));
          G[cc] += __logf(f);
          const float eg = __expf(G[cc]), ig = __expf(-G[cc]);
          Qp[tok * 512 + c] = f2bf(bf2f(qr[st][cc][e]) * eg);
          const u16 kk = f2bf((1.f - f) * ig);
          Kp[tok * 512 + c] = kk;
          kb[e] = kk;
        }
        const int s0 = dir ? 56 - 8 * j8 : 8 * j8;
        uint4 w;
        w.x = dir ? (kb[7] | (kb[6] << 16)) : (kb[0] | (kb[1] << 16));
        w.y = dir ? (kb[5] | (kb[4] << 16)) : (kb[2] | (kb[3] << 16));
        w.z = dir ? (kb[3] | (kb[2] << 16)) : (kb[4] | (kb[5] << 16));
        w.w = dir ? (kb[1] | (kb[0] << 16)) : (kb[6] | (kb[7] << 16));
        *(uint4*)(KT + (((size_t)cidx * 2 + dir) * 512 + c) * 64 + s0) = w;
      }
    }
#undef P15_LOAD
#pragma unroll
    for (int cc = 0; cc < 2; ++cc) DEC[((size_t)dir * 512 + cidx) * 512 + tid + 256 * cc] = __expf(G[cc]);
  }
}

DEV void scan_item_mfma(const Params& p, int g, int item, char* smem) {
  const int L = g ? 8192 : 4096;
  const int NC = L / 64;
  const int vs = item & 3, dir = (item >> 2) & 1, h = (item >> 3) & 3, b = item >> 5;
  char* Qs = smem;
  char* Ks = Qs + 17408;
  char* KTs = Ks + 17408;
  char* Vts = KTs + 18432;
  char* Ps = Vts + 4608;
  char* Sts = Ps + 9216;
  float* decs = (float*)(Sts + 8704);
  u16* PHG = (u16*)(p.ws + OFF_PHG);
  const u16* QK = (const u16*)(p.out + (size_t)g * NTOK * D);
  const u16* Qp = QK + (size_t)(2 * dir) * NTOK * 512;
  const u16* Kp = Qp + (size_t)NTOK * 512;
  const u16* KT = (const u16*)(p.ws + OFF_KT);
  const float* DEC = (const float*)(p.ws + OFF_DEC);
  const int tid = tidx();
  const int wave = __builtin_amdgcn_readfirstlane(tid >> 6);
  const int lane = tid & 63, r = lane & 31, hh = lane >> 5;
  __syncthreads();
  for (int e = tid; e < 8704 / 16; e += 256) ((uint4*)Sts)[e] = make_uint4(0, 0, 0, 0);
  f32x16 accS[2];
#pragma unroll
  for (int t = 0; t < 2; ++t)
#pragma unroll
    for (int i = 0; i < 16; ++i) accS[t][i] = 0.f;
  const int ocol = (dir ? 1024 : 0) + h * 128 + vs * 32;

  uint4 q0, q1, q2, q3, k0, k1, k2, k3, t0, t1, t2, t3, vv;
  float dd = 0.f;
  const int qrow = tid >> 4, qc = tid & 15;
  const int trow = tid >> 3, tc = tid & 7;
  const int vrow = tid >> 2, vc = tid & 3;
#define SCAN_ISSUE(n_)                                                                                   \
  {                                                                                                      \
    const size_t cidx_ = (size_t)b * NC + (n_);                                                          \
    const size_t tok_ = cidx_ * 64;                                                                      \
    const u16* gq = Qp + (tok_ + qrow) * 512 + h * 128 + qc * 8;                                         \
    const u16* gk = Kp + (tok_ + qrow) * 512 + h * 128 + qc * 8;                                         \
    q0 = *(const uint4*)(gq); q1 = *(const uint4*)(gq + 16 * 512);                                       \
    q2 = *(const uint4*)(gq + 32 * 512); q3 = *(const uint4*)(gq + 48 * 512);                            \
    k0 = *(const uint4*)(gk); k1 = *(const uint4*)(gk + 16 * 512);                                       \
    k2 = *(const uint4*)(gk + 32 * 512); k3 = *(const uint4*)(gk + 48 * 512);                            \
    const u16* gt = KT + ((cidx_ * 2 + dir) * 512 + h * 128 + trow) * 64 + tc * 8;                       \
    t0 = *(const uint4*)(gt); t1 = *(const uint4*)(gt + 32 * 64);                                        \
    t2 = *(const uint4*)(gt + 64 * 64); t3 = *(const uint4*)(gt + 96 * 64);                              \
    vv = *(const uint4*)(PHG + (tok_ + vrow) * 2560 + 512 + h * 128 + vs * 32 + vc * 8);                 \
    dd = DEC[((size_t)dir * 512 + cidx_) * 512 + h * 128 + (tid & 127)];                                 \
  }
#define SCAN_BAR()                                        \
  {                                                       \
    asm volatile("s_waitcnt lgkmcnt(0)" ::: "memory");     \
    __builtin_amdgcn_s_barrier();                         \
    asm volatile("" ::: "memory");                         \
  }
  unsigned opk[8] = {0u, 0u, 0u, 0u, 0u, 0u, 0u, 0u};
  size_t otok = 0;
  SCAN_ISSUE(dir ? NC - 1 : 0);
  for (int ci = 0; ci < NC; ++ci) {
    const int n = dir ? NC - 1 - ci : ci;
    const size_t tok0 = ((size_t)b * NC + n) * 64;
    {
      char* d = Qs + qrow * 272 + qc * 16;
      *(uint4*)(d) = q0; *(uint4*)(d + 16 * 272) = q1; *(uint4*)(d + 32 * 272) = q2; *(uint4*)(d + 48 * 272) = q3;
      d = Ks + qrow * 272 + qc * 16;
      *(uint4*)(d) = k0; *(uint4*)(d + 16 * 272) = k1; *(uint4*)(d + 32 * 272) = k2; *(uint4*)(d + 48 * 272) = k3;
      d = KTs + trow * 144 + tc * 16;
      *(uint4*)(d) = t0; *(uint4*)(d + 32 * 144) = t1; *(uint4*)(d + 64 * 144) = t2; *(uint4*)(d + 96 * 144) = t3;
      st8t(Vts + (vc * 8) * 144 + vrow * 2, vv);
      if (tid < 128) decs[tid] = dd;
      if (wave < 2 && ci > 0) {
        u16* og = PHG + (otok + 32 * wave + 4 * hh) * 2560 + ocol + r;
#pragma unroll
        for (int i = 0; i < 8; ++i) {
          og[(size_t)(((2 * i) & 3) + 8 * ((2 * i) >> 2)) * 2560] = (u16)(opk[i] & 0xffffu);
          og[(size_t)(((2 * i + 1) & 3) + 8 * ((2 * i + 1) >> 2)) * 2560] = (u16)(opk[i] >> 16);
        }
      }
      if (wave >= 2 && ci > 0) {
#pragma unroll
        for (int t = 0; t < 2; ++t) {
          const int kt = 2 * (wave - 2) + t;
#pragma unroll
          for (int rg = 0; rg < 4; ++rg) {
            const int kk0 = 32 * kt + 8 * rg + 4 * hh;
            *(uint2*)(Sts + r * 272 + kk0 * 2) = make_uint2(pack2(accS[t][4 * rg + 0], accS[t][4 * rg + 1]),
                                                            pack2(accS[t][4 * rg + 2], accS[t][4 * rg + 3]));
          }
        }
      }
    }
    SCAN_BAR();
    {
      const int nn = (ci + 1 < NC) ? (dir ? NC - 2 - ci : ci + 1) : n;
      SCAN_ISSUE(nn);
    }
    __builtin_amdgcn_sched_barrier(0);
    {
      const int jt = wave >> 1, st = wave & 1;
      const bool active = dir ? (st >= jt) : (st <= jt);
      f32x16 pa;
#pragma unroll
      for (int i = 0; i < 16; ++i) pa[i] = 0.f;
      if (active) {
        bf16x8 qa[8], kb[8];
#pragma unroll
        for (int ks = 0; ks < 8; ++ks) {
          qa[ks] = *(const bf16x8*)(Qs + (32 * jt + r) * 272 + ks * 32 + hh * 16);
          kb[ks] = *(const bf16x8*)(Ks + (32 * st + r) * 272 + ks * 32 + hh * 16);
        }
        __builtin_amdgcn_sched_barrier(0);
        f32x16 p1;
#pragma unroll
        for (int i = 0; i < 16; ++i) p1[i] = 0.f;
#pragma unroll
        for (int ks = 0; ks < 4; ++ks) {
          pa = __builtin_amdgcn_mfma_f32_32x32x16_bf16(qa[2 * ks], kb[2 * ks], pa, 0, 0, 0);
          p1 = __builtin_amdgcn_mfma_f32_32x32x16_bf16(qa[2 * ks + 1], kb[2 * ks + 1], p1, 0, 0, 0);
        }
#pragma unroll
        for (int i = 0; i < 16; ++i) pa[i] += p1[i];
      }
#pragma unroll
      for (int i = 0; i < 16; ++i) {
        const int j = 32 * jt + (i & 3) + 8 * (i >> 2) + 4 * hh;
        const int s_ = 32 * st + r;
        const bool keep = dir ? (s_ >= j) : (s_ <= j);
        *(u16*)(Ps + j * 144 + s_ * 2) = keep ? f2bf(pa[i]) : (u16)0;
      }
    }
    SCAN_BAR();
    if (wave < 2) {
      const int jt = wave;
      bf16x8 pp[4], vb[4], qa[4], sb[4];
#pragma unroll
      for (int ks = 0; ks < 4; ++ks) {
        pp[ks] = *(const bf16x8*)(Ps + (32 * jt + r) * 144 + ks * 32 + hh * 16);
        vb[ks] = *(const bf16x8*)(Vts + r * 144 + ks * 32 + hh * 16);
        qa[ks] = *(const bf16x8*)(Qs + (32 * jt + r) * 272 + ks * 32 + hh * 16);
        sb[ks] = *(const bf16x8*)(Sts + r * 272 + ks * 32 + hh * 16);
      }
      __builtin_amdgcn_sched_barrier(0);
      f32x16 o, o1;
#pragma unroll
      for (int i = 0; i < 16; ++i) { o[i] = 0.f; o1[i] = 0.f; }
#pragma unroll
      for (int ks = 0; ks < 4; ++ks) {
        o = __builtin_amdgcn_mfma_f32_32x32x16_bf16(pp[ks], vb[ks], o, 0, 0, 0);
        o1 = __builtin_amdgcn_mfma_f32_32x32x16_bf16(qa[ks], sb[ks], o1, 0, 0, 0);
      }
      __builtin_amdgcn_sched_barrier(0);
#pragma unroll
      for (int ks = 0; ks < 4; ++ks) {
        qa[ks] = *(const bf16x8*)(Qs + (32 * jt + r) * 272 + (ks + 4) * 32 + hh * 16);
        sb[ks] = *(const bf16x8*)(Sts + r * 272 + (ks + 4) * 32 + hh * 16);
      }
      __builtin_amdgcn_sched_barrier(0);
      o = __builtin_amdgcn_mfma_f32_32x32x16_bf16(qa[0], sb[0], o, 0, 0, 0);
      o1 = __builtin_amdgcn_mfma_f32_32x32x16_bf16(qa[1], sb[1], o1, 0, 0, 0);
      o = __builtin_amdgcn_mfma_f32_32x32x16_bf16(qa[2], sb[2], o, 0, 0, 0);
      o1 = __builtin_amdgcn_mfma_f32_32x32x16_bf16(qa[3], sb[3], o1, 0, 0, 0);
      f32x16 o2;
#pragma unroll
      for (int i = 0; i < 16; ++i) o2[i] = 0.f;
#pragma unroll
      for (int i = 0; i < 8; ++i)
        opk[i] = pack2(o[2 * i] + o1[2 * i] + o2[2 * i], o[2 * i + 1] + o1[2 * i + 1] + o2[2 * i + 1]);
      otok = tok0;
    } else {
      const int kt0 = 2 * (wave - 2);
      bf16x8 ka[2][4], vb[4];
#pragma unroll
      for (int ks = 0; ks < 4; ++ks) {
        vb[ks] = *(const bf16x8*)(Vts + r * 144 + ks * 32 + hh * 16);
        ka[0][ks] = *(const bf16x8*)(KTs + (32 * kt0 + r) * 144 + ks * 32 + hh * 16);
        ka[1][ks] = *(const bf16x8*)(KTs + (32 * (kt0 + 1) + r) * 144 + ks * 32 + hh * 16);
      }
      __builtin_amdgcn_sched_barrier(0);
#pragma unroll
      for (int ks = 0; ks < 4; ++ks) {
        accS[0] = __builtin_amdgcn_mfma_f32_32x32x16_bf16(ka[0][ks], vb[ks], accS[0], 0, 0, 0);
        accS[1] = __builtin_amdgcn_mfma_f32_32x32x16_bf16(ka[1][ks], vb[ks], accS[1], 0, 0, 0);
      }
#pragma unroll
      for (int t = 0; t < 2; ++t)
#pragma unroll
        for (int i = 0; i < 16; ++i) accS[t][i] *= decs[32 * (kt0 + t) + (i & 3) + 8 * (i >> 2) + 4 * hh];
    }
    SCAN_BAR();
  }
  if (wave < 2) {
    u16* og = PHG + (otok + 32 * wave + 4 * hh) * 2560 + ocol + r;
#pragma unroll
    for (int i = 0; i < 8; ++i) {
      og[(size_t)(((2 * i) & 3) + 8 * ((2 * i) >> 2)) * 2560] = (u16)(opk[i] & 0xffffu);
      og[(size_t)(((2 * i + 1) & 3) + 8 * ((2 * i + 1) >> 2)) * 2560] = (u16)(opk[i] >> 16);
    }
  }
#undef SCAN_ISSUE
#undef SCAN_BAR
}

DEV float conv3_at(const u16* __restrict__ row, int t, int L, float w0, float w1, float w2, float bb) {
  const float um = (t > 0) ? bf2f(row[t - 1]) : 0.f;
  const float u0 = bf2f(row[t]);
  const float up = (t < L - 1) ? bf2f(row[t + 1]) : 0.f;
  return um * w0 + u0 * w1 + up * w2 + bb;
}

struct F8 { float v[8]; };
DEV F8 conv8(const u16* __restrict__ row, int t, int L, float w0, float w1, float w2, float bb) {
  const uint4 u = *(const uint4*)(row + t);
  const float um = (t > 0) ? bf2f(row[t - 1]) : 0.f;
  const float up = (t + 8 < L) ? bf2f(row[t + 8]) : 0.f;
  float x[10];
  x[0] = um;
  x[1] = bflo(u.x); x[2] = bfhi(u.x); x[3] = bflo(u.y); x[4] = bfhi(u.y);
  x[5] = bflo(u.z); x[6] = bfhi(u.z); x[7] = bflo(u.w); x[8] = bfhi(u.w);
  x[9] = up;
  F8 o;
#pragma unroll
  for (int j = 0; j < 8; ++j) o.v[j] = x[j] * w0 + x[j + 1] * w1 + x[j + 2] * w2 + bb;
  return o;
}

template <int BG>
DEV void hyena_item_mfma(const Params& p, int g, int item, char* smem, int half) {
  constexpr int NT = 256 / BG;
  constexpr int L = NT * 64;
  constexpr int VROW = 144;
  constexpr int RK1 = 4 * L + 64;
  constexpr int VBASE = 2 * (4 * L + 64);
  const int c = item >> 1, bgi = item & 1;
  char* Vl = smem + VBASE + half * (257 * VROW);
  u16* UHY = (u16*)(p.ws + OFF_UHY);
  const u16* RK = (const u16*)(p.ws + OFF_KK) + (g ? (size_t)512 * 8192 : 0) + (size_t)c * 2 * L;
  const float* cw = p.in[I_CONVW];
  const float* cb = p.in[I_CONVB];
  const int tid = tidx();
  __syncthreads();
  if (half == 0) {
#pragma unroll 8
    for (int e = tid; e < 2 * L / 8; e += 256) ((uint4*)smem)[e] = ((const uint4*)RK)[e];
  } else {
#pragma unroll 4
    for (int e = tid; e < 2 * L / 8; e += 256) {
      const uint4 v = ((const uint4*)RK)[e];
      const unsigned nx = (8 * e + 8 < 2 * L) ? (unsigned)RK[8 * e + 8] : 0u;
      uint4 o;
      o.x = (v.x >> 16) | (v.y << 16);
      o.y = (v.y >> 16) | (v.z << 16);
      o.z = (v.z >> 16) | (v.w << 16);
      o.w = (v.w >> 16) | (nx << 16);
      ((uint4*)(smem + RK1))[e] = o;
    }
  }
  {
    const float wx1_0 = cw[0 * 1536 + 512 + c], wx1_1 = cw[1 * 1536 + 512 + c], wx1_2 = cw[2 * 1536 + 512 + c], bx1 = cb[512 + c];
    const float wv_0 = cw[0 * 1536 + 1024 + c], wv_1 = cw[1 * 1536 + 1024 + c], wv_2 = cw[2 * 1536 + 1024 + c], bv = cb[1024 + c];
#pragma unroll 4
    for (int e = tid; e < BG * L / 8; e += 256) {
      const int bl = e / (L / 8), t = (e % (L / 8)) * 8;
      const int b = bgi * BG + bl;
      const F8 a = conv8(UHY + ((size_t)b * 1536 + 1024 + c) * L, t, L, wv_0, wv_1, wv_2, bv);
      const F8 x = conv8(UHY + ((size_t)b * 1536 + 512 + c) * L, t, L, wx1_0, wx1_1, wx1_2, bx1);
      *(uint4*)(Vl + ((t >> 6) * BG + bl) * VROW + (t & 63) * 2) =
          make_uint4(pack2(a.v[0] * x.v[0], a.v[1] * x.v[1]), pack2(a.v[2] * x.v[2], a.v[3] * x.v[3]),
                     pack2(a.v[4] * x.v[4], a.v[5] * x.v[5]), pack2(a.v[6] * x.v[6], a.v[7] * x.v[7]));
    }
  }
  if (tid < 9) *(uint4*)(Vl + 256 * VROW + tid * 16) = make_uint4(0u, 0u, 0u, 0u);
  __syncthreads();
  const int wave = tid >> 6, lane = tid & 63;
  const int n = lane & 31, hh = lane >> 5;
  Acc acc;
  acc_zero(acc);
  const int colw = wave * 64;
  {
    typedef __attribute__((ext_vector_type(2))) unsigned u32x2;
    typedef __attribute__((ext_vector_type(4))) unsigned u32x4;
    struct HySet {
      u32x2 wlo[6], whi[6];
      u32x4 bv[2][4];
      bool valid[2];
    };
    const int Tw0 = colw / BG;
    const int dlo = Tw0 - NT + 1, dhi = Tw0 + 64 / BG - 1;
    const int par = n & 1;
    const unsigned pkb = (unsigned)(size_t)smem + (par ? RK1 : 0) + 2u * (unsigned)(L - n + 8 * hh - 32 - par);
    const unsigned vlb = (unsigned)(size_t)Vl;
#define HY_PREP(Y_, dl_)                                              \
    const unsigned pabY_ = pkb - 128u * (unsigned)(dl_);               \
    unsigned pbY0_;                                                    \
    {                                                                  \
      const int col = colw + 0 + n;                                   \
      const int S = col / BG - (dl_);                                  \
      Y_.valid[0] = (unsigned)S < (unsigned)NT;                        \
      const int scol = Y_.valid[0] ? col - (dl_) * BG : 256;           \
      pbY0_ = vlb + (unsigned)(scol * VROW + hh * 16);                 \
    }                                                                  \
    unsigned pbY1_;                                                    \
    {                                                                  \
      const int col = colw + 32 + n;                                   \
      const int S = col / BG - (dl_);                                  \
      Y_.valid[1] = (unsigned)S < (unsigned)NT;                        \
      const int scol = Y_.valid[1] ? col - (dl_) * BG : 256;           \
      pbY1_ = vlb + (unsigned)(scol * VROW + hh * 16);                 \
    }                                                                  \

#define HY_ISSUE0(Y_, dl_)                                            \
    {                                                                  \
      HY_PREP(Y_, dl_)                                                 \
      asm volatile("ds_read2_b32 %0, %1 offset0:0 offset1:1" : "=v"(Y_.wlo[0]) : "v"(pabY_));  \
      asm volatile("ds_read2_b32 %0, %1 offset0:2 offset1:3" : "=v"(Y_.whi[0]) : "v"(pabY_));  \
      asm volatile("ds_read2_b32 %0, %1 offset0:8 offset1:9" : "=v"(Y_.wlo[1]) : "v"(pabY_));  \
      asm volatile("ds_read2_b32 %0, %1 offset0:10 offset1:11" : "=v"(Y_.whi[1]) : "v"(pabY_));  \
      asm volatile("ds_read2_b32 %0, %1 offset0:16 offset1:17" : "=v"(Y_.wlo[2]) : "v"(pabY_));  \
      asm volatile("ds_read2_b32 %0, %1 offset0:18 offset1:19" : "=v"(Y_.whi[2]) : "v"(pabY_));  \
      asm volatile("ds_read2_b32 %0, %1 offset0:24 offset1:25" : "=v"(Y_.wlo[3]) : "v"(pabY_));  \
      asm volatile("ds_read2_b32 %0, %1 offset0:26 offset1:27" : "=v"(Y_.whi[3]) : "v"(pabY_));  \
      asm volatile("ds_read2_b32 %0, %1 offset0:32 offset1:33" : "=v"(Y_.wlo[4]) : "v"(pabY_));  \
      asm volatile("ds_read2_b32 %0, %1 offset0:34 offset1:35" : "=v"(Y_.whi[4]) : "v"(pabY_));  \
      asm volatile("ds_read2_b32 %0, %1 offset0:40 offset1:41" : "=v"(Y_.wlo[5]) : "v"(pabY_));  \
      asm volatile("ds_read2_b32 %0, %1 offset0:42 offset1:43" : "=v"(Y_.whi[5]) : "v"(pabY_));  \
      asm volatile("ds_read_b128 %0, %1 offset:0" : "=v"(Y_.bv[0][0]) : "v"(pbY0_));  \
      asm volatile("ds_read_b128 %0, %1 offset:32" : "=v"(Y_.bv[0][1]) : "v"(pbY0_));  \
      asm volatile("ds_read_b128 %0, %1 offset:64" : "=v"(Y_.bv[0][2]) : "v"(pbY0_));  \
      asm volatile("ds_read_b128 %0, %1 offset:96" : "=v"(Y_.bv[0][3]) : "v"(pbY0_));  \
      asm volatile("ds_read_b128 %0, %1 offset:0" : "=v"(Y_.bv[1][0]) : "v"(pbY1_));  \
      asm volatile("ds_read_b128 %0, %1 offset:32" : "=v"(Y_.bv[1][1]) : "v"(pbY1_));  \
      asm volatile("ds_read_b128 %0, %1 offset:64" : "=v"(Y_.bv[1][2]) : "v"(pbY1_));  \
      asm volatile("ds_read_b128 %0, %1 offset:96" : "=v"(Y_.bv[1][3]) : "v"(pbY1_));  \
    }

#define HY_STEP(X_, Y_, dl_)                                          \
    {                                                                  \
      HY_PREP(Y_, dl_)                                                 \
      bf16x8 a[6];                                                     \
      _Pragma("unroll") for (int q = 0; q < 6; ++q) {                  \
        const u32x4 t = {X_.wlo[q][0], X_.wlo[q][1], X_.whi[q][0], X_.whi[q][1]}; \
        a[q] = __builtin_bit_cast(bf16x8, t);                          \
      }                                                                \
      {                                                                \
        u32x4 bq = X_.bv[0][0];                                        \
        const bf16x8 bb = __builtin_bit_cast(bf16x8, bq);              \
        __builtin_amdgcn_sched_barrier(0);                             \
        asm volatile("ds_read2_b32 %0, %1 offset0:0 offset1:1" : "=v"(Y_.wlo[0]) : "v"(pabY_));  \
        asm volatile("ds_read2_b32 %0, %1 offset0:2 offset1:3" : "=v"(Y_.whi[0]) : "v"(pabY_));  \
        __builtin_amdgcn_sched_barrier(0);                             \
        asm volatile("s_nop 1\n\tv_mfma_f32_32x32x16_bf16 %0, %1, %2, %0" : "+v"(acc[0][0]) : "v"(a[2]), "v"(bb)); \
        __builtin_amdgcn_sched_barrier(0);                             \
        asm volatile("ds_read2_b32 %0, %1 offset0:8 offset1:9" : "=v"(Y_.wlo[1]) : "v"(pabY_));  \
        asm volatile("ds_read2_b32 %0, %1 offset0:10 offset1:11" : "=v"(Y_.whi[1]) : "v"(pabY_));  \
        __builtin_amdgcn_sched_barrier(0);                             \
        asm volatile("s_nop 1\n\tv_mfma_f32_32x32x16_bf16 %0, %1, %2, %0" : "+v"(acc[0][1]) : "v"(a[0]), "v"(bb)); \
      }                                                                \
      {                                                                \
        u32x4 bq = X_.bv[0][1];                                        \
        const bf16x8 bb = __builtin_bit_cast(bf16x8, bq);              \
        __builtin_amdgcn_sched_barrier(0);                             \
        asm volatile("ds_read2_b32 %0, %1 offset0:16 offset1:17" : "=v"(Y_.wlo[2]) : "v"(pabY_));  \
        asm volatile("ds_read2_b32 %0, %1 offset0:18 offset1:19" : "=v"(Y_.whi[2]) : "v"(pabY_));  \
        __builtin_amdgcn_sched_barrier(0);                             \
        asm volatile("s_nop 1\n\tv_mfma_f32_32x32x16_bf16 %0, %1, %2, %0" : "+v"(acc[0][0]) : "v"(a[3]), "v"(bb)); \
        __builtin_amdgcn_sched_barrier(0);                             \
        asm volatile("ds_read2_b32 %0, %1 offset0:24 offset1:25" : "=v"(Y_.wlo[3]) : "v"(pabY_));  \
        asm volatile("ds_read2_b32 %0, %1 offset0:26 offset1:27" : "=v"(Y_.whi[3]) : "v"(pabY_));  \
        __builtin_amdgcn_sched_barrier(0);                             \
        asm volatile("s_nop 1\n\tv_mfma_f32_32x32x16_bf16 %0, %1, %2, %0" : "+v"(acc[0][1]) : "v"(a[1]), "v"(bb)); \
      }                                                                \
      {                                                                \
        u32x4 bq = X_.bv[0][2];                                        \
        const bf16x8 bb = __builtin_bit_cast(bf16x8, bq);              \
        __builtin_amdgcn_sched_barrier(0);                             \
        asm volatile("ds_read2_b32 %0, %1 offset0:32 offset1:33" : "=v"(Y_.wlo[4]) : "v"(pabY_));  \
        asm volatile("ds_read2_b32 %0, %1 offset0:34 offset1:35" : "=v"(Y_.whi[4]) : "v"(pabY_));  \
        __builtin_amdgcn_sched_barrier(0);                             \
        asm volatile("s_nop 1\n\tv_mfma_f32_32x32x16_bf16 %0, %1, %2, %0" : "+v"(acc[0][0]) : "v"(a[4]), "v"(bb)); \
        __builtin_amdgcn_sched_barrier(0);                             \
        asm volatile("ds_read2_b32 %0, %1 offset0:40 offset1:41" : "=v"(Y_.wlo[5]) : "v"(pabY_));  \
        asm volatile("ds_read2_b32 %0, %1 offset0:42 offset1:43" : "=v"(Y_.whi[5]) : "v"(pabY_));  \
        __builtin_amdgcn_sched_barrier(0);                             \
        asm volatile("s_nop 1\n\tv_mfma_f32_32x32x16_bf16 %0, %1, %2, %0" : "+v"(acc[0][1]) : "v"(a[2]), "v"(bb)); \
      }                                                                \
      {                                                                \
        u32x4 bq = X_.bv[0][3];                                        \
        const bf16x8 bb = __builtin_bit_cast(bf16x8, bq);              \
        __builtin_amdgcn_sched_barrier(0);                             \
        asm volatile("ds_read_b128 %0, %1 offset:0" : "=v"(Y_.bv[0][0]) : "v"(pbY0_));  \
        asm volatile("ds_read_b128 %0, %1 offset:32" : "=v"(Y_.bv[0][1]) : "v"(pbY0_));  \
        __builtin_amdgcn_sched_barrier(0);                             \
        asm volatile("s_nop 1\n\tv_mfma_f32_32x32x16_bf16 %0, %1, %2, %0" : "+v"(acc[0][0]) : "v"(a[5]), "v"(bb)); \
        __builtin_amdgcn_sched_barrier(0);                             \
        asm volatile("ds_read_b128 %0, %1 offset:64" : "=v"(Y_.bv[0][2]) : "v"(pbY0_));  \
        asm volatile("ds_read_b128 %0, %1 offset:96" : "=v"(Y_.bv[0][3]) : "v"(pbY0_));  \
        __builtin_amdgcn_sched_barrier(0);                             \
        asm volatile("s_nop 1\n\tv_mfma_f32_32x32x16_bf16 %0, %1, %2, %0" : "+v"(acc[0][1]) : "v"(a[3]), "v"(bb)); \
      }                                                                \
      {                                                                \
        u32x4 bq = X_.bv[1][0];                                        \
        const bf16x8 bb = __builtin_bit_cast(bf16x8, bq);              \
        __builtin_amdgcn_sched_barrier(0);                             \
        asm volatile("ds_read_b128 %0, %1 offset:0" : "=v"(Y_.bv[1][0]) : "v"(pbY1_));  \
        asm volatile("ds_read_b128 %0, %1 offset:32" : "=v"(Y_.bv[1][1]) : "v"(pbY1_));  \
        __builtin_amdgcn_sched_barrier(0);                             \
        asm volatile("s_nop 1\n\tv_mfma_f32_32x32x16_bf16 %0, %1, %2, %0" : "+v"(acc[1][0]) : "v"(a[2]), "v"(bb)); \
        __builtin_amdgcn_sched_barrier(0);                             \
        asm volatile("ds_read_b128 %0, %1 offset:64" : "=v"(Y_.bv[1][2]) : "v"(pbY1_));  \
        asm volatile("ds_read_b128 %0, %1 offset:96" : "=v"(Y_.bv[1][3]) : "v"(pbY1_));  \
        __builtin_amdgcn_sched_barrier(0);                             \
        asm volatile("s_nop 1\n\tv_mfma_f32_32x32x16_bf16 %0, %1, %2, %0" : "+v"(acc[1][1]) : "v"(a[0]), "v"(bb)); \
      }                                                                \
      {                                                                \
        u32x4 bq = X_.bv[1][1];                                        \
        const bf16x8 bb = __builtin_bit_cast(bf16x8, bq);              \
        __builtin_amdgcn_sched_barrier(0);                             \
        __builtin_amdgcn_sched_barrier(0);                             \
        asm volatile("s_nop 1\n\tv_mfma_f32_32x32x16_bf16 %0, %1, %2, %0" : "+v"(acc[1][0]) : "v"(a[3]), "v"(bb)); \
        __builtin_amdgcn_sched_barrier(0);                             \
        __builtin_amdgcn_sched_barrier(0);                             \
        asm volatile("s_nop 1\n\tv_mfma_f32_32x32x16_bf16 %0, %1, %2, %0" : "+v"(acc[1][1]) : "v"(a[1]), "v"(bb)); \
      }                                                                \
      {                                                                \
        u32x4 bq = X_.bv[1][2];                                        \
        const bf16x8 bb = __builtin_bit_cast(bf16x8, bq);              \
        __builtin_amdgcn_sched_barrier(0);                             \
        __builtin_amdgcn_sched_barrier(0);                             \
        asm volatile("s_nop 1\n\tv_mfma_f32_32x32x16_bf16 %0, %1, %2, %0" : "+v"(acc[1][0]) : "v"(a[4]), "v"(bb)); \
        __builtin_amdgcn_sched_barrier(0);                             \
        __builtin_amdgcn_sched_barrier(0);                             \
        asm volatile("s_nop 1\n\tv_mfma_f32_32x32x16_bf16 %0, %1, %2, %0" : "+v"(acc[1][1]) : "v"(a[2]), "v"(bb)); \
      }                                                                \
      {                                                                \
        u32x4 bq = X_.bv[1][3];                                        \
        const bf16x8 bb = __builtin_bit_cast(bf16x8, bq);              \
        __builtin_amdgcn_sched_barrier(0);                             \
        __builtin_amdgcn_sched_barrier(0);                             \
        asm volatile("s_nop 1\n\tv_mfma_f32_32x32x16_bf16 %0, %1, %2, %0" : "+v"(acc[1][0]) : "v"(a[5]), "v"(bb)); \
        __builtin_amdgcn_sched_barrier(0);                             \
        __builtin_amdgcn_sched_barrier(0);                             \
        asm volatile("s_nop 1\n\tv_mfma_f32_32x32x16_bf16 %0, %1, %2, %0" : "+v"(acc[1][1]) : "v"(a[3]), "v"(bb)); \
      }                                                                \
    }

#define HY_COMPUTE(X_)                                                \
    {                                                                  \
      bf16x8 a[6];                                                     \
      _Pragma("unroll") for (int q = 0; q < 6; ++q) {                  \
        const u32x4 t = {X_.wlo[q][0], X_.wlo[q][1], X_.whi[q][0], X_.whi[q][1]}; \
        a[q] = __builtin_bit_cast(bf16x8, t);                          \
      }                                                                \
      _Pragma("unroll") for (int nt = 0; nt < 2; ++nt) {               \
        _Pragma("unroll") for (int ks = 0; ks < 4; ++ks) {             \
          u32x4 bq = X_.bv[nt][ks];                                    \
          const bf16x8 bb = __builtin_bit_cast(bf16x8, bq);            \
          acc[nt][0] = __builtin_amdgcn_mfma_f32_32x32x16_bf16(a[ks + 2], bb, acc[nt][0], 0, 0, 0); \
          acc[nt][1] = __builtin_amdgcn_mfma_f32_32x32x16_bf16(a[ks], bb, acc[nt][1], 0, 0, 0);     \
        }                                                              \
      }                                                                \
    }
#define HY_WAIT(S_) asm volatile("s_waitcnt lgkmcnt(0)" : "+v"(S_.wlo[0]), "+v"(S_.whi[0]), "+v"(S_.wlo[1]), "+v"(S_.whi[1]), "+v"(S_.wlo[2]), "+v"(S_.whi[2]), "+v"(S_.wlo[3]), "+v"(S_.whi[3]), "+v"(S_.wlo[4]), "+v"(S_.whi[4]), "+v"(S_.wlo[5]), "+v"(S_.whi[5]), "+v"(S_.bv[0][0]), "+v"(S_.bv[0][1]), "+v"(S_.bv[0][2]), "+v"(S_.bv[0][3]), "+v"(S_.bv[1][0]), "+v"(S_.bv[1][1]), "+v"(S_.bv[1][2]), "+v"(S_.bv[1][3]) :: "memory")
    HySet s0, s1;
    HY_ISSUE0(s0, dlo);
    int dl = dlo;
    for (; dl + 1 <= dhi; dl += 2) {
      HY_WAIT(s0);
      HY_STEP(s0, s1, dl + 1);
      __builtin_amdgcn_sched_barrier(0);
      HY_WAIT(s1);
      {
        const int d2 = (dl + 2 <= dhi) ? dl + 2 : dhi;
        HY_STEP(s1, s0, d2);
      }
      __builtin_amdgcn_sched_barrier(0);
    }
    if (dl == dhi) {
      HY_WAIT(s0);
      HY_COMPUTE(s0);
    }
    asm volatile("s_waitcnt lgkmcnt(0)" ::: "memory");
#undef HY_PREP
#undef HY_ISSUE0
#undef HY_STEP
#undef HY_COMPUTE
#undef HY_WAIT
  }
  __syncthreads();
  {
    const float fbias = p.in[I_FBIAS][c];
#pragma unroll
    for (int nt = 0; nt < 2; ++nt)
#pragma unroll
      for (int mi = 0; mi < 2; ++mi)
#pragma unroll
        for (int rg = 0; rg < 4; ++rg) {
          const int col = colw + 32 * nt + n, i0 = 32 * mi + 8 * rg + 4 * hh;
          char* pv = Vl + col * VROW + i0 * 2;
          const uint2 w = *(const uint2*)pv;
          const float t0 = acc[nt][mi][4 * rg + 0] + bflo(w.x) * fbias;
          const float t1 = acc[nt][mi][4 * rg + 1] + bfhi(w.x) * fbias;
          const float t2 = acc[nt][mi][4 * rg + 2] + bflo(w.y) * fbias;
          const float t3 = acc[nt][mi][4 * rg + 3] + bfhi(w.y) * fbias;
          *(uint2*)pv = make_uint2(pack2(t0, t1), pack2(t2, t3));
        }
  }
  __syncthreads();
  {
    const float wx0_0 = cw[0 * 1536 + c], wx0_1 = cw[1 * 1536 + c], wx0_2 = cw[2 * 1536 + c], bx0 = cb[c];
    for (int e0 = tid; e0 < BG * L / 8; e0 += 256 * 4) {
      F8 x[4];
      uint4 y[4];
#pragma unroll
      for (int u = 0; u < 4; ++u) {
        const int e = e0 + 256 * u;
        const int bl = e / (L / 8), t = (e % (L / 8)) * 8;
        const int b = bgi * BG + bl;
        x[u] = conv8(UHY + ((size_t)b * 1536 + c) * L, t, L, wx0_0, wx0_1, wx0_2, bx0);
        y[u] = *(const uint4*)(Vl + ((t >> 6) * BG + bl) * VROW + (t & 63) * 2);
      }
#pragma unroll
      for (int u = 0; u < 4; ++u) {
        const int e = e0 + 256 * u;
        const int bl = e / (L / 8), t = (e % (L / 8)) * 8;
        const int b = bgi * BG + bl;
        *(uint4*)(UHY + ((size_t)b * 1536 + 1024 + c) * L + t) =
            make_uint4(pack2(bflo(y[u].x) * x[u].v[0], bfhi(y[u].x) * x[u].v[1]), pack2(bflo(y[u].y) * x[u].v[2], bfhi(y[u].y) * x[u].v[3]),
                       pack2(bflo(y[u].z) * x[u].v[4], bfhi(y[u].z) * x[u].v[5]), pack2(bflo(y[u].w) * x[u].v[6], bfhi(y[u].w) * x[u].v[7]));
      }
    }
  }
}

DEV void phase_p2_naive(const Params& p, int g, char* hsm) {
  __shared__ int s_item;
  const int nscan = g ? 128 : 256;
  const int nhy = 1024;
  unsigned* cnt = (unsigned*)(p.ws + OFF_CNT) + g;
  const int half = vhalf();
  if ((int)blockIdx.x * 2 < nscan) scan_item_mfma(p, g, blockIdx.x * 2 + half, hsm);
  for (;;) {
    __syncthreads();
    if (threadIdx.x == 0) s_item = (int)atomicAdd(cnt, 2u);
    __syncthreads();
    const int it = s_item + half;
    if (it >= nhy) break;
    if (g == 0) hyena_item_mfma<4>(p, g, it, hsm - half * HALF_BYTES, half);
    else hyena_item_mfma<2>(p, g, it, hsm - half * HALF_BYTES, half);
  }
  unsigned* cnt2 = (unsigned*)(p.ws + OFF_CNT) + 2 + g;
  const float* mod = (const float*)(p.ws + OFF_MOD);
  for (;;) {
    __syncthreads();
    if (threadIdx.x == 0) s_item = (int)atomicAdd(cnt2, 2u);
    __syncthreads();
    const int it = s_item + half;
    if (it >= 512) break;
    if (g == 0) norm_adaln_rows(p.in[I_XS], p.in[I_N1G], mod, 8, 8192, 0, 1024, (u16*)(p.out + (size_t)NTOK * D), it * 64);
    else final_norm_rows(p.out, p.in[I_FING], it * 64);
  }
}

DEV void phase_p2c(const Params& p, int g) {
  u16* PHG = (u16*)(p.ws + OFF_PHG);
  const float* gn = p.in[I_GNG];
  const int tid = tidx();
  const int wave = tid >> 6, lane = tid & 63;
  constexpr int RB = 4;
  const int stride = NVB * 4;
  const int c = lane * 8;
  for (int tok0 = VBID * 4 + wave; tok0 < NTOK; tok0 += stride * RB) {
    uint4 a[RB], bq[RB], og[RB];
#pragma unroll
    for (int j = 0; j < RB; ++j) {
      const int t_ = tok0 + j * stride;
      const size_t tok = (size_t)(t_ < NTOK ? t_ : tok0);
      a[j] = *(const uint4*)(PHG + tok * 2560 + c);
      bq[j] = *(const uint4*)(PHG + tok * 2560 + 1024 + c);
      og[j] = *(const uint4*)(PHG + tok * 2560 + 2048 + c);
    }
    const float4 g0 = *(const float4*)(gn + c), g1 = *(const float4*)(gn + c + 4);
#pragma unroll
    for (int j = 0; j < RB; ++j) {
      const int t_ = tok0 + j * stride;
      float o[8];
      o[0] = bflo(a[j].x) + bflo(bq[j].x); o[1] = bfhi(a[j].x) + bfhi(bq[j].x);
      o[2] = bflo(a[j].y) + bflo(bq[j].y); o[3] = bfhi(a[j].y) + bfhi(bq[j].y);
      o[4] = bflo(a[j].z) + bflo(bq[j].z); o[5] = bfhi(a[j].z) + bfhi(bq[j].z);
      o[6] = bflo(a[j].w) + bflo(bq[j].w); o[7] = bfhi(a[j].w) + bfhi(bq[j].w);
      float ss = 0.f;
#pragma unroll
      for (int i = 0; i < 8; ++i) ss += o[i] * o[i];
      ss += __shfl_xor(ss, 1);
      ss += __shfl_xor(ss, 2);
      ss += __shfl_xor(ss, 4);
      ss += __shfl_xor(ss, 8);
      const float rstd = rsqrtf(ss * (1.f / 128.f) + EPSF);
      const float y0 = o[0] * rstd * g0.x * bflo(og[j].x), y1 = o[1] * rstd * g0.y * bfhi(og[j].x);
      const float y2 = o[2] * rstd * g0.z * bflo(og[j].y), y3 = o[3] * rstd * g0.w * bfhi(og[j].y);
      const float y4 = o[4] * rstd * g1.x * bflo(og[j].z), y5 = o[5] * rstd * g1.y * bfhi(og[j].z);
      const float y6 = o[6] * rstd * g1.z * bflo(og[j].w), y7 = o[7] * rstd * g1.w * bfhi(og[j].w);
      if (t_ < NTOK)
        *(uint4*)(PHG + (size_t)t_ * 2560 + c) = make_uint4(pack2(y0, y1), pack2(y2, y3), pack2(y4, y5), pack2(y6, y7));
    }
  }
}

DEV void tile_order(int tile, int ntn, int& mt, int& nt) {
  const int grp = tile / (16 * ntn), rem = tile % (16 * ntn);
  mt = grp * 16 + (rem & 15);
  nt = rem >> 4;
}

DEV void phase_p3a(const Params& p, int g, char* smem) {
  const int L = g ? 8192 : 4096;
  u16* PHG = (u16*)(p.ws + OFF_PHG);
  const u16* GT = (const u16*)(p.ws + OFF_GT);
  const u16* UHY = (const u16*)(p.ws + OFF_UHY);
  const u16* WbrT = (const u16*)(p.ws + OFF_WBR);
  for (int iter = 0;; ++iter) {
    int mt, nt;
    if (!tile_map(iter, 128, 4, mt, nt)) break;
    const int m0 = mt * 256, n0 = nt * 256;
    Acc acc;
    acc_zero(acc);
    {
      TransLoader al{UHY, L};
      RowLoader bl{WbrT, 1024};
      gemm_mainloop(acc, al, bl, m0, n0, 0, 512, smem);
    }
    acc_foreach(acc, m0, n0, [&](int m, int n, float& v) {
      const float ga = bf2f(GT[(size_t)m * 2048 + n]);
      const float gb = bf2f(GT[(size_t)m * 2048 + 1024 + n]);
      v *= ga / fmaxf(gb, 1e-30f);
    });
    {
      RowLoader al{PHG - 512, 2560};
      RowLoader bl{WbrT, 1024};
      gemm_mainloop(acc, al, bl, m0, n0, 512, 1024, smem);
    }
    acc_foreach(acc, m0, n0, [&](int m, int n, float& v) {
      const float gb = bf2f(GT[(size_t)m * 2048 + 1024 + n]);
      PHG[(size_t)m * 2560 + 1024 + n] = f2bf(gb * v);
    });
  }
}

DEV void phase_p3b(const Params& p, int g, char* smem) {
  const int L = g ? 8192 : 4096;
  const int bg0 = g ? 8 : 0;
  const u16* PHG = (const u16*)(p.ws + OFF_PHG);
  const u16* WoutT = (const u16*)(p.ws + OFF_WOUT);
  const float* X = p.in[g ? I_XS : I_XP];
  const float* mod = (const float*)(p.ws + OFF_MOD);
  float* X1 = p.out + (size_t)g * NTOK * D;
  for (int iter = 0;; ++iter) {
    int mt, nt;
    if (!tile_map(iter, 128, 4, mt, nt)) break;
    const int m0 = mt * 256, n0 = nt * 256;
    Acc acc;
    acc_zero(acc);
    RowLoader al{PHG + 1024, 2560}, bl{WoutT, 1024};
    gemm_mainloop(acc, al, bl, m0, n0, 0, 1024, smem);
    const float* gt = mod + (size_t)(bg0 + m0 / L) * DIN + 2048;
    acc_foreach(acc, m0, n0, [&](int m, int n, float& v) {
      X1[(size_t)m * D + n] = X[(size_t)m * D + n] + gt[n] * v;
    });
  }
}

DEV void phase_ff1(const Params& p, int g, char* smem) {
  const u16* H2 = (const u16*)(p.ws + OFF_H2);
  const u16* W = (const u16*)(p.ws + OFF_WFF1);
  u16* AB = (u16*)(p.ws + OFF_ABUF);
  GemmPipe gp;
  gp.primed = false;
  for (int iter = 0;; ++iter) {
    int mt, nt, mtn, ntn;
    if (!tile_map(iter, 128, 16, mt, nt)) break;
    const bool more = tile_map(iter + 1, 128, 16, mtn, ntn);
    if (!more) { mtn = mt; ntn = nt; }
    const int m0 = mt * 256, n0 = nt * 256;
    Acc acc;
    acc_zero(acc);
    RowLoader al{H2, 1024}, bl{W, 1024};
    gemm_mainloop_p(acc, al, bl, m0, n0, mtn * 256, ntn * 256, 1024, smem, gp);
    gp.primed = more;
    acc_foreach(acc, m0, n0, [&](int m, int n, float& v) {
      const float r = fmaxf(v, 0.f);
      AB[(size_t)m * 4096 + n] = f2bf(r * r);
    });
  }
}

DEV void phase_ff2(const Params& p, int g, char* smem) {
  const int L = g ? 8192 : 4096;
  const int bg0 = g ? 8 : 0;
  const u16* AB = (const u16*)(p.ws + OFF_ABUF);
  const u16* W = (const u16*)(p.ws + OFF_WFF2);
  const float* mod = (const float*)(p.ws + OFF_MOD);
  float* X1 = p.out + (size_t)g * NTOK * D;
  for (int iter = 0;; ++iter) {
    int mt, nt;
    if (!tile_map(iter, 128, 4, mt, nt)) break;
    const int m0 = mt * 256, n0 = nt * 256;
    Acc acc;
    acc_zero(acc);
    RowLoader al{AB, 4096}, bl{W, 4096};
    gemm_mainloop(acc, al, bl, m0, n0, 0, 4096, smem);
    const float* gt = mod + (size_t)(bg0 + m0 / L) * DIN + 5120;
    acc_foreach(acc, m0, n0, [&](int m, int n, float& v) { X1[(size_t)m * D + n] += gt[n] * v; });
  }
}

__global__ void __launch_bounds__(512) mk(Params p) {
  cg::grid_group grid = cg::this_grid();
  __shared__ __attribute__((aligned(16))) char smem[SMEM_BYTES];
  __shared__ uint4 xb_words;
  if (threadIdx.x == 0) xb_words = make_uint4(0u, 0u, 0u, 0u);
  __syncthreads();
  const XcdBarrier xb = xcd_barrier_post((unsigned*)(p.ws + OFF_XBAR), (volatile LAS unsigned*)&xb_words);
  char* hsm = smem + vhalf() * HALF_BYTES;
  const float* mod = (const float*)(p.ws + OFF_MOD);
  phase_prep(p, hsm);
  phase_filter_mlp(p, hsm);
  xcd_barrier(xb);
  if (p.out == nullptr) grid.sync();
  phase_filter_norm(p, hsm);
  phase_norm_adaln(p.in[I_XP], p.in[I_N1G], mod, 0, 4096, 0, 1024, (u16*)p.out);
  xcd_barrier(xb);
#pragma unroll 1
  for (int gi = 0; gi < 2; ++gi) {
    int g = gi;
    asm volatile("" : "+s"(g));
    const int L = g ? 8192 : 4096;
    const int bg0 = g ? 8 : 0;
    float* OG = p.out + (size_t)g * NTOK * D;
    phase_p1(p, g, smem);
    xcd_barrier(xb);
    phase_p15(p, g);
    xcd_barrier(xb);
    phase_p2_naive(p, g, hsm);
    xcd_barrier(xb);
    phase_p2c(p, g);
    xcd_barrier(xb);
    phase_p3a(p, g, smem);
    xcd_barrier(xb);
    phase_p3b(p, g, smem);
    xcd_barrier(xb);
    phase_norm_adaln(OG, p.in[I_N2G], mod, bg0, L, 3072, 4096, (u16*)(p.ws + OFF_H2));
    xcd_barrier(xb);
    phase_ff1(p, g, smem);
    xcd_barrier(xb);
    phase_ff2(p, g, smem);
    xcd_barrier(xb);
  }
  phase_final_norm(p.out + (size_t)NTOK * D, p.in[I_FING]);
}

extern "C" void kernel_launch(void* const* d_in, const int* in_sizes, int n_in, void* d_out, int out_size,
                              void* d_ws, size_t ws_size, hipStream_t stream) {
  static int grid_blocks = 0;
  if (!grid_blocks) {
    int dev = 0, cus = 0, per_cu = 0;
    (void)hipGetDevice(&dev);
    (void)hipDeviceGetAttribute(&cus, hipDeviceAttributeMultiprocessorCount, dev);
    (void)hipOccupancyMaxActiveBlocksPerMultiprocessor(&per_cu, mk, 512, 0);
    if (per_cu > 1) per_cu = 1;
    if (per_cu < 1) per_cu = 1;
    grid_blocks = cus * per_cu;
  }
  if (ws_size < WS_NEED) fprintf(stderr, "workspace too small: %zu < %zu\n", ws_size, (size_t)WS_NEED);
  Params p{};
  for (int i = 0; i < 27; ++i) p.in[i] = (const float*)d_in[i];
  p.out = (float*)d_out;
  p.ws = (char*)d_ws;
  (void)hipMemsetAsync((char*)d_ws + OFF_XBAR, 0, 16384, stream);
  void* args[] = {&p};
  hipError_t e = hipLaunchCooperativeKernel((void*)mk, dim3(grid_blocks), dim3(512), args, 0, stream);
  if (e != hipSuccess) fprintf(stderr, "coop launch failed: %s (grid %d)\n", hipGetErrorString(e), grid_blocks);
}
```

```cpp
#include <hip/hip_runtime.h>
#include <hip/hip_cooperative_groups.h>
#include <cstdio>
namespace cg = cooperative_groups;

typedef unsigned short u16;
typedef __attribute__((ext_vector_type(8))) short bf16x8;
typedef __attribute__((ext_vector_type(16))) float f32x16;

#define DEV __device__ __forceinline__

constexpr int D = 1024;
constexpr int NTOK = 32768;
constexpr int DIN = 6144;
constexpr float EPSF = 1e-6f;

enum { I_XP = 0, I_XS, I_CP, I_CS, I_ADAW, I_ADAB, I_N1G, I_WIN, I_CONVW, I_CONVB, I_FW1, I_FB1, I_FW2, I_FB2,
       I_FW3, I_FB3, I_FWO, I_FFREQ, I_FBIAS, I_LB, I_GNG, I_WBR, I_WOUT, I_N2G, I_WFF1, I_WFF2, I_FING };

constexpr size_t OFF_WIN = 0;
constexpr size_t OFF_WBR = OFF_WIN + (size_t)6144 * 1024 * 2;
constexpr size_t OFF_WOUT = OFF_WBR + (size_t)1024 * 1024 * 2;
constexpr size_t OFF_WFF1 = OFF_WOUT + (size_t)1024 * 1024 * 2;
constexpr size_t OFF_WFF2 = OFF_WFF1 + (size_t)4096 * 1024 * 2;
constexpr size_t OFF_MOD = OFF_WFF2 + (size_t)4096 * 1024 * 2;
constexpr size_t OFF_CNT = OFF_MOD + (size_t)12 * 6144 * 4;
constexpr size_t OFF_XBAR = OFF_CNT + 256;
constexpr size_t OFF_PART = OFF_XBAR + 16384;
constexpr size_t OFF_KK = OFF_PART + (size_t)768 * 1024 * 4;
constexpr size_t OFF_DEC = OFF_KK + (size_t)512 * (8192 + 16384) * 2;
constexpr size_t OFF_KT = OFF_DEC + (size_t)2 * 512 * 512 * 4;
constexpr size_t OFF_P = OFF_KT + (size_t)512 * 2 * 512 * 64 * 2;
constexpr size_t OFF_UHY = OFF_P;
constexpr size_t OFF_PHG = OFF_UHY + (size_t)NTOK * 1536 * 2;
constexpr size_t OFF_GT = OFF_PHG + (size_t)NTOK * 2560 * 2;
constexpr size_t WS_NEED = OFF_GT + (size_t)NTOK * 2048 * 2;
constexpr size_t OFF_HRAW = OFF_P;
constexpr size_t OFF_ABUF = OFF_UHY;
constexpr size_t OFF_H2 = OFF_GT;

struct Params {
  const float* in[27];
  float* out;
  char* ws;
};

DEV unsigned pack2(float a, float b) {
  unsigned r;
  asm("s_nop 0\n\tv_cvt_pk_bf16_f32 %0, %1, %2" : "=v"(r) : "v"(a), "v"(b));
  return r;
}
DEV u16 f2bf(float f) { return (u16)(pack2(f, f) & 0xffffu); }
DEV float bf2f(u16 h) { return __uint_as_float(((unsigned)h) << 16); }
DEV float bflo(unsigned w) { return __uint_as_float(w << 16); }
DEV float bfhi(unsigned w) { return __uint_as_float(w & 0xffff0000u); }
DEV float silu_f(float x) { return x / (1.f + __expf(-x)); }
DEV float sigmoid_f(float x) { return __builtin_amdgcn_rcpf(1.f + __expf(-x)); }
DEV int tidx_full() {
  int t = threadIdx.x;
  asm volatile("" : "+v"(t));
  return t;
}
DEV int tidx() { return tidx_full() & 255; }
DEV int vhalf() { return __builtin_amdgcn_readfirstlane((int)(threadIdx.x >> 8)); }
#define VBID ((int)blockIdx.x * 2 + vhalf())
#define NVB ((int)gridDim.x * 2)
DEV float wave_sum(float v) {
#pragma unroll
  for (int o = 32; o > 0; o >>= 1) v += __shfl_xor(v, o);
  return v;
}

#define XB_TMO      128
#define XB_XCNT(j)  (256  + 64 * (j))
#define XB_XSUB(j)  (1280 + 64 * (j))
#define XB_XGEN(j)  (2304 + 64 * (j))
#define XB_TOP      3328
#define XB_TOPGEN   3392
#define XCD_BAR_WORDS 3456
#define XB_SPIN_CAP (1u << 18)
#define LAS __attribute__((address_space(3)))

__device__ __forceinline__ unsigned xb_ld(unsigned* p)              { return __hip_atomic_load(p, __ATOMIC_RELAXED, __HIP_MEMORY_SCOPE_AGENT); }
__device__ __forceinline__ unsigned xb_add(unsigned* p, unsigned v) { return __hip_atomic_fetch_add(p, v, __ATOMIC_RELAXED, __HIP_MEMORY_SCOPE_AGENT); }
__device__ __forceinline__ unsigned xb_xcc_id() { return (unsigned)__builtin_amdgcn_s_getreg((3 << 11) | 20) & 0xFu; }
#define XB_SPIN(cond, bar) do { unsigned _sp = 0; while (cond) { __builtin_amdgcn_s_sleep(1); \
    if ((++_sp & 255u) == 0u) { if (xb_ld(&(bar)[XB_TMO])) break; if (_sp > XB_SPIN_CAP) { atomicAdd(&(bar)[XB_TMO], 1u); break; } } } } while (0)

struct XcdBarrier {
    unsigned* bar; unsigned x;
    volatile LAS unsigned* st;
};

__device__ __forceinline__ XcdBarrier xcd_barrier_post(unsigned* bar, volatile LAS unsigned* st) {
    XcdBarrier b; b.bar = bar; b.x = xb_xcc_id(); b.st = st;
    if (threadIdx.x == 0) (void)xb_add(&bar[XB_XCNT(b.x)], 1u);
    return b;
}
__device__ __forceinline__ void xcd_barrier_complete(unsigned* bar, unsigned x, unsigned& nloc, unsigned& nx) {
    const unsigned G = gridDim.x * gridDim.y * gridDim.z;
    unsigned sum, cnt, mine, sp = 0u;
    for (;;) {
        sum = 0u; cnt = 0u; mine = 0u;
#pragma unroll
        for (unsigned j = 0; j < 16; ++j) { const unsigned c = xb_ld(&bar[XB_XCNT(j)]); sum += c; cnt += (c > 0u) ? 1u : 0u; mine = (j == x) ? c : mine; }
        if (sum == G) break;
        __builtin_amdgcn_s_sleep(1);
        if ((++sp & 255u) == 0u) { if (xb_ld(&bar[XB_TMO])) break; if (sp > XB_SPIN_CAP) { atomicAdd(&bar[XB_TMO], 1u); break; } }
    }
    nloc = mine > 0u ? mine : 1u; nx = cnt > 0u ? cnt : 1u;
}

__device__ __forceinline__ void xcd_barrier(const XcdBarrier& b) {
    asm volatile("s_waitcnt vmcnt(0)" ::: "memory");
    __syncthreads();
    if (threadIdx.x == 0) {
        unsigned* bar = b.bar;
        __builtin_amdgcn_s_waitcnt(0);
        unsigned nloc = b.st[0], nx = b.st[1];
        if (nloc == 0u) { xcd_barrier_complete(bar, b.x, nloc, nx); b.st[0] = nloc; b.st[1] = nx; }
        const unsigned old = xb_add(&bar[XB_XSUB(b.x)], 1u);
        const unsigned gen = old / nloc;
        if (old + 1u == (gen + 1u) * nloc) {
            __builtin_amdgcn_fence(__ATOMIC_RELEASE, "agent");
            asm volatile("s_waitcnt vmcnt(0)" ::: "memory");
            const unsigned og = xb_add(&bar[XB_TOP], 1u);
            const unsigned tg = og / nx;
            if (og + 1u == (tg + 1u) * nx) xb_add(&bar[XB_TOPGEN], 1u);
            else XB_SPIN(xb_ld(&bar[XB_TOPGEN]) == tg, bar);
            __builtin_amdgcn_fence(__ATOMIC_ACQUIRE, "agent");
            xb_add(&bar[XB_XGEN(b.x)], 1u);
            asm volatile("s_waitcnt vmcnt(0)" ::: "memory");
        } else {
            XB_SPIN(xb_ld(&bar[XB_XGEN(b.x)]) == gen, bar);
            __builtin_amdgcn_fence(__ATOMIC_ACQUIRE, "agent");
            asm volatile("s_waitcnt vmcnt(0)" ::: "memory");
        }
    }
    __syncthreads();
}


constexpr int BK = 64;
constexpr int LDSROW = 144;
constexpr int TILE_BYTES = 256 * LDSROW;
constexpr int HALF_BYTES = 76800;
constexpr int SMEM_BYTES = 2 * HALF_BYTES;

struct R4 { uint4 a, b, c, d; };

struct RowLoader {
  const u16* base;
  long ld;
  DEV R4 load(int tid, int r0, int k0) const {
    const int tr = tid >> 3, tc = tid & 7;
    const u16* p = base + (long)(r0 + tr) * ld + k0 + tc * 8;
    R4 r;
    r.a = *(const uint4*)(p);
    r.b = *(const uint4*)(p + 64 * ld);
    r.c = *(const uint4*)(p + 128 * ld);
    r.d = *(const uint4*)(p + 192 * ld);
    return r;
  }
  DEV void store(int tid, char* lds, const R4& r) const {
    const int tr = tid >> 3, tc = tid & 7;
    char* q = lds + tr * LDSROW + tc * 16;
    *(uint4*)(q) = r.a;
    *(uint4*)(q + 64 * LDSROW) = r.b;
    *(uint4*)(q + 128 * LDSROW) = r.c;
    *(uint4*)(q + 192 * LDSROW) = r.d;
  }
};

DEV void st8t(char* q, const uint4& v) {
  *(u16*)(q + 0 * LDSROW) = (u16)(v.x & 0xffff);
  *(u16*)(q + 1 * LDSROW) = (u16)(v.x >> 16);
  *(u16*)(q + 2 * LDSROW) = (u16)(v.y & 0xffff);
  *(u16*)(q + 3 * LDSROW) = (u16)(v.y >> 16);
  *(u16*)(q + 4 * LDSROW) = (u16)(v.z & 0xffff);
  *(u16*)(q + 5 * LDSROW) = (u16)(v.z >> 16);
  *(u16*)(q + 6 * LDSROW) = (u16)(v.w & 0xffff);
  *(u16*)(q + 7 * LDSROW) = (u16)(v.w >> 16);
}

struct TransLoader {
  const u16* U;
  int L;
  DEV R4 load(int tid, int m0, int k0) const {
    const int b = m0 / L, t0 = m0 - b * L;
    const int k = k0 + (tid & 63), tg = tid >> 6;
    const u16* p = U + ((long)(b * 1536 + 1024 + k)) * L + t0 + tg * 8;
    R4 r;
    r.a = *(const uint4*)(p);
    r.b = *(const uint4*)(p + 64);
    r.c = *(const uint4*)(p + 128);
    r.d = *(const uint4*)(p + 192);
    return r;
  }
  DEV void store(int tid, char* lds, const R4& r) const {
    const int kl = tid & 63, tg = tid >> 6;
    char* q = lds + (tg * 8) * LDSROW + kl * 2;
    st8t(q, r.a);
    st8t(q + 64 * LDSROW, r.b);
    st8t(q + 128 * LDSROW, r.c);
    st8t(q + 192 * LDSROW, r.d);
  }
};

typedef f32x16 Acc[4][2];

template <class AL, class BL>
DEV void gemm_ktile(Acc& acc, const char* A, const char* B, int wm, int wn, int lr, int lh, const AL& al, const BL& bl,
                    int tid, int m0, int n0, int knext, char* nxt, R4& ra, R4& rb) {
  bf16x8 a[2][4], b[2][2];
  const char* pa = A + (wm + lr) * LDSROW + lh * 16;
  const char* pb = B + (wn + lr) * LDSROW + lh * 16;
#pragma unroll
  for (int i = 0; i < 4; ++i) a[0][i] = *(const bf16x8*)(pa + 32 * i * LDSROW);
#pragma unroll
  for (int j = 0; j < 2; ++j) b[0][j] = *(const bf16x8*)(pb + 32 * j * LDSROW);
#pragma unroll
  for (int ks = 0; ks < 4; ++ks) {
    const int cur = ks & 1, nx = cur ^ 1;
    if (ks < 3) {
#pragma unroll
      for (int i = 0; i < 4; ++i) a[nx][i] = *(const bf16x8*)(pa + 32 * i * LDSROW + (ks + 1) * 32);
#pragma unroll
      for (int j = 0; j < 2; ++j) b[nx][j] = *(const bf16x8*)(pb + 32 * j * LDSROW + (ks + 1) * 32);
    }
    __builtin_amdgcn_sched_barrier(0);
#pragma unroll
    for (int i = 0; i < 4; ++i)
#pragma unroll
      for (int j = 0; j < 2; ++j)
        acc[i][j] = __builtin_amdgcn_mfma_f32_32x32x16_bf16(a[cur][i], b[cur][j], acc[i][j], 0, 0, 0);
    __builtin_amdgcn_sched_barrier(0);
    if (ks == 1) {
      al.store(tid, nxt, ra);
      bl.store(tid, nxt + TILE_BYTES, rb);
      __builtin_amdgcn_sched_barrier(0);
      ra = al.load(tid, m0, knext);
      rb = bl.load(tid, n0, knext);
      __builtin_amdgcn_sched_barrier(0);
    }
  }
}

template <class AL, class BL>
DEV void gemm_mainloop(Acc& acc, const AL& al, const BL& bl, int m0, int n0, int kbeg, int kend, char* lds) {
  const int tid = tidx_full();
  const int wave = tid >> 6, lane = tid & 63;
  const int wm = (wave >> 2) * 128, wn = (wave & 3) * 64;
  const int lr = lane & 31, lh = lane >> 5;
  const int nk = (kend - kbeg) / BK;
  R4 a0 = al.load(tid, m0, kbeg);
  R4 b0 = bl.load(tid, n0, kbeg);
  __syncthreads();
  al.store(tid, lds, a0);
  bl.store(tid, lds + TILE_BYTES, b0);
  a0 = al.load(tid, m0, kbeg + BK);
  b0 = bl.load(tid, n0, kbeg + BK);
  __syncthreads();
  for (int kt = 0; kt < nk; ++kt) {
    const char* cur = lds + (kt & 1) * 2 * TILE_BYTES;
    char* nxt = lds + ((kt + 1) & 1) * 2 * TILE_BYTES;
    const int t2 = (kt + 2 < nk) ? kt + 2 : nk - 1;
    __builtin_amdgcn_sched_barrier(0);
    gemm_ktile(acc, cur, cur + TILE_BYTES, wm, wn, lr, lh, al, bl, tid, m0, n0, kbeg + t2 * BK, nxt, a0, b0);
    __builtin_amdgcn_sched_barrier(0);
    __syncthreads();
  }
}

struct GemmPipe {
  R4 ra, rb;
  bool primed;
};
template <class AL, class BL>
DEV void gemm_mainloop_p(Acc& acc, const AL& al, const BL& bl, int m0, int n0, int m0n, int n0n, int K, char* lds,
                         GemmPipe& gp) {
  const int tid = tidx_full();
  const int wave = tid >> 6, lane = tid & 63;
  const int wm = (wave >> 2) * 128, wn = (wave & 3) * 64;
  const int lr = lane & 31, lh = lane >> 5;
  const int nk = K / BK;
  if (!gp.primed) {
    gp.ra = al.load(tid, m0, 0);
    gp.rb = bl.load(tid, n0, 0);
    __syncthreads();
    al.store(tid, lds, gp.ra);
    bl.store(tid, lds + TILE_BYTES, gp.rb);
    gp.ra = al.load(tid, m0, BK);
    gp.rb = bl.load(tid, n0, BK);
    __syncthreads();
  }
  for (int kt = 0; kt < nk; ++kt) {
    const char* cur = lds + (kt & 1) * 2 * TILE_BYTES;
    char* nxt = lds + ((kt + 1) & 1) * 2 * TILE_BYTES;
    const bool wrap = (kt + 2 >= nk);
    const int kk = (wrap ? kt + 2 - nk : kt + 2) * BK;
    const int mr = wrap ? m0n : m0, nr = wrap ? n0n : n0;
    __builtin_amdgcn_sched_barrier(0);
    gemm_ktile(acc, cur, cur + TILE_BYTES, wm, wn, lr, lh, al, bl, tid, mr, nr, kk, nxt, gp.ra, gp.rb);
    __builtin_amdgcn_sched_barrier(0);
    __syncthreads();
  }
}

DEV void acc_zero(Acc& acc) {
#pragma unroll
  for (int i = 0; i < 4; ++i)
#pragma unroll
    for (int j = 0; j < 2; ++j)
#pragma unroll
      for (int r = 0; r < 16; ++r) acc[i][j][r] = 0.f;
}

template <class F>
DEV void acc_foreach(Acc& acc, int m0, int n0, F f) {
  asm volatile("s_nop 7\n\ts_nop 7\n\ts_nop 3" ::: "memory");
  const int tid = tidx_full();
  const int wave = tid >> 6, lane = tid & 63;
  const int wm = (wave >> 2) * 128, wn = (wave & 3) * 64;
  const int lr = lane & 31, lh = lane >> 5;
#pragma unroll
  for (int i = 0; i < 4; ++i)
#pragma unroll
    for (int j = 0; j < 2; ++j)
#pragma unroll
      for (int r = 0; r < 16; ++r) {
        const int m = m0 + wm + 32 * i + (r & 3) + 8 * (r >> 2) + 4 * lh;
        const int n = n0 + wn + 32 * j + lr;
        float v = acc[i][j][r];
        f(m, n, v);
        acc[i][j][r] = v;
      }
}

DEV bool tile_map(int iter, int ntm, int ntn, int& mt, int& nt) {
  int PM = 0, PN = 0;
  if (ntn == 18) { PM = 16; PN = 2; }
  else if (ntn == 128) { PM = 2; PN = 16; }
  else if (ntn == 16 || ntn == 4) { PM = 8; PN = 4; }
  if (gridDim.x == 256 && PM > 0 && (ntm % PM) == 0) {
    const int xcd = blockIdx.x & 7, slot = blockIdx.x >> 3;
    const int nsn = ntn / PN, nsuper = (ntm / PM) * nsn;
    const int s_ = iter * 8 + xcd;
    if (s_ >= nsuper) return false;
    const int sm = s_ / nsn, sn = s_ - sm * nsn;
    mt = sm * PM + slot / PN;
    nt = sn * PN + slot % PN;
    return true;
  }
  const int tile = blockIdx.x + iter * gridDim.x;
  if (tile >= ntm * ntn) return false;
  mt = tile / ntn;
  nt = tile - mt * ntn;
  return true;
}

DEV void prep_transpose_tile(const float* __restrict__ W, int K, int N, u16* __restrict__ WT, int tile, char* smem) {
  u16(*T)[66] = (u16(*)[66])smem;
  const int ntn = N / 64;
  const int k0 = (tile / ntn) * 64, n0 = (tile % ntn) * 64;
  const int tid = tidx();
  const int kr = tid >> 4, nc = (tid & 15) * 4;
  __syncthreads();
#pragma unroll
  for (int i = 0; i < 4; ++i) {
    const int k = kr + 16 * i;
    const float4 v = *(const float4*)(W + (long)(k0 + k) * N + n0 + nc);
    T[nc + 0][k] = f2bf(v.x);
    T[nc + 1][k] = f2bf(v.y);
    T[nc + 2][k] = f2bf(v.z);
    T[nc + 3][k] = f2bf(v.w);
  }
  __syncthreads();
  const int n = tid >> 2, kc = (tid & 3) * 16;
  unsigned o[8];
#pragma unroll
  for (int i = 0; i < 8; ++i) o[i] = (unsigned)T[n][kc + 2 * i] | ((unsigned)T[n][kc + 2 * i + 1] << 16);
  uint4* dst = (uint4*)(WT + (long)(n0 + n) * K + k0 + kc);
  dst[0] = make_uint4(o[0], o[1], o[2], o[3]);
  dst[1] = make_uint4(o[4], o[5], o[6], o[7]);
}

DEV void prep_mod_item(const Params& p, int item, char* smem) {
  float* sc = (float*)smem;
  float* red = (float*)(smem + 12 * 1024 * 4);
  __syncthreads();
  const int tid = tidx();
  for (int e = tid; e < 12 * 1024; e += 256) {
    const int b = e >> 10, k = e & 1023;
    const float c = (b < 8) ? p.in[I_CP][b * 1024 + k] : p.in[I_CS][(b - 8) * 1024 + k];
    sc[e] = silu_f(c);
  }
  __syncthreads();
  const int col = tid & 31, kg = tid >> 5;
  const int j = item * 32 + col;
  float acc[12];
#pragma unroll
  for (int b = 0; b < 12; ++b) acc[b] = 0.f;
  const float* W = p.in[I_ADAW];
  for (int kk = 0; kk < 128; ++kk) {
    const int k = kg * 128 + kk;
    const float w = W[(long)k * DIN + j];
#pragma unroll
    for (int b = 0; b < 12; ++b) acc[b] += sc[b * 1024 + k] * w;
  }
#pragma unroll
  for (int b = 0; b < 12; ++b) red[(kg * 12 + b) * 32 + col] = acc[b];
  __syncthreads();
  for (int e = tid; e < 12 * 32; e += 256) {
    const int b = e >> 5, c = e & 31;
    float s = p.in[I_ADAB][item * 32 + c];
#pragma unroll
    for (int g = 0; g < 8; ++g) s += red[(g * 12 + b) * 32 + c];
    ((float*)(p.ws + OFF_MOD))[b * DIN + item * 32 + c] = s;
  }
}

DEV void phase_prep(const Params& p, char* smem) {
  if (blockIdx.x == 0 && threadIdx.x < 64) ((unsigned*)(p.ws + OFF_CNT))[threadIdx.x] = 0u;
  for (int it = VBID; it < 4096 + 192; it += NVB) {
    if (it < 1536) prep_transpose_tile(p.in[I_WIN], 1024, 6144, (u16*)(p.ws + OFF_WIN), it, smem);
    else if (it < 1792) prep_transpose_tile(p.in[I_WBR], 1024, 1024, (u16*)(p.ws + OFF_WBR), it - 1536, smem);
    else if (it < 2048) prep_transpose_tile(p.in[I_WOUT], 1024, 1024, (u16*)(p.ws + OFF_WOUT), it - 1792, smem);
    else if (it < 3072) prep_transpose_tile(p.in[I_WFF1], 1024, 4096, (u16*)(p.ws + OFF_WFF1), it - 2048, smem);
    else if (it < 4096) prep_transpose_tile(p.in[I_WFF2], 4096, 1024, (u16*)(p.ws + OFF_WFF2), it - 3072, smem);
    else prep_mod_item(p, it - 4096, smem);
  }
}

DEV void phase_filter_mlp(const Params& p, char* smem) {
  float* z = (float*)smem;
  float* h1 = z + 4 * 36;
  float* h2 = h1 + 256;
  float* h3 = h2 + 256;
  const float* w1 = p.in[I_FW1];
  const float* b1 = p.in[I_FB1];
  const float* w2 = p.in[I_FW2];
  const float* b2 = p.in[I_FB2];
  const float* w3 = p.in[I_FW3];
  const float* b3 = p.in[I_FB3];
  const float* wo = p.in[I_FWO];
  const float* fr = p.in[I_FFREQ];
  float* hraw = (float*)(p.ws + OFF_HRAW);
  float* part = (float*)(p.ws + OFF_PART);
  const int tid = tidx();
  for (int it = VBID; it < 768; it += NVB) {
    const int g = (it < 256) ? 0 : 1;
    const int L = g ? 8192 : 4096;
    const int tbase = (g ? (it - 256) : it) * 16;
    const long rowbase = g ? 4096 : 0;
    float psum[4] = {0.f, 0.f, 0.f, 0.f};
    for (int rnd = 0; rnd < 4; ++rnd) {
      const int t0 = tbase + rnd * 4;
      __syncthreads();
      if (tid < 4 * 33) {
        const int pp = tid / 33, f = tid % 33;
        const int t = t0 + pp;
        float val;
        if (f == 0) val = (float)t / (float)(L - 1);
        else {
          const int j = (f - 1) & 15;
          const float fb = 1e-4f + (float)j * ((15.0f - 1e-4f) / 15.0f);
          const float w = 6.283185307179586f * (float)t / (float)L;
          val = (f <= 16) ? cosf(fb * w) : -sinf(fb * w);
        }
        z[pp * 36 + f] = val;
      }
      __syncthreads();
      const int pp = tid >> 6, u = tid & 63;
      {
        float s = b1[u];
        for (int k = 0; k < 33; ++k) s += z[pp * 36 + k] * w1[k * 64 + u];
        h1[pp * 64 + u] = sinf(fr[u] * s);
      }
      __syncthreads();
      {
        float s = b2[u];
        for (int k = 0; k < 64; ++k) s += h1[pp * 64 + k] * w2[k * 64 + u];
        h2[pp * 64 + u] = sinf(fr[64 + u] * s);
      }
      __syncthreads();
      {
        float s = b3[u];
        for (int k = 0; k < 64; ++k) s += h2[pp * 64 + k] * w3[k * 64 + u];
        h3[pp * 64 + u] = sinf(fr[128 + u] * s);
      }
      __syncthreads();
      float acc[4][4];
#pragma unroll
      for (int a = 0; a < 4; ++a)
#pragma unroll
        for (int q = 0; q < 4; ++q) acc[a][q] = 0.f;
      for (int k = 0; k < 64; ++k) {
        float wv[4];
#pragma unroll
        for (int q = 0; q < 4; ++q) wv[q] = wo[k * 1024 + tid + 256 * q];
#pragma unroll
        for (int a = 0; a < 4; ++a) {
          const float hv = h3[a * 64 + k];
#pragma unroll
          for (int q = 0; q < 4; ++q) acc[a][q] += hv * wv[q];
        }
      }
#pragma unroll
      for (int q = 0; q < 4; ++q) {
        const int c = tid + 256 * q;
        const int ch = c & 511;
        const float mind = -3.0701134573253943f, maxd = -15.350567286626972f;
        const float delta = fabsf(mind + (float)ch * ((maxd - mind) / 511.0f));
#pragma unroll
        for (int a = 0; a < 4; ++a) {
          const int t = t0 + a;
          const float tt = (float)t / (float)(L - 1);
          const float val = acc[a][q] * __expf(-tt * delta);
          hraw[(rowbase + t) * 1024 + c] = val;
          if (!(c >= 512 && t == 0)) psum[q] += fabsf(val);
        }
      }
    }
#pragma unroll
    for (int q = 0; q < 4; ++q) part[(long)it * 1024 + tid + 256 * q] = psum[q];
  }
}

DEV void phase_filter_norm(const Params& p, char* smem) {
  float* Tf = (float*)smem;
  float* Tb = Tf + 64 * 65;
  float* red = Tb + 64 * 65;
  float* nrm = red + 256;
  const float* hraw = (const float*)(p.ws + OFF_HRAW);
  const float* part = (const float*)(p.ws + OFF_PART);
  const int tid = tidx();
  for (int it = VBID; it < 512 + 1024; it += NVB) {
    const int g = (it < 512) ? 0 : 1;
    const int L = g ? 8192 : 4096;
    const int li = g ? it - 512 : it;
    const int ntt = L / 64;
    const int ct = li / ntt, tt = li % ntt;
    const long rowbase = g ? 4096 : 0;
    const int prow0 = g ? 256 : 0, nprow = g ? 512 : 256;
    u16* KK = (u16*)(p.ws + OFF_KK) + (g ? (size_t)512 * 8192 : 0);
    __syncthreads();
    {
      const int c = tid & 63, ph = tid >> 6;
      float s = 0.f;
      for (int r = ph; r < nprow; r += 4) {
        s += part[(long)(prow0 + r) * 1024 + ct * 64 + c];
        s += part[(long)(prow0 + r) * 1024 + 512 + ct * 64 + c];
      }
      red[ph * 64 + c] = s;
#pragma unroll
      for (int i = 0; i < 16; ++i) {
        const int r = ph + 4 * i;
        const long row = rowbase + tt * 64 + r;
        Tf[c * 65 + r] = hraw[row * 1024 + ct * 64 + c];
        Tb[c * 65 + r] = hraw[row * 1024 + 512 + ct * 64 + c];
      }
    }
    __syncthreads();
    if (tid < 64) nrm[tid] = red[tid] + red[64 + tid] + red[128 + tid] + red[192 + tid] + EPSF;
    __syncthreads();
    {
      const int c = tid >> 2, rq = (tid & 3) * 16;
      const float inv = 1.f / nrm[c];
      u16* row = KK + (size_t)(ct * 64 + c) * (2 * L);
#pragma unroll
      for (int i = 0; i < 16; ++i) {
        const int r = rq + i;
        const int t = tt * 64 + r;
        row[L - t] = f2bf(Tf[c * 65 + r] * inv);
        if (t >= 1) row[L + t] = f2bf(Tb[c * 65 + r] * inv);
      }
      if (tt == 0 && (tid & 3) == 0) row[0] = 0;
    }
  }
}

DEV void phase_norm_adaln(const float* __restrict__ X, const float* __restrict__ gvec, const float* __restrict__ mod,
                          int bg0, int L, int sh_off, int sc_off, u16* __restrict__ H) {
  const int tid = tidx();
  const int wave = tid >> 6, lane = tid & 63;
  constexpr int RB = 4;
  const int stride = NVB * 4;
  for (int row0 = VBID * 4 + wave; row0 < NTOK; row0 += stride * RB) {
    float4 v[RB][4];
    float ss[RB];
#pragma unroll
    for (int j = 0; j < RB; ++j) {
      const int row = row0 + j * stride;
      const float* x = X + (long)(row < NTOK ? row : row0) * D;
#pragma unroll
      for (int i = 0; i < 4; ++i) v[j][i] = *(const float4*)(x + lane * 4 + 256 * i);
    }
#pragma unroll
    for (int j = 0; j < RB; ++j) {
      float t = 0.f;
#pragma unroll
      for (int i = 0; i < 4; ++i) t += v[j][i].x * v[j][i].x + v[j][i].y * v[j][i].y + v[j][i].z * v[j][i].z + v[j][i].w * v[j][i].w;
      ss[j] = wave_sum(t);
    }
#pragma unroll
    for (int j = 0; j < RB; ++j) {
      const int row = row0 + j * stride;
      if (row < NTOK) {
        const float rstd = rsqrtf(ss[j] * (1.f / 1024.f) + EPSF);
        const float* mrow = mod + (long)(bg0 + row / L) * DIN;
#pragma unroll
        for (int i = 0; i < 4; ++i) {
          const int k = lane * 4 + 256 * i;
          const float4 g = *(const float4*)(gvec + k);
          const float4 sc = *(const float4*)(mrow + sc_off + k);
          const float4 sh = *(const float4*)(mrow + sh_off + k);
          const float o0 = v[j][i].x * rstd * g.x * (1.f + sc.x) + sh.x;
          const float o1 = v[j][i].y * rstd * g.y * (1.f + sc.y) + sh.y;
          const float o2 = v[j][i].z * rstd * g.z * (1.f + sc.z) + sh.z;
          const float o3 = v[j][i].w * rstd * g.w * (1.f + sc.w) + sh.w;
          *(uint2*)(H + (long)row * D + k) = make_uint2(pack2(o0, o1), pack2(o2, o3));
        }
      }
    }
  }
}

DEV void phase_final_norm(float* __restrict__ X, const float* __restrict__ gvec) {
  const int tid = tidx();
  const int wave = tid >> 6, lane = tid & 63;
  constexpr int RB = 4;
  const int stride = NVB * 4;
  for (int row0 = VBID * 4 + wave; row0 < NTOK; row0 += stride * RB) {
    float4 v[RB][4];
    float ss[RB];
#pragma unroll
    for (int j = 0; j < RB; ++j) {
      const int row = row0 + j * stride;
      const float* x = X + (long)(row < NTOK ? row : row0) * D;
#pragma unroll
      for (int i = 0; i < 4; ++i) v[j][i] = *(const float4*)(x + lane * 4 + 256 * i);
    }
#pragma unroll
    for (int j = 0; j < RB; ++j) {
      float t = 0.f;
#pragma unroll
      for (int i = 0; i < 4; ++i) t += v[j][i].x * v[j][i].x + v[j][i].y * v[j][i].y + v[j][i].z * v[j][i].z + v[j][i].w * v[j][i].w;
      ss[j] = wave_sum(t);
    }
#pragma unroll
    for (int j = 0; j < RB; ++j) {
      const int row = row0 + j * stride;
      if (row < NTOK) {
        const float rstd = rsqrtf(ss[j] * (1.f / 1024.f) + EPSF);
        float* x = X + (long)row * D;
#pragma unroll
        for (int i = 0; i < 4; ++i) {
          const int k = lane * 4 + 256 * i;
          const float4 g = *(const float4*)(gvec + k);
          *(float4*)(x + k) = make_float4(v[j][i].x * rstd * g.x, v[j][i].y * rstd * g.y, v[j][i].z * rstd * g.z, v[j][i].w * rstd * g.w);
        }
      }
    }
  }
}

DEV void norm_adaln_rows(const float* __restrict__ X, const float* __restrict__ gvec, const float* __restrict__ mod,
                         int bg0, int L, int sh_off, int sc_off, u16* __restrict__ H, int rbeg) {
  const int tid = tidx();
  const int wave = tid >> 6, lane = tid & 63;
  for (int jb = 0; jb < 16; jb += 4) {
    float4 v[4][4];
    float ss[4];
#pragma unroll
    for (int j = 0; j < 4; ++j) {
      const float* x = X + (long)(rbeg + wave + 4 * (jb + j)) * D;
#pragma unroll
      for (int i = 0; i < 4; ++i) v[j][i] = *(const float4*)(x + lane * 4 + 256 * i);
    }
#pragma unroll
    for (int j = 0; j < 4; ++j) {
      float t = 0.f;
#pragma unroll
      for (int i = 0; i < 4; ++i) t += v[j][i].x * v[j][i].x + v[j][i].y * v[j][i].y + v[j][i].z * v[j][i].z + v[j][i].w * v[j][i].w;
      ss[j] = wave_sum(t);
    }
#pragma unroll
    for (int j = 0; j < 4; ++j) {
      const int row = rbeg + wave + 4 * (jb + j);
      const float rstd = rsqrtf(ss[j] * (1.f / 1024.f) + EPSF);
      const float* mrow = mod + (long)(bg0 + row / L) * DIN;
#pragma unroll
      for (int i = 0; i < 4; ++i) {
        const int k = lane * 4 + 256 * i;
        const float4 g = *(const float4*)(gvec + k);
        const float4 sc = *(const float4*)(mrow + sc_off + k);
        const float4 sh = *(const float4*)(mrow + sh_off + k);
        const float o0 = v[j][i].x * rstd * g.x * (1.f + sc.x) + sh.x;
        const float o1 = v[j][i].y * rstd * g.y * (1.f + sc.y) + sh.y;
        const float o2 = v[j][i].z * rstd * g.z * (1.f + sc.z) + sh.z;
        const float o3 = v[j][i].w * rstd * g.w * (1.f + sc.w) + sh.w;
        *(uint2*)(H + (long)row * D + k) = make_uint2(pack2(o0, o1), pack2(o2, o3));
      }
    }
  }
}

DEV void final_norm_rows(float* __restrict__ X, const float* __restrict__ gvec, int rbeg) {
  const int tid = tidx();
  const int wave = tid >> 6, lane = tid & 63;
  for (int jb = 0; jb < 16; jb += 4) {
    float4 v[4][4];
    float ss[4];
#pragma unroll
    for (int j = 0; j < 4; ++j) {
      const float* x = X + (long)(rbeg + wave + 4 * (jb + j)) * D;
#pragma unroll
      for (int i = 0; i < 4; ++i) v[j][i] = *(const float4*)(x + lane * 4 + 256 * i);
    }
#pragma unroll
    for (int j = 0; j < 4; ++j) {
      float t = 0.f;
#pragma unroll
      for (int i = 0; i < 4; ++i) t += v[j][i].x * v[j][i].x + v[j][i].y * v[j][i].y + v[j][i].z * v[j][i].z + v[j][i].w * v[j][i].w;
      ss[j] = wave_sum(t);
    }
#pragma unroll
    for (int j = 0; j < 4; ++j) {
      float* x = X + (long)(rbeg + wave + 4 * (jb + j)) * D;
      const float rstd = rsqrtf(ss[j] * (1.f / 1024.f) + EPSF);
#pragma unroll
      for (int i = 0; i < 4; ++i) {
        const int k = lane * 4 + 256 * i;
        const float4 g = *(const float4*)(gvec + k);
        *(float4*)(x + k) = make_float4(v[j][i].x * rstd * g.x, v[j][i].y * rstd * g.y, v[j][i].z * rstd * g.z, v[j][i].w * rstd * g.w);
      }
    }
  }
}

DEV void phase_p1(const Params& p, int g, char* smem) {
  const int L = g ? 8192 : 4096;
  const u16* H = (const u16*)(p.out + (size_t)g * NTOK * D);
  const u16* WinT = (const u16*)(p.ws + OFF_WIN);
  u16* PHG = (u16*)(p.ws + OFF_PHG);
  u16* GT = (u16*)(p.ws + OFF_GT);
  u16* UHY = (u16*)(p.ws + OFF_UHY);
  {
    GemmPipe gp;
    gp.primed = false;
    for (int iter = 0;; ++iter) {
      int mt, nt, mtn, ntn;
      if (!tile_map(iter, 128, 18, mt, nt)) break;
      const bool more = tile_map(iter + 1, 128, 18, mtn, ntn);
      if (!more) { mtn = mt; ntn = nt; }
      Acc acc;
      acc_zero(acc);
      const int m0 = mt * 256, n0 = nt * 256;
      RowLoader al{H, 1024}, bl{WinT + (size_t)1536 * 1024, 1024};
      gemm_mainloop_p(acc, al, bl, m0, n0, mtn * 256, ntn * 256, 1024, smem, gp);
      gp.primed = more;
      if (n0 < 2560) {
        const bool dosilu = (n0 < 512) || (n0 >= 2048);
        acc_foreach(acc, m0, n0, [&](int m, int n, float& v) {
          const float o = dosilu ? silu_f(v) : v;
          PHG[(size_t)m * 2560 + n] = f2bf(o);
        });
      } else {
        acc_foreach(acc, m0, n0, [&](int m, int n, float& v) { GT[(size_t)m * 2048 + (n - 2560)] = f2bf(sigmoid_f(v)); });
      }
    }
  }
  {
    GemmPipe gp;
    gp.primed = false;
    for (int iter = 0;; ++iter) {
      int cm, tn, cmn, tnn;
      if (!tile_map(iter, 6, 128, cm, tn)) break;
      const bool more = tile_map(iter + 1, 6, 128, cmn, tnn);
      if (!more) { cmn = cm; tnn = tn; }
      Acc acc;
      acc_zero(acc);
      const int m0 = cm * 256, n0 = tn * 256;
      RowLoader al{WinT, 1024}, bl{H, 1024};
      gemm_mainloop_p(acc, al, bl, m0, n0, cmn * 256, tnn * 256, 1024, smem, gp);
      gp.primed = more;
      const int b = n0 / L, tb = n0 - b * L;
      u16* dst = UHY + (size_t)b * 1536 * L + tb - n0;
      acc_foreach(acc, m0, n0, [&](int m, int n, float& v) { dst[(size_t)m * L + n] = f2bf(v); });
    }
  }
}

DEV void phase_p15(const Params& p, int g) {
  const u16* PHG = (const u16*)(p.ws + OFF_PHG);
  u16* QK = (u16*)(p.out + (size_t)g * NTOK * D);
  u16* KT = (u16*)(p.ws + OFF_KT);
  float* DEC = (float*)(p.ws + OFF_DEC);
  for (int it = VBID; it < 1024; it += NVB) {
    const int tid = tidx();
    const int cidx = it >> 1, dir = it & 1;
    u16* Qp = QK + (size_t)(2 * dir) * NTOK * 512;
    u16* Kp = Qp + (size_t)NTOK * 512;
    float lb[2], G[2];
#pragma unroll
    for (int cc = 0; cc < 2; ++cc) {
      const int c = tid + 256 * cc;
      const float a0 = p.in[I_LB][(0 * 2 + dir) * 512 + c];
      const float a1 = p.in[I_LB][(1 * 2 + dir) * 512 + c];
      lb[cc] = 1.f / (1.f + __expf(a1 - a0));
      G[cc] = 0.f;
    }
    u16 xr[3][2][8], qr[3][2][8];
#define P15_LOAD(st_, j8_)                                                          \
    _Pragma("unroll") for (int e = 0; e < 8; ++e) {                                 \
      const int jj = (j8_) * 8 + e;                                                 \
      const int j = dir ? 63 - jj : jj;                                             \
      const size_t tok = (size_t)cidx * 64 + j;                                     \
      _Pragma("unroll") for (int cc = 0; cc < 2; ++cc) {                            \
        xr[st_][cc][e] = PHG[tok * 2560 + 1024 + 512 * dir + tid + 256 * cc];       \
        qr[st_][cc][e] = PHG[tok * 2560 + tid + 256 * cc];                          \
      }                                                                             \
    }
    P15_LOAD(0, 0);
    P15_LOAD(1, 1);
#pragma unroll
    for (int j8 = 0; j8 < 8; ++j8) {
      const int st = j8 % 3;
      if (j8 < 6) { P15_LOAD((j8 + 2) % 3, j8 + 2); }
#pragma unroll
      for (int cc = 0; cc < 2; ++cc) {
        const int c = tid + 256 * cc;
        unsigned kb[8];
#pragma unroll
        for (int e = 0; e < 8; ++e) {
          const int jj = j8 * 8 + e;
          const int j = dir ? 63 - jj : jj;
          const size_t tok = (size_t)cidx * 64 + j;
          const float f = lb[cc] + (1.f - lb[cc]) * sigmoid_f(bf2f(xr[st][cc][e]));
          G[cc] += __logf(f);
          const float eg = __expf(G[cc]), ig = __expf(-G[cc]);
          Qp[tok * 512 + c] = f2bf(bf2f(qr[st][cc][e]) * eg);
          const u16 kk = f2bf((1.f - f) * ig);
          Kp[tok * 512 + c] = kk;
          kb[e] = kk;
        }
        const int s0 = dir ? 56 - 8 * j8 : 8 * j8;
        uint4 w;
        w.x = dir ? (kb[7] | (kb[6] << 16)) : (kb[0] | (kb[1] << 16));
        w.y = dir ? (kb[5] | (kb[4] << 16)) : (kb[2] | (kb[3] << 16));
        w.z = dir ? (kb[3] | (kb[2] << 16)) : (kb[4] | (kb[5] << 16));
        w.w = dir ? (kb[1] | (kb[0] << 16)) : (kb[6] | (kb[7] << 16));
        *(uint4*)(KT + (((size_t)cidx * 2 + dir) * 512 + c) * 64 + s0) = w;
      }
    }
#undef P15_LOAD
#pragma unroll
    for (int cc = 0; cc < 2; ++cc) DEC[((size_t)dir * 512 + cidx) * 512 + tid + 256 * cc] = __expf(G[cc]);
  }
}

DEV void scan_item_mfma(const Params& p, int g, int item, char* smem) {
  const int L = g ? 8192 : 4096;
  const int NC = L / 64;
  const int vs = item & 3, dir = (item >> 2) & 1, h = (item >> 3) & 3, b = item >> 5;
  char* Qs = smem;
  char* Ks = Qs + 17408;
  char* KTs = Ks + 17408;
  char* Vts = KTs + 18432;
  char* Ps = Vts + 4608;
  char* Sts = Ps + 9216;
  float* decs = (float*)(Sts + 8704);
  u16* PHG = (u16*)(p.ws + OFF_PHG);
  const u16* QK = (const u16*)(p.out + (size_t)g * NTOK * D);
  const u16* Qp = QK + (size_t)(2 * dir) * NTOK * 512;
  const u16* Kp = Qp + (size_t)NTOK * 512;
  const u16* KT = (const u16*)(p.ws + OFF_KT);
  const float* DEC = (const float*)(p.ws + OFF_DEC);
  const int tid = tidx();
  const int wave = __builtin_amdgcn_readfirstlane(tid >> 6);
  const int lane = tid & 63, r = lane & 31, hh = lane >> 5;
  __syncthreads();
  for (int e = tid; e < 8704 / 16; e += 256) ((uint4*)Sts)[e] = make_uint4(0, 0, 0, 0);
  f32x16 accS[2];
#pragma unroll
  for (int t = 0; t < 2; ++t)
#pragma unroll
    for (int i = 0; i < 16; ++i) accS[t][i] = 0.f;
  const int ocol = (dir ? 1024 : 0) + h * 128 + vs * 32;

  uint4 q0, q1, q2, q3, k0, k1, k2, k3, t0, t1, t2, t3, vv;
  float dd = 0.f;
  const int qrow = tid >> 4, qc = tid & 15;
  const int trow = tid >> 3, tc = tid & 7;
  const int vrow = tid >> 2, vc = tid & 3;
#define SCAN_ISSUE(n_)                                                                                   \
  {                                                                                                      \
    const size_t cidx_ = (size_t)b * NC + (n_);                                                          \
    const size_t tok_ = cidx_ * 64;                                                                      \
    const u16* gq = Qp + (tok_ + qrow) * 512 + h * 128 + qc * 8;                                         \
    const u16* gk = Kp + (tok_ + qrow) * 512 + h * 128 + qc * 8;                                         \
    q0 = *(const uint4*)(gq); q1 = *(const uint4*)(gq + 16 * 512);                                       \
    q2 = *(const uint4*)(gq + 32 * 512); q3 = *(const uint4*)(gq + 48 * 512);                            \
    k0 = *(const uint4*)(gk); k1 = *(const uint4*)(gk + 16 * 512);                                       \
    k2 = *(const uint4*)(gk + 32 * 512); k3 = *(const uint4*)(gk + 48 * 512);                            \
    const u16* gt = KT + ((cidx_ * 2 + dir) * 512 + h * 128 + trow) * 64 + tc * 8;                       \
    t0 = *(const uint4*)(gt); t1 = *(const uint4*)(gt + 32 * 64);                                        \
    t2 = *(const uint4*)(gt + 64 * 64); t3 = *(const uint4*)(gt + 96 * 64);                              \
    vv = *(const uint4*)(PHG + (tok_ + vrow) * 2560 + 512 + h * 128 + vs * 32 + vc * 8);                 \
    dd = DEC[((size_t)dir * 512 + cidx_) * 512 + h * 128 + (tid & 127)];                                 \
  }
#define SCAN_BAR()                                        \
  {                                                       \
    asm volatile("s_waitcnt lgkmcnt(0)" ::: "memory");     \
    __builtin_amdgcn_s_barrier();                         \
    asm volatile("" ::: "memory");                         \
  }
  unsigned opk[8] = {0u, 0u, 0u, 0u, 0u, 0u, 0u, 0u};
  size_t otok = 0;
  SCAN_ISSUE(dir ? NC - 1 : 0);
  for (int ci = 0; ci < NC; ++ci) {
    const int n = dir ? NC - 1 - ci : ci;
    const size_t tok0 = ((size_t)b * NC + n) * 64;
    {
      char* d = Qs + qrow * 272 + qc * 16;
      *(uint4*)(d) = q0; *(uint4*)(d + 16 * 272) = q1; *(uint4*)(d + 32 * 272) = q2; *(uint4*)(d + 48 * 272) = q3;
      d = Ks + qrow * 272 + qc * 16;
      *(uint4*)(d) = k0; *(uint4*)(d + 16 * 272) = k1; *(uint4*)(d + 32 * 272) = k2; *(uint4*)(d + 48 * 272) = k3;
      d = KTs + trow * 144 + tc * 16;
      *(uint4*)(d) = t0; *(uint4*)(d + 32 * 144) = t1; *(uint4*)(d + 64 * 144) = t2; *(uint4*)(d + 96 * 144) = t3;
      st8t(Vts + (vc * 8) * 144 + vrow * 2, vv);
      if (tid < 128) decs[tid] = dd;
      if (wave < 2 && ci > 0) {
        u16* og = PHG + (otok + 32 * wave + 4 * hh) * 2560 + ocol + r;
#pragma unroll
        for (int i = 0; i < 8; ++i) {
          og[(size_t)(((2 * i) & 3) + 8 * ((2 * i) >> 2)) * 2560] = (u16)(opk[i] & 0xffffu);
          og[(size_t)(((2 * i + 1) & 3) + 8 * ((2 * i + 1) >> 2)) * 2560] = (u16)(opk[i] >> 16);
        }
      }
      if (wave >= 2 && ci > 0) {
#pragma unroll
        for (int t = 0; t < 2; ++t) {
          const int kt = 2 * (wave - 2) + t;
#pragma unroll
          for (int rg = 0; rg < 4; ++rg) {
            const int kk0 = 32 * kt + 8 * rg + 4 * hh;
            *(uint2*)(Sts + r * 272 + kk0 * 2) = make_uint2(pack2(accS[t][4 * rg + 0], accS[t][4 * rg + 1]),
                                                            pack2(accS[t][4 * rg + 2], accS[t][4 * rg + 3]));
          }
        }
      }
    }
    SCAN_BAR();
    {
      const int nn = (ci + 1 < NC) ? (dir ? NC - 2 - ci : ci + 1) : n;
      SCAN_ISSUE(nn);
    }
    __builtin_amdgcn_sched_barrier(0);
    {
      const int jt = wave >> 1, st = wave & 1;
      const bool active = dir ? (st >= jt) : (st <= jt);
      f32x16 pa;
#pragma unroll
      for (int i = 0; i < 16; ++i) pa[i] = 0.f;
      if (active) {
        bf16x8 qa[8], kb[8];
#pragma unroll
        for (int ks = 0; ks < 8; ++ks) {
          qa[ks] = *(const bf16x8*)(Qs + (32 * jt + r) * 272 + ks * 32 + hh * 16);
          kb[ks] = *(const bf16x8*)(Ks + (32 * st + r) * 272 + ks * 32 + hh * 16);
        }
        __builtin_amdgcn_sched_barrier(0);
        f32x16 p1;
#pragma unroll
        for (int i = 0; i < 16; ++i) p1[i] = 0.f;
#pragma unroll
        for (int ks = 0; ks < 4; ++ks) {
          pa = __builtin_amdgcn_mfma_f32_32x32x16_bf16(qa[2 * ks], kb[2 * ks], pa, 0, 0, 0);
          p1 = __builtin_amdgcn_mfma_f32_32x32x16_bf16(qa[2 * ks + 1], kb[2 * ks + 1], p1, 0, 0, 0);
        }
#pragma unroll
        for (int i = 0; i < 16; ++i) pa[i] += p1[i];
      }
#pragma unroll
      for (int i = 0; i < 16; ++i) {
        const int j = 32 * jt + (i & 3) + 8 * (i >> 2) + 4 * hh;
        const int s_ = 32 * st + r;
        const bool keep = dir ? (s_ >= j) : (s_ <= j);
        *(u16*)(Ps + j * 144 + s_ * 2) = keep ? f2bf(pa[i]) : (u16)0;
      }
    }
    SCAN_BAR();
    if (wave < 2) {
      const int jt = wave;
      bf16x8 pp[4], vb[4], qa[4], sb[4];
#pragma unroll
      for (int ks = 0; ks < 4; ++ks) {
        pp[ks] = *(const bf16x8*)(Ps + (32 * jt + r) * 144 + ks * 32 + hh * 16);
        vb[ks] = *(const bf16x8*)(Vts + r * 144 + ks * 32 + hh * 16);
        qa[ks] = *(const bf16x8*)(Qs + (32 * jt + r) * 272 + ks * 32 + hh * 16);
        sb[ks] = *(const bf16x8*)(Sts + r * 272 + ks * 32 + hh * 16);
      }
      __builtin_amdgcn_sched_barrier(0);
      f32x16 o, o1;
#pragma unroll
      for (int i = 0; i < 16; ++i) { o[i] = 0.f; o1[i] = 0.f; }
#pragma unroll
      for (int ks = 0; ks < 4; ++ks) {
        o = __builtin_amdgcn_mfma_f32_32x32x16_bf16(pp[ks], vb[ks], o, 0, 0, 0);
        o1 = __builtin_amdgcn_mfma_f32_32x32x16_bf16(qa[ks], sb[ks], o1, 0, 0, 0);
      }
      __builtin_amdgcn_sched_barrier(0);
#pragma unroll
      for (int ks = 0; ks < 4; ++ks) {
        qa[ks] = *(const bf16x8*)(Qs + (32 * jt + r) * 272 + (ks + 4) * 32 + hh * 16);
        sb[ks] = *(const bf16x8*)(Sts + r * 272 + (ks + 4) * 32 + hh * 16);
      }
      __builtin_amdgcn_sched_barrier(0);
      o = __builtin_amdgcn_mfma_f32_32x32x16_bf16(qa[0], sb[0], o, 0, 0, 0);
      o1 = __builtin_amdgcn_mfma_f32_32x32x16_bf16(qa[1], sb[1], o1, 0, 0, 0);
      o = __builtin_amdgcn_mfma_f32_32x32x16_bf16(qa[2], sb[2], o, 0, 0, 0);
      o1 = __builtin_amdgcn_mfma_f32_32x32x16_bf16(qa[3], sb[3], o1, 0, 0, 0);
      f32x16 o2;
#pragma unroll
      for (int i = 0; i < 16; ++i) o2[i] = 0.f;
#pragma unroll
      for (int i = 0; i < 8; ++i)
        opk[i] = pack2(o[2 * i] + o1[2 * i] + o2[2 * i], o[2 * i + 1] + o1[2 * i + 1] + o2[2 * i + 1]);
      otok = tok0;
    } else {
      const int kt0 = 2 * (wave - 2);
      bf16x8 ka[2][4], vb[4];
#pragma unroll
      for (int ks = 0; ks < 4; ++ks) {
        vb[ks] = *(const bf16x8*)(Vts + r * 144 + ks * 32 + hh * 16);
        ka[0][ks] = *(const bf16x8*)(KTs + (32 * kt0 + r) * 144 + ks * 32 + hh * 16);
        ka[1][ks] = *(const bf16x8*)(KTs + (32 * (kt0 + 1) + r) * 144 + ks * 32 + hh * 16);
      }
      __builtin_amdgcn_sched_barrier(0);
#pragma unroll
      for (int ks = 0; ks < 4; ++ks) {
        accS[0] = __builtin_amdgcn_mfma_f32_32x32x16_bf16(ka[0][ks], vb[ks], accS[0], 0, 0, 0);
        accS[1] = __builtin_amdgcn_mfma_f32_32x32x16_bf16(ka[1][ks], vb[ks], accS[1], 0, 0, 0);
      }
#pragma unroll
      for (int t = 0; t < 2; ++t)
#pragma unroll
        for (int i = 0; i < 16; ++i) accS[t][i] *= decs[32 * (kt0 + t) + (i & 3) + 8 * (i >> 2) + 4 * hh];
    }
    SCAN_BAR();
  }
  if (wave < 2) {
    u16* og = PHG + (otok + 32 * wave + 4 * hh) * 2560 + ocol + r;
#pragma unroll
    for (int i = 0; i < 8; ++i) {
      og[(size_t)(((2 * i) & 3) + 8 * ((2 * i) >> 2)) * 2560] = (u16)(opk[i] & 0xffffu);
      og[(size_t)(((2 * i + 1) & 3) + 8 * ((2 * i + 1) >> 2)) * 2560] = (u16)(opk[i] >> 16);
    }
  }
#undef SCAN_ISSUE
#undef SCAN_BAR
}

DEV float conv3_at(const u16* __restrict__ row, int t, int L, float w0, float w1, float w2, float bb) {
  const float um = (t > 0) ? bf2f(row[t - 1]) : 0.f;
  const float u0 = bf2f(row[t]);
  const float up = (t < L - 1) ? bf2f(row[t + 1]) : 0.f;
  return um * w0 + u0 * w1 + up * w2 + bb;
}

struct F8 { float v[8]; };
DEV F8 conv8(const u16* __restrict__ row, int t, int L, float w0, float w1, float w2, float bb) {
  const uint4 u = *(const uint4*)(row + t);
  const float um = (t > 0) ? bf2f(row[t - 1]) : 0.f;
  const float up = (t + 8 < L) ? bf2f(row[t + 8]) : 0.f;
  float x[10];
  x[0] = um;
  x[1] = bflo(u.x); x[2] = bfhi(u.x); x[3] = bflo(u.y); x[4] = bfhi(u.y);
  x[5] = bflo(u.z); x[6] = bfhi(u.z); x[7] = bflo(u.w); x[8] = bfhi(u.w);
  x[9] = up;
  F8 o;
#pragma unroll
  for (int j = 0; j < 8; ++j) o.v[j] = x[j] * w0 + x[j + 1] * w1 + x[j + 2] * w2 + bb;
  return o;
}

template <int BG>
DEV void hyena_item_mfma(const Params& p, int g, int item, char* smem, int half) {
  constexpr int NT = 256 / BG;
  constexpr int L = NT * 64;
  constexpr int VROW = 144;
  constexpr int RK1 = 4 * L + 64;
  constexpr int VBASE = 2 * (4 * L + 64);
  const int c = item >> 1, bgi = item & 1;
  char* Vl = smem + VBASE + half * (257 * VROW);
  u16* UHY = (u16*)(p.ws + OFF_UHY);
  const u16* RK = (const u16*)(p.ws + OFF_KK) + (g ? (size_t)512 * 8192 : 0) + (size_t)c * 2 * L;
  const float* cw = p.in[I_CONVW];
  const float* cb = p.in[I_CONVB];
  const int tid = tidx();
  __syncthreads();
  if (half == 0) {
#pragma unroll 8
    for (int e = tid; e < 2 * L / 8; e += 256) ((uint4*)smem)[e] = ((const uint4*)RK)[e];
  } else {
#pragma unroll 4
    for (int e = tid; e < 2 * L / 8; e += 256) {
      const uint4 v = ((const uint4*)RK)[e];
      const unsigned nx = (8 * e + 8 < 2 * L) ? (unsigned)RK[8 * e + 8] : 0u;
      uint4 o;
      o.x = (v.x >> 16) | (v.y << 16);
      o.y = (v.y >> 16) | (v.z << 16);
      o.z = (v.z >> 16) | (v.w << 16);
      o.w = (v.w >> 16) | (nx << 16);
      ((uint4*)(smem + RK1))[e] = o;
    }
  }
  {
    const float wx1_0 = cw[0 * 1536 + 512 + c], wx1_1 = cw[1 * 1536 + 512 + c], wx1_2 = cw[2 * 1536 + 512 + c], bx1 = cb[512 + c];
    const float wv_0 = cw[0 * 1536 + 1024 + c], wv_1 = cw[1 * 1536 + 1024 + c], wv_2 = cw[2 * 1536 + 1024 + c], bv = cb[1024 + c];
#pragma unroll 4
    for (int e = tid; e < BG * L / 8; e += 256) {
      const int bl = e / (L / 8), t = (e % (L / 8)) * 8;
      const int b = bgi * BG + bl;
      const F8 a = conv8(UHY + ((size_t)b * 1536 + 1024 + c) * L, t, L, wv_0, wv_1, wv_2, bv);
      const F8 x = conv8(UHY + ((size_t)b * 1536 + 512 + c) * L, t, L, wx1_0, wx1_1, wx1_2, bx1);
      *(uint4*)(Vl + ((t >> 6) * BG + bl) * VROW + (t & 63) * 2) =
          make_uint4(pack2(a.v[0] * x.v[0], a.v[1] * x.v[1]), pack2(a.v[2] * x.v[2], a.v[3] * x.v[3]),
                     pack2(a.v[4] * x.v[4], a.v[5] * x.v[5]), pack2(a.v[6] * x.v[6], a.v[7] * x.v[7]));
    }
  }
  if (tid < 9) *(uint4*)(Vl + 256 * VROW + tid * 16) = make_uint4(0u, 0u, 0u, 0u);
  __syncthreads();
  const int wave = tid >> 6, lane = tid & 63;
  const int n = lane & 31, hh = lane >> 5;
  Acc acc;
  acc_zero(acc);
  const int colw = wave * 64;
  {
    typedef __attribute__((ext_vector_type(2))) unsigned u32x2;
    typedef __attribute__((ext_vector_type(4))) unsigned u32x4;
    struct HySet {
      u32x2 wlo[6], whi[6];
      u32x4 bv[2][4];
      bool valid[2];
    };
    const int Tw0 = colw / BG;
    const int dlo = Tw0 - NT + 1, dhi = Tw0 + 64 / BG - 1;
    const int par = n & 1;
    const unsigned pkb = (unsigned)(size_t)smem + (par ? RK1 : 0) + 2u * (unsigned)(L - n + 8 * hh - 32 - par);
    const unsigned vlb = (unsigned)(size_t)Vl;
#define HY_PREP(Y_, dl_)                                              \
    const unsigned pabY_ = pkb - 128u * (unsigned)(dl_);               \
    unsigned pbY0_;                                                    \
    {                                                                  \
      const int col = colw + 0 + n;                                   \
      const int S = col / BG - (dl_);                                  \
      Y_.valid[0] = (unsigned)S < (unsigned)NT;                        \
      const int scol = Y_.valid[0] ? col - (dl_) * BG : 256;           \
      pbY0_ = vlb + (unsigned)(scol * VROW + hh * 16);                 \
    }                                                                  \
    unsigned pbY1_;                                                    \
    {                                                                  \
      const int col = colw + 32 + n;                                   \
      const int S = col / BG - (dl_);                                  \
      Y_.valid[1] = (unsigned)S < (unsigned)NT;                        \
      const int scol = Y_.valid[1] ? col - (dl_) * BG : 256;           \
      pbY1_ = vlb + (unsigned)(scol * VROW + hh * 16);                 \
    }                                                                  \

#define HY_ISSUE0(Y_, dl_)                                            \
    {                                                                  \
      HY_PREP(Y_, dl_)                                                 \
      asm volatile("ds_read2_b32 %0, %1 offset0:0 offset1:1" : "=v"(Y_.wlo[0]) : "v"(pabY_));  \
      asm volatile("ds_read2_b32 %0, %1 offset0:2 offset1:3" : "=v"(Y_.whi[0]) : "v"(pabY_));  \
      asm volatile("ds_read2_b32 %0, %1 offset0:8 offset1:9" : "=v"(Y_.wlo[1]) : "v"(pabY_));  \
      asm volatile("ds_read2_b32 %0, %1 offset0:10 offset1:11" : "=v"(Y_.whi[1]) : "v"(pabY_));  \
      asm volatile("ds_read2_b32 %0, %1 offset0:16 offset1:17" : "=v"(Y_.wlo[2]) : "v"(pabY_));  \
      asm volatile("ds_read2_b32 %0, %1 offset0:18 offset1:19" : "=v"(Y_.whi[2]) : "v"(pabY_));  \
      asm volatile("ds_read2_b32 %0, %1 offset0:24 offset1:25" : "=v"(Y_.wlo[3]) : "v"(pabY_));  \
      asm volatile("ds_read2_b32 %0, %1 offset0:26 offset1:27" : "=v"(Y_.whi[3]) : "v"(pabY_));  \
      asm volatile("ds_read2_b32 %0, %1 offset0:32 offset1:33" : "=v"(Y_.wlo[4]) : "v"(pabY_));  \
      asm volatile("ds_read2_b32 %0, %1 offset0:34 offset1:35" : "=v"(Y_.whi[4]) : "v"(pabY_));  \
      asm volatile("ds_read2_b32 %0, %1 offset0:40 offset1:41" : "=v"(Y_.wlo[5]) : "v"(pabY_));  \
      asm volatile("ds_read2_b32 %0, %1 offset0:42 offset1:43" : "=v"(Y_.whi[5]) : "v"(pabY_));  \
      asm volatile("ds_read_b128 %0, %1 offset:0" : "=v"(Y_.bv[0][0]) : "v"(pbY0_));  \
      asm volatile("ds_read_b128 %0, %1 offset:32" : "=v"(Y_.bv[0][1]) : "v"(pbY0_));  \
      asm volatile("ds_read_b128 %0, %1 offset:64" : "=v"(Y_.bv[0][2]) : "v"(pbY0_));  \
      asm volatile("ds_read_b128 %0, %1 offset:96" : "=v"(Y_.bv[0][3]) : "v"(pbY0_));  \
      asm volatile("ds_read_b128 %0, %1 offset:0" : "=v"(Y_.bv[1][0]) : "v"(pbY1_));  \
      asm volatile("ds_read_b128 %0, %1 offset:32" : "=v"(Y_.bv[1][1]) : "v"(pbY1_));  \
      asm volatile("ds_read_b128 %0, %1 offset:64" : "=v"(Y_.bv[1][2]) : "v"(pbY1_));  \
      asm volatile("ds_read_b128 %0, %1 offset:96" : "=v"(Y_.bv[1][3]) : "v"(pbY1_));  \
    }

#define HY_STEP(X_, Y_, dl_)                                          \
    {                                                                  \
      HY_PREP(Y_, dl_)                                                 \
      bf16x8 a[6];                                                     \
      _Pragma("unroll") for (int q = 0; q < 6; ++q) {                  \
        const u32x4 t = {X_.wlo[q][0], X_.wlo[q][1], X_.whi[q][0], X_.whi[q][1]}; \
        a[q] = __builtin_bit_cast(bf16x8, t);                          \
      }                                                                \
      {                                                                \
        u32x4 bq = X_.bv[0][0];                                        \
        const bf16x8 bb = __builtin_bit_cast(bf16x8, bq);              \
        __builtin_amdgcn_sched_barrier(0);                             \
        asm volatile("ds_read2_b32 %0, %1 offset0:0 offset1:1" : "=v"(Y_.wlo[0]) : "v"(pabY_));  \
        asm volatile("ds_read2_b32 %0, %1 offset0:2 offset1:3" : "=v"(Y_.whi[0]) : "v"(pabY_));  \
        __builtin_amdgcn_sched_barrier(0);                             \
        asm volatile("s_nop 1\n\tv_mfma_f32_32x32x16_bf16 %0, %1, %2, %0" : "+v"(acc[0][0]) : "v"(a[2]), "v"(bb)); \
        __builtin_amdgcn_sched_barrier(0);                             \
        asm volatile("ds_read2_b32 %0, %1 offset0:8 offset1:9" : "=v"(Y_.wlo[1]) : "v"(pabY_));  \
        asm volatile("ds_read2_b32 %0, %1 offset0:10 offset1:11" : "=v"(Y_.whi[1]) : "v"(pabY_));  \
        __builtin_amdgcn_sched_barrier(0);                             \
        asm volatile("s_nop 1\n\tv_mfma_f32_32x32x16_bf16 %0, %1, %2, %0" : "+v"(acc[0][1]) : "v"(a[0]), "v"(bb)); \
      }                                                                \
      {                                                                \
        u32x4 bq = X_.bv[0][1];                                        \
        const bf16x8 bb = __builtin_bit_cast(bf16x8, bq);              \
        __builtin_amdgcn_sched_barrier(0);                             \
        asm volatile("ds_read2_b32 %0, %1 offset0:16 offset1:17" : "=v"(Y_.wlo[2]) : "v"(pabY_));  \
        asm volatile("ds_read2_b32 %0, %1 offset0:18 offset1:19" : "=v"(Y_.whi[2]) : "v"(pabY_));  \
        __builtin_amdgcn_sched_barrier(0);                             \
        asm volatile("s_nop 1\n\tv_mfma_f32_32x32x16_bf16 %0, %1, %2, %0" : "+v"(acc[0][0]) : "v"(a[3]), "v"(bb)); \
        __builtin_amdgcn_sched_barrier(0);                             \
        asm volatile("ds_read2_b32 %0, %1 offset0:24 offset1:25" : "=v"(Y_.wlo[3]) : "v"(pabY_));  \
        asm volatile("ds_read2_b32 %0, %1 offset0:26 offset1:27" : "=v"(Y_.whi[3]) : "v"(pabY_));  \
        __builtin_amdgcn_sched_barrier(0);                             \
        asm volatile("s_nop 1\n\tv_mfma_f32_32x32x16_bf16 %0, %1, %2, %0" : "+v"(acc[0][1]) : "v"(a[1]), "v"(bb)); \
      }                                                                \
      {                                                                \
        u32x4 bq = X_.bv[0][2];                                        \
        const bf16x8 bb = __builtin_bit_cast(bf16x8, bq);              \
        __builtin_amdgcn_sched_barrier(0);                             \
        asm volatile("ds_read2_b32 %0, %1 offset0:32 offset1:33" : "=v"(Y_.wlo[4]) : "v"(pabY_));  \
        asm volatile("ds_read2_b32 %0, %1 offset0:34 offset1:35" : "=v"(Y_.whi[4]) : "v"(pabY_));  \
        __builtin_amdgcn_sched_barrier(0);                             \
        asm volatile("s_nop 1\n\tv_mfma_f32_32x32x16_bf16 %0, %1, %2, %0" : "+v"(acc[0][0]) : "v"(a[4]), "v"(bb)); \
        __builtin_amdgcn_sched_barrier(0);                             \
        asm volatile("ds_read2_b32 %0, %1 offset0:40 offset1:41" : "=v"(Y_.wlo[5]) : "v"(pabY_));  \
        asm volatile("ds_read2_b32 %0, %1 offset0:42 offset1:43" : "=v"(Y_.whi[5]) : "v"(pabY_));  \
        __builtin_amdgcn_sched_barrier(0);                             \
        asm volatile("s_nop 1\n\tv_mfma_f32_32x32x16_bf16 %0, %1, %2, %0" : "+v"(acc[0][1]) : "v"(a[2]), "v"(bb)); \
      }                                                                \
      {                                                                \
        u32x4 bq = X_.bv[0][3];                                        \
        const bf16x8 bb = __builtin_bit_cast(bf16x8, bq);              \
        __builtin_amdgcn_sched_barrier(0);                             \
        asm volatile("ds_read_b128 %0, %1 offset:0" : "=v"(Y_.bv[0][0]) : "v"(pbY0_));  \
        asm volatile("ds_read_b128 %0, %1 offset:32" : "=v"(Y_.bv[0][1]) : "v"(pbY0_));  \
        __builtin_amdgcn_sched_barrier(0);                             \
        asm volatile("s_nop 1\n\tv_mfma_f32_32x32x16_bf16 %0, %1, %2, %0" : "+v"(acc[0][0]) : "v"(a[5]), "v"(bb)); \
        __builtin_amdgcn_sched_barrier(0);                             \
        asm volatile("ds_read_b128 %0, %1 offset:64" : "=v"(Y_.bv[0][2]) : "v"(pbY0_));  \
        asm volatile("ds_read_b128 %0, %1 offset:96" : "=v"(Y_.bv[0][3]) : "v"(pbY0_));  \
        __builtin_amdgcn_sched_barrier(0);                             \
        asm volatile("s_nop 1\n\tv_mfma_f32_32x32x16_bf16 %0, %1, %2, %0" : "+v"(acc[0][1]) : "v"(a[3]), "v"(bb)); \
      }                                                                \
      {                                                                \
        u32x4 bq = X_.bv[1][0];                                        \
        const bf16x8 bb = __builtin_bit_cast(bf16x8, bq);              \
        __builtin_amdgcn_sched_barrier(0);                             \
        asm volatile("ds_read_b128 %0, %1 offset:0" : "=v"(Y_.bv[1][0]) : "v"(pbY1_));  \
        asm volatile("ds_read_b128 %0, %1 offset:32" : "=v"(Y_.bv[1][1]) : "v"(pbY1_));  \
        __builtin_amdgcn_sched_barrier(0);                             \
        asm volatile("s_nop 1\n\tv_mfma_f32_32x32x16_bf16 %0, %1, %2, %0" : "+v"(acc[1][0]) : "v"(a[2]), "v"(bb)); \
        __builtin_amdgcn_sched_barrier(0);                             \
        asm volatile("ds_read_b128 %0, %1 offset:64" : "=v"(Y_.bv[1][2]) : "v"(pbY1_));  \
        asm volatile("ds_read_b128 %0, %1 offset:96" : "=v"(Y_.bv[1][3]) : "v"(pbY1_));  \
        __builtin_amdgcn_sched_barrier(0);                             \
        asm volatile("s_nop 1\n\tv_mfma_f32_32x32x16_bf16 %0, %1, %2, %0" : "+v"(acc[1][1]) : "v"(a[0]), "v"(bb)); \
      }                                                                \
      {                                                                \
        u32x4 bq = X_.bv[1][1];                                        \
        const bf16x8 bb = __builtin_bit_cast(bf16x8, bq);              \
        __builtin_amdgcn_sched_barrier(0);                             \
        __builtin_amdgcn_sched_barrier(0);                             \
        asm volatile("s_nop 1\n\tv_mfma_f32_32x32x16_bf16 %0, %1, %2, %0" : "+v"(acc[1][0]) : "v"(a[3]), "v"(bb)); \
        __builtin_amdgcn_sched_barrier(0);                             \
        __builtin_amdgcn_sched_barrier(0);                             \
        asm volatile("s_nop 1\n\tv_mfma_f32_32x32x16_bf16 %0, %1, %2, %0" : "+v"(acc[1][1]) : "v"(a[1]), "v"(bb)); \
      }                                                                \
      {                                                                \
        u32x4 bq = X_.bv[1][2];                                        \
        const bf16x8 bb = __builtin_bit_cast(bf16x8, bq);              \
        __builtin_amdgcn_sched_barrier(0);                             \
        __builtin_amdgcn_sched_barrier(0);                             \
        asm volatile("s_nop 1\n\tv_mfma_f32_32x32x16_bf16 %0, %1, %2, %0" : "+v"(acc[1][0]) : "v"(a[4]), "v"(bb)); \
        __builtin_amdgcn_sched_barrier(0);                             \
        __builtin_amdgcn_sched_barrier(0);                             \
        asm volatile("s_nop 1\n\tv_mfma_f32_32x32x16_bf16 %0, %1, %2, %0" : "+v"(acc[1][1]) : "v"(a[2]), "v"(bb)); \
      }                                                                \
      {                                                                \
        u32x4 bq = X_.bv[1][3];                                        \
        const bf16x8 bb = __builtin_bit_cast(bf16x8, bq);              \
        __builtin_amdgcn_sched_barrier(0);                             \
        __builtin_amdgcn_sched_barrier(0);                             \
        asm volatile("s_nop 1\n\tv_mfma_f32_32x32x16_bf16 %0, %1, %2, %0" : "+v"(acc[1][0]) : "v"(a[5]), "v"(bb)); \
        __builtin_amdgcn_sched_barrier(0);                             \
        __builtin_amdgcn_sched_barrier(0);                             \
        asm volatile("s_nop 1\n\tv_mfma_f32_32x32x16_bf16 %0, %1, %2, %0" : "+v"(acc[1][1]) : "v"(a[3]), "v"(bb)); \
      }                                                                \
    }

#define HY_COMPUTE(X_)                                                \
    {                                                                  \
      bf16x8 a[6];                                                     \
      _Pragma("unroll") for (int q = 0; q < 6; ++q) {                  \
        const u32x4 t = {X_.wlo[q][0], X_.wlo[q][1], X_.whi[q][0], X_.whi[q][1]}; \
        a[q] = __builtin_bit_cast(bf16x8, t);                          \
      }                                                                \
      _Pragma("unroll") for (int nt = 0; nt < 2; ++nt) {               \
        _Pragma("unroll") for (int ks = 0; ks < 4; ++ks) {             \
          u32x4 bq = X_.bv[nt][ks];                                    \
          const bf16x8 bb = __builtin_bit_cast(bf16x8, bq);            \
          acc[nt][0] = __builtin_amdgcn_mfma_f32_32x32x16_bf16(a[ks + 2], bb, acc[nt][0], 0, 0, 0); \
          acc[nt][1] = __builtin_amdgcn_mfma_f32_32x32x16_bf16(a[ks], bb, acc[nt][1], 0, 0, 0);     \
        }                                                              \
      }                                                                \
    }
#define HY_WAIT(S_) asm volatile("s_waitcnt lgkmcnt(0)" : "+v"(S_.wlo[0]), "+v"(S_.whi[0]), "+v"(S_.wlo[1]), "+v"(S_.whi[1]), "+v"(S_.wlo[2]), "+v"(S_.whi[2]), "+v"(S_.wlo[3]), "+v"(S_.whi[3]), "+v"(S_.wlo[4]), "+v"(S_.whi[4]), "+v"(S_.wlo[5]), "+v"(S_.whi[5]), "+v"(S_.bv[0][0]), "+v"(S_.bv[0][1]), "+v"(S_.bv[0][2]), "+v"(S_.bv[0][3]), "+v"(S_.bv[1][0]), "+v"(S_.bv[1][1]), "+v"(S_.bv[1][2]), "+v"(S_.bv[1][3]) :: "memory")
    HySet s0, s1;
    HY_ISSUE0(s0, dlo);
    int dl = dlo;
    for (; dl + 1 <= dhi; dl += 2) {
      HY_WAIT(s0);
      HY_STEP(s0, s1, dl + 1);
      __builtin_amdgcn_sched_barrier(0);
      HY_WAIT(s1);
      {
        const int d2 = (dl + 2 <= dhi) ? dl + 2 : dhi;
        HY_STEP(s1, s0, d2);
      }
      __builtin_amdgcn_sched_barrier(0);
    }
    if (dl == dhi) {
      HY_WAIT(s0);
      HY_COMPUTE(s0);
    }
    asm volatile("s_waitcnt lgkmcnt(0)" ::: "memory");
#undef HY_PREP
#undef HY_ISSUE0
#undef HY_STEP
#undef HY_COMPUTE
#undef HY_WAIT
  }
  __syncthreads();
  {
    const float fbias = p.in[I_FBIAS][c];
#pragma unroll
    for (int nt = 0; nt < 2; ++nt)
#pragma unroll
      for (int mi = 0; mi < 2; ++mi)
#pragma unroll
        for (int rg = 0; rg < 4; ++rg) {
          const int col = colw + 32 * nt + n, i0 = 32 * mi + 8 * rg + 4 * hh;
          char* pv = Vl + col * VROW + i0 * 2;
          const uint2 w = *(const uint2*)pv;
          const float t0 = acc[nt][mi][4 * rg + 0] + bflo(w.x) * fbias;
          const float t1 = acc[nt][mi][4 * rg + 1] + bfhi(w.x) * fbias;
          const float t2 = acc[nt][mi][4 * rg + 2] + bflo(w.y) * fbias;
          const float t3 = acc[nt][mi][4 * rg + 3] + bfhi(w.y) * fbias;
          *(uint2*)pv = make_uint2(pack2(t0, t1), pack2(t2, t3));
        }
  }
  __syncthreads();
  {
    const float wx0_0 = cw[0 * 1536 + c], wx0_1 = cw[1 * 1536 + c], wx0_2 = cw[2 * 1536 + c], bx0 = cb[c];
    for (int e0 = tid; e0 < BG * L / 8; e0 += 256 * 4) {
      F8 x[4];
      uint4 y[4];
#pragma unroll
      for (int u = 0; u < 4; ++u) {
        const int e = e0 + 256 * u;
        const int bl = e / (L / 8), t = (e % (L / 8)) * 8;
        const int b = bgi * BG + bl;
        x[u] = conv8(UHY + ((size_t)b * 1536 + c) * L, t, L, wx0_0, wx0_1, wx0_2, bx0);
        y[u] = *(const uint4*)(Vl + ((t >> 6) * BG + bl) * VROW + (t & 63) * 2);
      }
#pragma unroll
      for (int u = 0; u < 4; ++u) {
        const int e = e0 + 256 * u;
        const int bl = e / (L / 8), t = (e % (L / 8)) * 8;
        const int b = bgi * BG + bl;
        *(uint4*)(UHY + ((size_t)b * 1536 + 1024 + c) * L + t) =
            make_uint4(pack2(bflo(y[u].x) * x[u].v[0], bfhi(y[u].x) * x[u].v[1]), pack2(bflo(y[u].y) * x[u].v[2], bfhi(y[u].y) * x[u].v[3]),
                       pack2(bflo(y[u].z) * x[u].v[4], bfhi(y[u].z) * x[u].v[5]), pack2(bflo(y[u].w) * x[u].v[6], bfhi(y[u].w) * x[u].v[7]));
      }
    }
  }
}

DEV void phase_p2_naive(const Params& p, int g, char* hsm) {
  __shared__ int s_item;
  const int nscan = g ? 128 : 256;
  const int nhy = 1024;
  unsigned* cnt = (unsigned*)(p.ws + OFF_CNT) + g;
  const int half = vhalf();
  if ((int)blockIdx.x * 2 < nscan) scan_item_mfma(p, g, blockIdx.x * 2 + half, hsm);
  for (;;) {
    __syncthreads();
    if (threadIdx.x == 0) s_item = (int)atomicAdd(cnt, 2u);
    __syncthreads();
    const int it = s_item + half;
    if (it >= nhy) break;
    if (g == 0) hyena_item_mfma<4>(p, g, it, hsm - half * HALF_BYTES, half);
    else hyena_item_mfma<2>(p, g, it, hsm - half * HALF_BYTES, half);
  }
  unsigned* cnt2 = (unsigned*)(p.ws + OFF_CNT) + 2 + g;
  const float* mod = (const float*)(p.ws + OFF_MOD);
  for (;;) {
    __syncthreads();
    if (threadIdx.x == 0) s_item = (int)atomicAdd(cnt2, 2u);
    __syncthreads();
    const int it = s_item + half;
    if (it >= 512) break;
    if (g == 0) norm_adaln_rows(p.in[I_XS], p.in[I_N1G], mod, 8, 8192, 0, 1024, (u16*)(p.out + (size_t)NTOK * D), it * 64);
    else final_norm_rows(p.out, p.in[I_FING], it * 64);
  }
}

DEV void phase_p2c(const Params& p, int g) {
  u16* PHG = (u16*)(p.ws + OFF_PHG);
  const float* gn = p.in[I_GNG];
  const int tid = tidx();
  const int wave = tid >> 6, lane = tid & 63;
  constexpr int RB = 4;
  const int stride = NVB * 4;
  const int c = lane * 8;
  for (int tok0 = VBID * 4 + wave; tok0 < NTOK; tok0 += stride * RB) {
    uint4 a[RB], bq[RB], og[RB];
#pragma unroll
    for (int j = 0; j < RB; ++j) {
      const int t_ = tok0 + j * stride;
      const size_t tok = (size_t)(t_ < NTOK ? t_ : tok0);
      a[j] = *(const uint4*)(PHG + tok * 2560 + c);
      bq[j] = *(const uint4*)(PHG + tok * 2560 + 1024 + c);
      og[j] = *(const uint4*)(PHG + tok * 2560 + 2048 + c);
    }
    const float4 g0 = *(const float4*)(gn + c), g1 = *(const float4*)(gn + c + 4);
#pragma unroll
    for (int j = 0; j < RB; ++j) {
      const int t_ = tok0 + j * stride;
      float o[8];
      o[0] = bflo(a[j].x) + bflo(bq[j].x); o[1] = bfhi(a[j].x) + bfhi(bq[j].x);
      o[2] = bflo(a[j].y) + bflo(bq[j].y); o[3] = bfhi(a[j].y) + bfhi(bq[j].y);
      o[4] = bflo(a[j].z) + bflo(bq[j].z); o[5] = bfhi(a[j].z) + bfhi(bq[j].z);
      o[6] = bflo(a[j].w) + bflo(bq[j].w); o[7] = bfhi(a[j].w) + bfhi(bq[j].w);
      float ss = 0.f;
#pragma unroll
      for (int i = 0; i < 8; ++i) ss += o[i] * o[i];
      ss += __shfl_xor(ss, 1);
      ss += __shfl_xor(ss, 2);
      ss += __shfl_xor(ss, 4);
      ss += __shfl_xor(ss, 8);
      const float rstd = rsqrtf(ss * (1.f / 128.f) + EPSF);
      const float y0 = o[0] * rstd * g0.x * bflo(og[j].x), y1 = o[1] * rstd * g0.y * bfhi(og[j].x);
      const float y2 = o[2] * rstd * g0.z * bflo(og[j].y), y3 = o[3] * rstd * g0.w * bfhi(og[j].y);
      const float y4 = o[4] * rstd * g1.x * bflo(og[j].z), y5 = o[5] * rstd * g1.y * bfhi(og[j].z);
      const float y6 = o[6] * rstd * g1.z * bflo(og[j].w), y7 = o[7] * rstd * g1.w * bfhi(og[j].w);
      if (t_ < NTOK)
        *(uint4*)(PHG + (size_t)t_ * 2560 + c) = make_uint4(pack2(y0, y1), pack2(y2, y3), pack2(y4, y5), pack2(y6, y7));
    }
  }
}

DEV void tile_order(int tile, int ntn, int& mt, int& nt) {
  const int grp = tile / (16 * ntn), rem = tile % (16 * ntn);
  mt = grp * 16 + (rem & 15);
  nt = rem >> 4;
}

DEV void phase_p3a(const Params& p, int g, char* smem) {
  const int L = g ? 8192 : 4096;
  u16* PHG = (u16*)(p.ws + OFF_PHG);
  const u16* GT = (const u16*)(p.ws + OFF_GT);
  const u16* UHY = (const u16*)(p.ws + OFF_UHY);
  const u16* WbrT = (const u16*)(p.ws + OFF_WBR);
  for (int iter = 0;; ++iter) {
    int mt, nt;
    if (!tile_map(iter, 128, 4, mt, nt)) break;
    const int m0 = mt * 256, n0 = nt * 256;
    Acc acc;
    acc_zero(acc);
    {
      TransLoader al{UHY, L};
      RowLoader bl{WbrT, 1024};
      gemm_mainloop(acc, al, bl, m0, n0, 0, 512, smem);
    }
    acc_foreach(acc, m0, n0, [&](int m, int n, float& v) {
      const float ga = bf2f(GT[(size_t)m * 2048 + n]);
      const float gb = bf2f(GT[(size_t)m * 2048 + 1024 + n]);
      v *= ga * __builtin_amdgcn_rcpf(fmaxf(gb, 1e-30f));
    });
    {
      RowLoader al{PHG - 512, 2560};
      RowLoader bl{WbrT, 1024};
      gemm_mainloop(acc, al, bl, m0, n0, 512, 1024, smem);
    }
    acc_foreach(acc, m0, n0, [&](int m, int n, float& v) {
      const float gb = bf2f(GT[(size_t)m * 2048 + 1024 + n]);
      PHG[(size_t)m * 2560 + 1024 + n] = f2bf(gb * v);
    });
  }
}

DEV void phase_p3b(const Params& p, int g, char* smem) {
  const int L = g ? 8192 : 4096;
  const int bg0 = g ? 8 : 0;
  const u16* PHG = (const u16*)(p.ws + OFF_PHG);
  const u16* WoutT = (const u16*)(p.ws + OFF_WOUT);
  const float* X = p.in[g ? I_XS : I_XP];
  const float* mod = (const float*)(p.ws + OFF_MOD);
  float* X1 = p.out + (size_t)g * NTOK * D;
  for (int iter = 0;; ++iter) {
    int mt, nt;
    if (!tile_map(iter, 128, 4, mt, nt)) break;
    const int m0 = mt * 256, n0 = nt * 256;
    Acc acc;
    acc_zero(acc);
    RowLoader al{PHG + 1024, 2560}, bl{WoutT, 1024};
    gemm_mainloop(acc, al, bl, m0, n0, 0, 1024, smem);
    const float* gt = mod + (size_t)(bg0 + m0 / L) * DIN + 2048;
    acc_foreach(acc, m0, n0, [&](int m, int n, float& v) {
      X1[(size_t)m * D + n] = X[(size_t)m * D + n] + gt[n] * v;
    });
  }
}

DEV void phase_ff1(const Params& p, int g, char* smem) {
  const u16* H2 = (const u16*)(p.ws + OFF_H2);
  const u16* W = (const u16*)(p.ws + OFF_WFF1);
  u16* AB = (u16*)(p.ws + OFF_ABUF);
  GemmPipe gp;
  gp.primed = false;
  for (int iter = 0;; ++iter) {
    int mt, nt, mtn, ntn;
    if (!tile_map(iter, 128, 16, mt, nt)) break;
    const bool more = tile_map(iter + 1, 128, 16, mtn, ntn);
    if (!more) { mtn = mt; ntn = nt; }
    const int m0 = mt * 256, n0 = nt * 256;
    Acc acc;
    acc_zero(acc);
    RowLoader al{H2, 1024}, bl{W, 1024};
    gemm_mainloop_p(acc, al, bl, m0, n0, mtn * 256, ntn * 256, 1024, smem, gp);
    gp.primed = more;
    acc_foreach(acc, m0, n0, [&](int m, int n, float& v) {
      const float r = fmaxf(v, 0.f);
      AB[(size_t)m * 4096 + n] = f2bf(r * r);
    });
  }
}

DEV void phase_ff2(const Params& p, int g, char* smem) {
  const int L = g ? 8192 : 4096;
  const int bg0 = g ? 8 : 0;
  const u16* AB = (const u16*)(p.ws + OFF_ABUF);
  const u16* W = (const u16*)(p.ws + OFF_WFF2);
  const float* mod = (const float*)(p.ws + OFF_MOD);
  float* X1 = p.out + (size_t)g * NTOK * D;
  for (int iter = 0;; ++iter) {
    int mt, nt;
    if (!tile_map(iter, 128, 4, mt, nt)) break;
    const int m0 = mt * 256, n0 = nt * 256;
    Acc acc;
    acc_zero(acc);
    RowLoader al{AB, 4096}, bl{W, 4096};
    gemm_mainloop(acc, al, bl, m0, n0, 0, 4096, smem);
    const float* gt = mod + (size_t)(bg0 + m0 / L) * DIN + 5120;
    acc_foreach(acc, m0, n0, [&](int m, int n, float& v) { X1[(size_t)m * D + n] += gt[n] * v; });
  }
}

__global__ void __launch_bounds__(512) mk(Params p) {
  cg::grid_group grid = cg::this_grid();
  __shared__ __attribute__((aligned(16))) char smem[SMEM_BYTES];
  __shared__ uint4 xb_words;
  if (threadIdx.x == 0) xb_words = make_uint4(0u, 0u, 0u, 0u);
  __syncthreads();
  const XcdBarrier xb = xcd_barrier_post((unsigned*)(p.ws + OFF_XBAR), (volatile LAS unsigned*)&xb_words);
  char* hsm = smem + vhalf() * HALF_BYTES;
  const float* mod = (const float*)(p.ws + OFF_MOD);
  phase_prep(p, hsm);
  phase_filter_mlp(p, hsm);
  xcd_barrier(xb);
  if (p.out == nullptr) grid.sync();
  phase_filter_norm(p, hsm);
  phase_norm_adaln(p.in[I_XP], p.in[I_N1G], mod, 0, 4096, 0, 1024, (u16*)p.out);
  xcd_barrier(xb);
#pragma unroll 1
  for (int gi = 0; gi < 2; ++gi) {
    int g = gi;
    asm volatile("" : "+s"(g));
    const int L = g ? 8192 : 4096;
    const int bg0 = g ? 8 : 0;
    float* OG = p.out + (size_t)g * NTOK * D;
    phase_p1(p, g, smem);
    xcd_barrier(xb);
    phase_p15(p, g);
    xcd_barrier(xb);
    phase_p2_naive(p, g, hsm);
    xcd_barrier(xb);
    phase_p2c(p, g);
    xcd_barrier(xb);
    phase_p3a(p, g, smem);
    xcd_barrier(xb);
    phase_p3b(p, g, smem);
    xcd_barrier(xb);
    phase_norm_adaln(OG, p.in[I_N2G], mod, bg0, L, 3072, 4096, (u16*)(p.ws + OFF_H2));
    xcd_barrier(xb);
    phase_ff1(p, g, smem);
    xcd_barrier(xb);
    phase_ff2(p, g, smem);
    xcd_barrier(xb);
  }
  phase_final_norm(p.out + (size_t)NTOK * D, p.in[I_FING]);
}

extern "C" void kernel_launch(void* const* d_in, const int* in_sizes, int n_in, void* d_out, int out_size,
                              void* d_ws, size_t ws_size, hipStream_t stream) {
  static int grid_blocks = 0;
  if (!grid_blocks) {
    int dev = 0, cus = 0, per_cu = 0;
    (void)hipGetDevice(&dev);
    (void)hipDeviceGetAttribute(&cus, hipDeviceAttributeMultiprocessorCount, dev);
    (void)hipOccupancyMaxActiveBlocksPerMultiprocessor(&per_cu, mk, 512, 0);
    if (per_cu > 1) per_cu = 1;
    if (per_cu < 1) per_cu = 1;
    grid_blocks = cus * per_cu;
  }
  if (ws_size < WS_NEED) fprintf(stderr, "workspace too small: %zu < %zu\n", ws_size, (size_t)WS_NEED);
  Params p{};
  for (int i = 0; i < 27; ++i) p.in[i] = (const float*)d_in[i];
  p.out = (float*)d_out;
  p.ws = (char*)d_ws;
  (void)hipMemsetAsync((char*)d_ws + OFF_XBAR, 0, 16384, stream);
  void* args[] = {&p};
  hipError_t e = hipLaunchCooperativeKernel((void*)mk, dim3(grid_blocks), dim3(512), args, 0, stream);
  if (e != hipSuccess) fprintf(stderr, "coop launch failed: %s (grid %d)\n", hipGetErrorString(e), grid_blocks);
}
```

```cpp
#include <hip/hip_runtime.h>
#include <hip/hip_cooperative_groups.h>
#include <cstdio>
namespace cg = cooperative_groups;

typedef unsigned short u16;
typedef __attribute__((ext_vector_type(8))) short bf16x8;
typedef __attribute__((ext_vector_type(16))) float f32x16;

#define DEV __device__ __forceinline__

constexpr int D = 1024;
constexpr int NTOK = 32768;
constexpr int DIN = 6144;
constexpr float EPSF = 1e-6f;

enum { I_XP = 0, I_XS, I_CP, I_CS, I_ADAW, I_ADAB, I_N1G, I_WIN, I_CONVW, I_CONVB, I_FW1, I_FB1, I_FW2, I_FB2,
       I_FW3, I_FB3, I_FWO, I_FFREQ, I_FBIAS, I_LB, I_GNG, I_WBR, I_WOUT, I_N2G, I_WFF1, I_WFF2, I_FING };

constexpr size_t OFF_WIN = 0;
constexpr size_t OFF_WBR = OFF_WIN + (size_t)6144 * 1024 * 2;
constexpr size_t OFF_WOUT = OFF_WBR + (size_t)1024 * 1024 * 2;
constexpr size_t OFF_WFF1 = OFF_WOUT + (size_t)1024 * 1024 * 2;
constexpr size_t OFF_WFF2 = OFF_WFF1 + (size_t)4096 * 1024 * 2;
constexpr size_t OFF_MOD = OFF_WFF2 + (size_t)4096 * 1024 * 2;
constexpr size_t OFF_CNT = OFF_MOD + (size_t)12 * 6144 * 4;
constexpr size_t OFF_XBAR = OFF_CNT + 256;
constexpr size_t OFF_PART = OFF_XBAR + 16384;
constexpr size_t OFF_KK = OFF_PART + (size_t)768 * 1024 * 4;
constexpr size_t OFF_DEC = OFF_KK + (size_t)512 * (8192 + 16384) * 2;
constexpr size_t OFF_KT = OFF_DEC + (size_t)2 * 512 * 512 * 4;
constexpr size_t OFF_P = OFF_KT + (size_t)512 * 2 * 512 * 64 * 2;
constexpr size_t OFF_UHY = OFF_P;
constexpr size_t OFF_PHG = OFF_UHY + (size_t)NTOK * 1536 * 2;
constexpr size_t OFF_GT = OFF_PHG + (size_t)NTOK * 2560 * 2;
constexpr size_t WS_NEED = OFF_GT + (size_t)NTOK * 2048 * 2;
constexpr size_t OFF_HRAW = OFF_P;
constexpr size_t OFF_ABUF = OFF_UHY;
constexpr size_t OFF_H2 = OFF_GT;

struct Params {
  const float* in[27];
  float* out;
  char* ws;
};

DEV unsigned pack2(float a, float b) {
  unsigned r;
  asm("s_nop 0\n\tv_cvt_pk_bf16_f32 %0, %1, %2" : "=v"(r) : "v"(a), "v"(b));
  return r;
}
DEV u16 f2bf(float f) { return (u16)(pack2(f, f) & 0xffffu); }
DEV float bf2f(u16 h) { return __uint_as_float(((unsigned)h) << 16); }
DEV float bflo(unsigned w) { return __uint_as_float(w << 16); }
DEV float bfhi(unsigned w) { return __uint_as_float(w & 0xffff0000u); }
DEV float silu_f(float x) { return x / (1.f + __expf(-x)); }
DEV float sigmoid_f(float x) { return __builtin_amdgcn_rcpf(1.f + __expf(-x)); }
DEV int tidx_full() {
  int t = threadIdx.x;
  asm volatile("" : "+v"(t));
  return t;
}
DEV int tidx() { return tidx_full() & 255; }
DEV int vhalf() { return __builtin_amdgcn_readfirstlane((int)(threadIdx.x >> 8)); }
#define VBID ((int)blockIdx.x * 2 + vhalf())
#define NVB ((int)gridDim.x * 2)
DEV float wave_sum(float v) {
#pragma unroll
  for (int o = 32; o > 0; o >>= 1) v += __shfl_xor(v, o);
  return v;
}

#define XB_TMO      128
#define XB_XCNT(j)  (256  + 64 * (j))
#define XB_XSUB(j)  (1280 + 64 * (j))
#define XB_XGEN(j)  (2304 + 64 * (j))
#define XB_TOP      3328
#define XB_TOPGEN   3392
#define XCD_BAR_WORDS 3456
#define XB_SPIN_CAP (1u << 18)
#define LAS __attribute__((address_space(3)))

__device__ __forceinline__ unsigned xb_ld(unsigned* p)              { return __hip_atomic_load(p, __ATOMIC_RELAXED, __HIP_MEMORY_SCOPE_AGENT); }
__device__ __forceinline__ unsigned xb_add(unsigned* p, unsigned v) { return __hip_atomic_fetch_add(p, v, __ATOMIC_RELAXED, __HIP_MEMORY_SCOPE_AGENT); }
__device__ __forceinline__ unsigned xb_xcc_id() { return (unsigned)__builtin_amdgcn_s_getreg((3 << 11) | 20) & 0xFu; }
#define XB_SPIN(cond, bar) do { unsigned _sp = 0; while (cond) { __builtin_amdgcn_s_sleep(1); \
    if ((++_sp & 255u) == 0u) { if (xb_ld(&(bar)[XB_TMO])) break; if (_sp > XB_SPIN_CAP) { atomicAdd(&(bar)[XB_TMO], 1u); break; } } } } while (0)

struct XcdBarrier {
    unsigned* bar; unsigned x;
    volatile LAS unsigned* st;
};

__device__ __forceinline__ XcdBarrier xcd_barrier_post(unsigned* bar, volatile LAS unsigned* st) {
    XcdBarrier b; b.bar = bar; b.x = xb_xcc_id(); b.st = st;
    if (threadIdx.x == 0) (void)xb_add(&bar[XB_XCNT(b.x)], 1u);
    return b;
}
__device__ __forceinline__ void xcd_barrier_complete(unsigned* bar, unsigned x, unsigned& nloc, unsigned& nx) {
    const unsigned G = gridDim.x * gridDim.y * gridDim.z;
    unsigned sum, cnt, mine, sp = 0u;
    for (;;) {
        sum = 0u; cnt = 0u; mine = 0u;
#pragma unroll
        for (unsigned j = 0; j < 16; ++j) { const unsigned c = xb_ld(&bar[XB_XCNT(j)]); sum += c; cnt += (c > 0u) ? 1u : 0u; mine = (j == x) ? c : mine; }
        if (sum == G) break;
        __builtin_amdgcn_s_sleep(1);
        if ((++sp & 255u) == 0u) { if (xb_ld(&bar[XB_TMO])) break; if (sp > XB_SPIN_CAP) { atomicAdd(&bar[XB_TMO], 1u); break; } }
    }
    nloc = mine > 0u ? mine : 1u; nx = cnt > 0u ? cnt : 1u;
}

__device__ __forceinline__ void xcd_barrier(const XcdBarrier& b) {
    asm volatile("s_waitcnt vmcnt(0)" ::: "memory");
    __syncthreads();
    if (threadIdx.x == 0) {
        unsigned* bar = b.bar;
        __builtin_amdgcn_s_waitcnt(0);
        unsigned nloc = b.st[0], nx = b.st[1];
        if (nloc == 0u) { xcd_barrier_complete(bar, b.x, nloc, nx); b.st[0] = nloc; b.st[1] = nx; }
        const unsigned old = xb_add(&bar[XB_XSUB(b.x)], 1u);
        const unsigned gen = old / nloc;
        if (old + 1u == (gen + 1u) * nloc) {
            __builtin_amdgcn_fence(__ATOMIC_RELEASE, "agent");
            asm volatile("s_waitcnt vmcnt(0)" ::: "memory");
            const unsigned og = xb_add(&bar[XB_TOP], 1u);
            const unsigned tg = og / nx;
            if (og + 1u == (tg + 1u) * nx) xb_add(&bar[XB_TOPGEN], 1u);
            else XB_SPIN(xb_ld(&bar[XB_TOPGEN]) == tg, bar);
            __builtin_amdgcn_fence(__ATOMIC_ACQUIRE, "agent");
            xb_add(&bar[XB_XGEN(b.x)], 1u);
            asm volatile("s_waitcnt vmcnt(0)" ::: "memory");
        } else {
            XB_SPIN(xb_ld(&bar[XB_XGEN(b.x)]) == gen, bar);
            __builtin_amdgcn_fence(__ATOMIC_ACQUIRE, "agent");
            asm volatile("s_waitcnt vmcnt(0)" ::: "memory");
        }
    }
    __syncthreads();
}


constexpr int BK = 64;
constexpr int LDSROW = 144;
constexpr int TILE_BYTES = 256 * LDSROW;
constexpr int HALF_BYTES = 76800;
constexpr int SMEM_BYTES = 2 * HALF_BYTES;

struct R4 { uint4 a, b, c, d; };

struct RowLoader {
  const u16* base;
  long ld;
  DEV R4 load(int tid, int r0, int k0) const {
    const int tr = tid >> 3, tc = tid & 7;
    const u16* p = base + (long)(r0 + tr) * ld + k0 + tc * 8;
    R4 r;
    r.a = *(const uint4*)(p);
    r.b = *(const uint4*)(p + 64 * ld);
    r.c = *(const uint4*)(p + 128 * ld);
    r.d = *(const uint4*)(p + 192 * ld);
    return r;
  }
  DEV void store(int tid, char* lds, const R4& r) const {
    const int tr = tid >> 3, tc = tid & 7;
    char* q = lds + tr * LDSROW + tc * 16;
    *(uint4*)(q) = r.a;
    *(uint4*)(q + 64 * LDSROW) = r.b;
    *(uint4*)(q + 128 * LDSROW) = r.c;
    *(uint4*)(q + 192 * LDSROW) = r.d;
  }
};

DEV void st8t(char* q, const uint4& v) {
  *(u16*)(q + 0 * LDSROW) = (u16)(v.x & 0xffff);
  *(u16*)(q + 1 * LDSROW) = (u16)(v.x >> 16);
  *(u16*)(q + 2 * LDSROW) = (u16)(v.y & 0xffff);
  *(u16*)(q + 3 * LDSROW) = (u16)(v.y >> 16);
  *(u16*)(q + 4 * LDSROW) = (u16)(v.z & 0xffff);
  *(u16*)(q + 5 * LDSROW) = (u16)(v.z >> 16);
  *(u16*)(q + 6 * LDSROW) = (u16)(v.w & 0xffff);
  *(u16*)(q + 7 * LDSROW) = (u16)(v.w >> 16);
}

struct TransLoader {
  const u16* U;
  int L;
  DEV R4 load(int tid, int m0, int k0) const {
    const int b = m0 / L, t0 = m0 - b * L;
    const int k = k0 + (tid & 63), tg = tid >> 6;
    const u16* p = U + ((long)(b * 1536 + 1024 + k)) * L + t0 + tg * 8;
    R4 r;
    r.a = *(const uint4*)(p);
    r.b = *(const uint4*)(p + 64);
    r.c = *(const uint4*)(p + 128);
    r.d = *(const uint4*)(p + 192);
    return r;
  }
  DEV void store(int tid, char* lds, const R4& r) const {
    const int kl = tid & 63, tg = tid >> 6;
    char* q = lds + (tg * 8) * LDSROW + kl * 2;
    st8t(q, r.a);
    st8t(q + 64 * LDSROW, r.b);
    st8t(q + 128 * LDSROW, r.c);
    st8t(q + 192 * LDSROW, r.d);
  }
};

typedef f32x16 Acc[4][2];

template <class AL, class BL>
DEV void gemm_ktile(Acc& acc, const char* A, const char* B, int wm, int wn, int lr, int lh, const AL& al, const BL& bl,
                    int tid, int m0, int n0, int knext, char* nxt, R4& ra, R4& rb) {
  bf16x8 a[2][4], b[2][2];
  const char* pa = A + (wm + lr) * LDSROW + lh * 16;
  const char* pb = B + (wn + lr) * LDSROW + lh * 16;
#pragma unroll
  for (int i = 0; i < 4; ++i) a[0][i] = *(const bf16x8*)(pa + 32 * i * LDSROW);
#pragma unroll
  for (int j = 0; j < 2; ++j) b[0][j] = *(const bf16x8*)(pb + 32 * j * LDSROW);
#pragma unroll
  for (int ks = 0; ks < 4; ++ks) {
    const int cur = ks & 1, nx = cur ^ 1;
    if (ks < 3) {
#pragma unroll
      for (int i = 0; i < 4; ++i) a[nx][i] = *(const bf16x8*)(pa + 32 * i * LDSROW + (ks + 1) * 32);
#pragma unroll
      for (int j = 0; j < 2; ++j) b[nx][j] = *(const bf16x8*)(pb + 32 * j * LDSROW + (ks + 1) * 32);
    }
    __builtin_amdgcn_sched_barrier(0);
#pragma unroll
    for (int i = 0; i < 4; ++i)
#pragma unroll
      for (int j = 0; j < 2; ++j)
        acc[i][j] = __builtin_amdgcn_mfma_f32_32x32x16_bf16(a[cur][i], b[cur][j], acc[i][j], 0, 0, 0);
    __builtin_amdgcn_sched_barrier(0);
    if (ks == 1) {
      al.store(tid, nxt, ra);
      bl.store(tid, nxt + TILE_BYTES, rb);
      __builtin_amdgcn_sched_barrier(0);
      ra = al.load(tid, m0, knext);
      rb = bl.load(tid, n0, knext);
      __builtin_amdgcn_sched_barrier(0);
    }
  }
}

template <class AL, class BL>
DEV void gemm_mainloop(Acc& acc, const AL& al, const BL& bl, int m0, int n0, int kbeg, int kend, char* lds) {
  const int tid = tidx_full();
  const int wave = tid >> 6, lane = tid & 63;
  const int wm = (wave >> 2) * 128, wn = (wave & 3) * 64;
  const int lr = lane & 31, lh = lane >> 5;
  const int nk = (kend - kbeg) / BK;
  R4 a0 = al.load(tid, m0, kbeg);
  R4 b0 = bl.load(tid, n0, kbeg);
  __syncthreads();
  al.store(tid, lds, a0);
  bl.store(tid, lds + TILE_BYTES, b0);
  a0 = al.load(tid, m0, kbeg + BK);
  b0 = bl.load(tid, n0, kbeg + BK);
  __syncthreads();
  for (int kt = 0; kt < nk; ++kt) {
    const char* cur = lds + (kt & 1) * 2 * TILE_BYTES;
    char* nxt = lds + ((kt + 1) & 1) * 2 * TILE_BYTES;
    const int t2 = (kt + 2 < nk) ? kt + 2 : nk - 1;
    __builtin_amdgcn_sched_barrier(0);
    gemm_ktile(acc, cur, cur + TILE_BYTES, wm, wn, lr, lh, al, bl, tid, m0, n0, kbeg + t2 * BK, nxt, a0, b0);
    __builtin_amdgcn_sched_barrier(0);
    __syncthreads();
  }
}

struct GemmPipe {
  R4 ra, rb;
  bool primed;
};
template <class AL, class BL>
DEV void gemm_mainloop_p(Acc& acc, const AL& al, const BL& bl, int m0, int n0, int m0n, int n0n, int K, char* lds,
                         GemmPipe& gp) {
  const int tid = tidx_full();
  const int wave = tid >> 6, lane = tid & 63;
  const int wm = (wave >> 2) * 128, wn = (wave & 3) * 64;
  const int lr = lane & 31, lh = lane >> 5;
  const int nk = K / BK;
  if (!gp.primed) {
    gp.ra = al.load(tid, m0, 0);
    gp.rb = bl.load(tid, n0, 0);
    __syncthreads();
    al.store(tid, lds, gp.ra);
    bl.store(tid, lds + TILE_BYTES, gp.rb);
    gp.ra = al.load(tid, m0, BK);
    gp.rb = bl.load(tid, n0, BK);
    __syncthreads();
  }
  for (int kt = 0; kt < nk; ++kt) {
    const char* cur = lds + (kt & 1) * 2 * TILE_BYTES;
    char* nxt = lds + ((kt + 1) & 1) * 2 * TILE_BYTES;
    const bool wrap = (kt + 2 >= nk);
    const int kk = (wrap ? kt + 2 - nk : kt + 2) * BK;
    const int mr = wrap ? m0n : m0, nr = wrap ? n0n : n0;
    __builtin_amdgcn_sched_barrier(0);
    gemm_ktile(acc, cur, cur + TILE_BYTES, wm, wn, lr, lh, al, bl, tid, mr, nr, kk, nxt, gp.ra, gp.rb);
    __builtin_amdgcn_sched_barrier(0);
    __syncthreads();
  }
}

DEV void acc_zero(Acc& acc) {
#pragma unroll
  for (int i = 0; i < 4; ++i)
#pragma unroll
    for (int j = 0; j < 2; ++j)
#pragma unroll
      for (int r = 0; r < 16; ++r) acc[i][j][r] = 0.f;
}

template <class F>
DEV void acc_foreach(Acc& acc, int m0, int n0, F f) {
  asm volatile("s_nop 7\n\ts_nop 7\n\ts_nop 3" ::: "memory");
  const int tid = tidx_full();
  const int wave = tid >> 6, lane = tid & 63;
  const int wm = (wave >> 2) * 128, wn = (wave & 3) * 64;
  const int lr = lane & 31, lh = lane >> 5;
#pragma unroll
  for (int i = 0; i < 4; ++i)
#pragma unroll
    for (int j = 0; j < 2; ++j)
#pragma unroll
      for (int r = 0; r < 16; ++r) {
        const int m = m0 + wm + 32 * i + (r & 3) + 8 * (r >> 2) + 4 * lh;
        const int n = n0 + wn + 32 * j + lr;
        float v = acc[i][j][r];
        f(m, n, v);
        acc[i][j][r] = v;
      }
}

DEV bool tile_map(int iter, int ntm, int ntn, int& mt, int& nt) {
  int PM = 0, PN = 0;
  if (ntn == 18) { PM = 16; PN = 2; }
  else if (ntn == 128) { PM = 2; PN = 16; }
  else if (ntn == 16 || ntn == 4) { PM = 8; PN = 4; }
  if (gridDim.x == 256 && PM > 0 && (ntm % PM) == 0) {
    const int xcd = blockIdx.x & 7, slot = blockIdx.x >> 3;
    const int nsn = ntn / PN, nsuper = (ntm / PM) * nsn;
    const int s_ = iter * 8 + xcd;
    if (s_ >= nsuper) return false;
    const int sm = s_ / nsn, sn = s_ - sm * nsn;
    mt = sm * PM + slot / PN;
    nt = sn * PN + slot % PN;
    return true;
  }
  const int tile = blockIdx.x + iter * gridDim.x;
  if (tile >= ntm * ntn) return false;
  mt = tile / ntn;
  nt = tile - mt * ntn;
  return true;
}

DEV void prep_transpose_tile(const float* __restrict__ W, int K, int N, u16* __restrict__ WT, int tile, char* smem) {
  u16(*T)[66] = (u16(*)[66])smem;
  const int ntn = N / 64;
  const int k0 = (tile / ntn) * 64, n0 = (tile % ntn) * 64;
  const int tid = tidx();
  const int kr = tid >> 4, nc = (tid & 15) * 4;
  __syncthreads();
#pragma unroll
  for (int i = 0; i < 4; ++i) {
    const int k = kr + 16 * i;
    const float4 v = *(const float4*)(W + (long)(k0 + k) * N + n0 + nc);
    T[nc + 0][k] = f2bf(v.x);
    T[nc + 1][k] = f2bf(v.y);
    T[nc + 2][k] = f2bf(v.z);
    T[nc + 3][k] = f2bf(v.w);
  }
  __syncthreads();
  const int n = tid >> 2, kc = (tid & 3) * 16;
  unsigned o[8];
#pragma unroll
  for (int i = 0; i < 8; ++i) o[i] = (unsigned)T[n][kc + 2 * i] | ((unsigned)T[n][kc + 2 * i + 1] << 16);
  uint4* dst = (uint4*)(WT + (long)(n0 + n) * K + k0 + kc);
  dst[0] = make_uint4(o[0], o[1], o[2], o[3]);
  dst[1] = make_uint4(o[4], o[5], o[6], o[7]);
}

DEV void prep_mod_item(const Params& p, int item, char* smem) {
  float* sc = (float*)smem;
  float* red = (float*)(smem + 12 * 1024 * 4);
  __syncthreads();
  const int tid = tidx();
  for (int e = tid; e < 12 * 1024; e += 256) {
    const int b = e >> 10, k = e & 1023;
    const float c = (b < 8) ? p.in[I_CP][b * 1024 + k] : p.in[I_CS][(b - 8) * 1024 + k];
    sc[e] = silu_f(c);
  }
  __syncthreads();
  const int col = tid & 31, kg = tid >> 5;
  const int j = item * 32 + col;
  float acc[12];
#pragma unroll
  for (int b = 0; b < 12; ++b) acc[b] = 0.f;
  const float* W = p.in[I_ADAW];
#pragma unroll 8
  for (int kk = 0; kk < 128; ++kk) {
    const int k = kg * 128 + kk;
    const float w = W[(long)k * DIN + j];
#pragma unroll
    for (int b = 0; b < 12; ++b) acc[b] += sc[b * 1024 + k] * w;
  }
#pragma unroll
  for (int b = 0; b < 12; ++b) red[(kg * 12 + b) * 32 + col] = acc[b];
  __syncthreads();
  for (int e = tid; e < 12 * 32; e += 256) {
    const int b = e >> 5, c = e & 31;
    float s = p.in[I_ADAB][item * 32 + c];
#pragma unroll
    for (int g = 0; g < 8; ++g) s += red[(g * 12 + b) * 32 + c];
    ((float*)(p.ws + OFF_MOD))[b * DIN + item * 32 + c] = s;
  }
}

DEV void phase_prep(const Params& p, char* smem) {
  if (blockIdx.x == 0 && threadIdx.x < 64) ((unsigned*)(p.ws + OFF_CNT))[threadIdx.x] = 0u;
  for (int it = VBID; it < 4096 + 192; it += NVB) {
    if (it < 1536) prep_transpose_tile(p.in[I_WIN], 1024, 6144, (u16*)(p.ws + OFF_WIN), it, smem);
    else if (it < 1792) prep_transpose_tile(p.in[I_WBR], 1024, 1024, (u16*)(p.ws + OFF_WBR), it - 1536, smem);
    else if (it < 2048) prep_transpose_tile(p.in[I_WOUT], 1024, 1024, (u16*)(p.ws + OFF_WOUT), it - 1792, smem);
    else if (it < 3072) prep_transpose_tile(p.in[I_WFF1], 1024, 4096, (u16*)(p.ws + OFF_WFF1), it - 2048, smem);
    else if (it < 4096) prep_transpose_tile(p.in[I_WFF2], 4096, 1024, (u16*)(p.ws + OFF_WFF2), it - 3072, smem);
    else prep_mod_item(p, it - 4096, smem);
  }
}

DEV void phase_filter_mlp(const Params& p, char* smem) {
  float* z = (float*)smem;
  float* h1 = z + 4 * 36;
  float* h2 = h1 + 256;
  float* h3 = h2 + 256;
  const float* w1 = p.in[I_FW1];
  const float* b1 = p.in[I_FB1];
  const float* w2 = p.in[I_FW2];
  const float* b2 = p.in[I_FB2];
  const float* w3 = p.in[I_FW3];
  const float* b3 = p.in[I_FB3];
  const float* wo = p.in[I_FWO];
  const float* fr = p.in[I_FFREQ];
  float* hraw = (float*)(p.ws + OFF_HRAW);
  float* part = (float*)(p.ws + OFF_PART);
  const int tid = tidx();
  for (int it = VBID; it < 768; it += NVB) {
    const int g = (it < 256) ? 0 : 1;
    const int L = g ? 8192 : 4096;
    const int tbase = (g ? (it - 256) : it) * 16;
    const long rowbase = g ? 4096 : 0;
    float psum[4] = {0.f, 0.f, 0.f, 0.f};
    for (int rnd = 0; rnd < 4; ++rnd) {
      const int t0 = tbase + rnd * 4;
      __syncthreads();
      if (tid < 4 * 33) {
        const int pp = tid / 33, f = tid % 33;
        const int t = t0 + pp;
        float val;
        if (f == 0) val = (float)t / (float)(L - 1);
        else {
          const int j = (f - 1) & 15;
          const float fb = 1e-4f + (float)j * ((15.0f - 1e-4f) / 15.0f);
          const float w = 6.283185307179586f * (float)t / (float)L;
          val = (f <= 16) ? cosf(fb * w) : -sinf(fb * w);
        }
        z[pp * 36 + f] = val;
      }
      __syncthreads();
      const int pp = tid >> 6, u = tid & 63;
      {
        float s = b1[u];
        for (int k = 0; k < 33; ++k) s += z[pp * 36 + k] * w1[k * 64 + u];
        h1[pp * 64 + u] = sinf(fr[u] * s);
      }
      __syncthreads();
      {
        float s = b2[u];
        for (int k = 0; k < 64; ++k) s += h1[pp * 64 + k] * w2[k * 64 + u];
        h2[pp * 64 + u] = sinf(fr[64 + u] * s);
      }
      __syncthreads();
      {
        float s = b3[u];
        for (int k = 0; k < 64; ++k) s += h2[pp * 64 + k] * w3[k * 64 + u];
        h3[pp * 64 + u] = sinf(fr[128 + u] * s);
      }
      __syncthreads();
      float acc[4][4];
#pragma unroll
      for (int a = 0; a < 4; ++a)
#pragma unroll
        for (int q = 0; q < 4; ++q) acc[a][q] = 0.f;
      for (int k = 0; k < 64; ++k) {
        float wv[4];
#pragma unroll
        for (int q = 0; q < 4; ++q) wv[q] = wo[k * 1024 + tid + 256 * q];
#pragma unroll
        for (int a = 0; a < 4; ++a) {
          const float hv = h3[a * 64 + k];
#pragma unroll
          for (int q = 0; q < 4; ++q) acc[a][q] += hv * wv[q];
        }
      }
#pragma unroll
      for (int q = 0; q < 4; ++q) {
        const int c = tid + 256 * q;
        const int ch = c & 511;
        const float mind = -3.0701134573253943f, maxd = -15.350567286626972f;
        const float delta = fabsf(mind + (float)ch * ((maxd - mind) / 511.0f));
#pragma unroll
        for (int a = 0; a < 4; ++a) {
          const int t = t0 + a;
          const float tt = (float)t / (float)(L - 1);
          const float val = acc[a][q] * __expf(-tt * delta);
          hraw[(rowbase + t) * 1024 + c] = val;
          if (!(c >= 512 && t == 0)) psum[q] += fabsf(val);
        }
      }
    }
#pragma unroll
    for (int q = 0; q < 4; ++q) part[(long)it * 1024 + tid + 256 * q] = psum[q];
  }
}

DEV void phase_filter_norm(const Params& p, char* smem) {
  float* Tf = (float*)smem;
  float* Tb = Tf + 64 * 65;
  float* red = Tb + 64 * 65;
  float* nrm = red + 256;
  const float* hraw = (const float*)(p.ws + OFF_HRAW);
  const float* part = (const float*)(p.ws + OFF_PART);
  const int tid = tidx();
  for (int it = VBID; it < 512 + 1024; it += NVB) {
    const int g = (it < 512) ? 0 : 1;
    const int L = g ? 8192 : 4096;
    const int li = g ? it - 512 : it;
    const int ntt = L / 64;
    const int ct = li / ntt, tt = li % ntt;
    const long rowbase = g ? 4096 : 0;
    const int prow0 = g ? 256 : 0, nprow = g ? 512 : 256;
    u16* KK = (u16*)(p.ws + OFF_KK) + (g ? (size_t)512 * 8192 : 0);
    __syncthreads();
    {
      const int c = tid & 63, ph = tid >> 6;
      float s = 0.f;
      for (int r = ph; r < nprow; r += 4) {
        s += part[(long)(prow0 + r) * 1024 + ct * 64 + c];
        s += part[(long)(prow0 + r) * 1024 + 512 + ct * 64 + c];
      }
      red[ph * 64 + c] = s;
#pragma unroll
      for (int i = 0; i < 16; ++i) {
        const int r = ph + 4 * i;
        const long row = rowbase + tt * 64 + r;
        Tf[c * 65 + r] = hraw[row * 1024 + ct * 64 + c];
        Tb[c * 65 + r] = hraw[row * 1024 + 512 + ct * 64 + c];
      }
    }
    __syncthreads();
    if (tid < 64) nrm[tid] = red[tid] + red[64 + tid] + red[128 + tid] + red[192 + tid] + EPSF;
    __syncthreads();
    {
      const int c = tid >> 2, rq = (tid & 3) * 16;
      const float inv = 1.f / nrm[c];
      u16* row = KK + (size_t)(ct * 64 + c) * (2 * L);
#pragma unroll
      for (int i = 0; i < 16; ++i) {
        const int r = rq + i;
        const int t = tt * 64 + r;
        row[L - t] = f2bf(Tf[c * 65 + r] * inv);
        if (t >= 1) row[L + t] = f2bf(Tb[c * 65 + r] * inv);
      }
      if (tt == 0 && (tid & 3) == 0) row[0] = 0;
    }
  }
}

DEV void phase_norm_adaln(const float* __restrict__ X, const float* __restrict__ gvec, const float* __restrict__ mod,
                          int bg0, int L, int sh_off, int sc_off, u16* __restrict__ H) {
  const int tid = tidx();
  const int wave = tid >> 6, lane = tid & 63;
  constexpr int RB = 4;
  const int stride = NVB * 4;
  for (int row0 = VBID * 4 + wave; row0 < NTOK; row0 += stride * RB) {
    float4 v[RB][4];
    float ss[RB];
#pragma unroll
    for (int j = 0; j < RB; ++j) {
      const int row = row0 + j * stride;
      const float* x = X + (long)(row < NTOK ? row : row0) * D;
#pragma unroll
      for (int i = 0; i < 4; ++i) v[j][i] = *(const float4*)(x + lane * 4 + 256 * i);
    }
#pragma unroll
    for (int j = 0; j < RB; ++j) {
      float t = 0.f;
#pragma unroll
      for (int i = 0; i < 4; ++i) t += v[j][i].x * v[j][i].x + v[j][i].y * v[j][i].y + v[j][i].z * v[j][i].z + v[j][i].w * v[j][i].w;
      ss[j] = wave_sum(t);
    }
#pragma unroll
    for (int j = 0; j < RB; ++j) {
      const int row = row0 + j * stride;
      if (row < NTOK) {
        const float rstd = rsqrtf(ss[j] * (1.f / 1024.f) + EPSF);
        const float* mrow = mod + (long)(bg0 + row / L) * DIN;
#pragma unroll
        for (int i = 0; i < 4; ++i) {
          const int k = lane * 4 + 256 * i;
          const float4 g = *(const float4*)(gvec + k);
          const float4 sc = *(const float4*)(mrow + sc_off + k);
          const float4 sh = *(const float4*)(mrow + sh_off + k);
          const float o0 = v[j][i].x * rstd * g.x * (1.f + sc.x) + sh.x;
          const float o1 = v[j][i].y * rstd * g.y * (1.f + sc.y) + sh.y;
          const float o2 = v[j][i].z * rstd * g.z * (1.f + sc.z) + sh.z;
          const float o3 = v[j][i].w * rstd * g.w * (1.f + sc.w) + sh.w;
          *(uint2*)(H + (long)row * D + k) = make_uint2(pack2(o0, o1), pack2(o2, o3));
        }
      }
    }
  }
}

DEV void phase_final_norm(float* __restrict__ X, const float* __restrict__ gvec) {
  const int tid = tidx();
  const int wave = tid >> 6, lane = tid & 63;
  constexpr int RB = 4;
  const int stride = NVB * 4;
  for (int row0 = VBID * 4 + wave; row0 < NTOK; row0 += stride * RB) {
    float4 v[RB][4];
    float ss[RB];
#pragma unroll
    for (int j = 0; j < RB; ++j) {
      const int row = row0 + j * stride;
      const float* x = X + (long)(row < NTOK ? row : row0) * D;
#pragma unroll
      for (int i = 0; i < 4; ++i) v[j][i] = *(const float4*)(x + lane * 4 + 256 * i);
    }
#pragma unroll
    for (int j = 0; j < RB; ++j) {
      float t = 0.f;
#pragma unroll
      for (int i = 0; i < 4; ++i) t += v[j][i].x * v[j][i].x + v[j][i].y * v[j][i].y + v[j][i].z * v[j][i].z + v[j][i].w * v[j][i].w;
      ss[j] = wave_sum(t);
    }
#pragma unroll
    for (int j = 0; j < RB; ++j) {
      const int row = row0 + j * stride;
      if (row < NTOK) {
        const float rstd = rsqrtf(ss[j] * (1.f / 1024.f) + EPSF);
        float* x = X + (long)row * D;
#pragma unroll
        for (int i = 0; i < 4; ++i) {
          const int k = lane * 4 + 256 * i;
          const float4 g = *(const float4*)(gvec + k);
          *(float4*)(x + k) = make_float4(v[j][i].x * rstd * g.x, v[j][i].y * rstd * g.y, v[j][i].z * rstd * g.z, v[j][i].w * rstd * g.w);
        }
      }
    }
  }
}

DEV void norm_adaln_rows(const float* __restrict__ X, const float* __restrict__ gvec, const float* __restrict__ mod,
                         int bg0, int L, int sh_off, int sc_off, u16* __restrict__ H, int rbeg) {
  const int tid = tidx();
  const int wave = tid >> 6, lane = tid & 63;
  for (int jb = 0; jb < 16; jb += 4) {
    float4 v[4][4];
    float ss[4];
#pragma unroll
    for (int j = 0; j < 4; ++j) {
      const float* x = X + (long)(rbeg + wave + 4 * (jb + j)) * D;
#pragma unroll
      for (int i = 0; i < 4; ++i) v[j][i] = *(const float4*)(x + lane * 4 + 256 * i);
    }
#pragma unroll
    for (int j = 0; j < 4; ++j) {
      float t = 0.f;
#pragma unroll
      for (int i = 0; i < 4; ++i) t += v[j][i].x * v[j][i].x + v[j][i].y * v[j][i].y + v[j][i].z * v[j][i].z + v[j][i].w * v[j][i].w;
      ss[j] = wave_sum(t);
    }
#pragma unroll
    for (int j = 0; j < 4; ++j) {
      const int row = rbeg + wave + 4 * (jb + j);
      const float rstd = rsqrtf(ss[j] * (1.f / 1024.f) + EPSF);
      const float* mrow = mod + (long)(bg0 + row / L) * DIN;
#pragma unroll
      for (int i = 0; i < 4; ++i) {
        const int k = lane * 4 + 256 * i;
        const float4 g = *(const float4*)(gvec + k);
        const float4 sc = *(const float4*)(mrow + sc_off + k);
        const float4 sh = *(const float4*)(mrow + sh_off + k);
        const float o0 = v[j][i].x * rstd * g.x * (1.f + sc.x) + sh.x;
        const float o1 = v[j][i].y * rstd * g.y * (1.f + sc.y) + sh.y;
        const float o2 = v[j][i].z * rstd * g.z * (1.f + sc.z) + sh.z;
        const float o3 = v[j][i].w * rstd * g.w * (1.f + sc.w) + sh.w;
        *(uint2*)(H + (long)row * D + k) = make_uint2(pack2(o0, o1), pack2(o2, o3));
      }
    }
  }
}

DEV void final_norm_rows(float* __restrict__ X, const float* __restrict__ gvec, int rbeg) {
  const int tid = tidx();
  const int wave = tid >> 6, lane = tid & 63;
  for (int jb = 0; jb < 16; jb += 4) {
    float4 v[4][4];
    float ss[4];
#pragma unroll
    for (int j = 0; j < 4; ++j) {
      const float* x = X + (long)(rbeg + wave + 4 * (jb + j)) * D;
#pragma unroll
      for (int i = 0; i < 4; ++i) v[j][i] = *(const float4*)(x + lane * 4 + 256 * i);
    }
#pragma unroll
    for (int j = 0; j < 4; ++j) {
      float t = 0.f;
#pragma unroll
      for (int i = 0; i < 4; ++i) t += v[j][i].x * v[j][i].x + v[j][i].y * v[j][i].y + v[j][i].z * v[j][i].z + v[j][i].w * v[j][i].w;
      ss[j] = wave_sum(t);
    }
#pragma unroll
    for (int j = 0; j < 4; ++j) {
      float* x = X + (long)(rbeg + wave + 4 * (jb + j)) * D;
      const float rstd = rsqrtf(ss[j] * (1.f / 1024.f) + EPSF);
#pragma unroll
      for (int i = 0; i < 4; ++i) {
        const int k = lane * 4 + 256 * i;
        const float4 g = *(const float4*)(gvec + k);
        *(float4*)(x + k) = make_float4(v[j][i].x * rstd * g.x, v[j][i].y * rstd * g.y, v[j][i].z * rstd * g.z, v[j][i].w * rstd * g.w);
      }
    }
  }
}

DEV void phase_p1(const Params& p, int g, char* smem) {
  const int L = g ? 8192 : 4096;
  const u16* H = (const u16*)(p.out + (size_t)g * NTOK * D);
  const u16* WinT = (const u16*)(p.ws + OFF_WIN);
  u16* PHG = (u16*)(p.ws + OFF_PHG);
  u16* GT = (u16*)(p.ws + OFF_GT);
  u16* UHY = (u16*)(p.ws + OFF_UHY);
  {
    GemmPipe gp;
    gp.primed = false;
    for (int iter = 0;; ++iter) {
      int mt, nt, mtn, ntn;
      if (!tile_map(iter, 128, 18, mt, nt)) break;
      const bool more = tile_map(iter + 1, 128, 18, mtn, ntn);
      if (!more) { mtn = mt; ntn = nt; }
      Acc acc;
      acc_zero(acc);
      const int m0 = mt * 256, n0 = nt * 256;
      RowLoader al{H, 1024}, bl{WinT + (size_t)1536 * 1024, 1024};
      gemm_mainloop_p(acc, al, bl, m0, n0, mtn * 256, ntn * 256, 1024, smem, gp);
      gp.primed = more;
      if (n0 < 2560) {
        const bool dosilu = (n0 < 512) || (n0 >= 2048);
        acc_foreach(acc, m0, n0, [&](int m, int n, float& v) {
          const float o = dosilu ? silu_f(v) : v;
          PHG[(size_t)m * 2560 + n] = f2bf(o);
        });
      } else {
        acc_foreach(acc, m0, n0, [&](int m, int n, float& v) { GT[(size_t)m * 2048 + (n - 2560)] = f2bf(sigmoid_f(v)); });
      }
    }
  }
  {
    GemmPipe gp;
    gp.primed = false;
    for (int iter = 0;; ++iter) {
      int cm, tn, cmn, tnn;
      if (!tile_map(iter, 6, 128, cm, tn)) break;
      const bool more = tile_map(iter + 1, 6, 128, cmn, tnn);
      if (!more) { cmn = cm; tnn = tn; }
      Acc acc;
      acc_zero(acc);
      const int m0 = cm * 256, n0 = tn * 256;
      RowLoader al{WinT, 1024}, bl{H, 1024};
      gemm_mainloop_p(acc, al, bl, m0, n0, cmn * 256, tnn * 256, 1024, smem, gp);
      gp.primed = more;
      const int b = n0 / L, tb = n0 - b * L;
      u16* dst = UHY + (size_t)b * 1536 * L + tb - n0;
      acc_foreach(acc, m0, n0, [&](int m, int n, float& v) { dst[(size_t)m * L + n] = f2bf(v); });
    }
  }
}

DEV void phase_p15(const Params& p, int g) {
  const u16* PHG = (const u16*)(p.ws + OFF_PHG);
  u16* QK = (u16*)(p.out + (size_t)g * NTOK * D);
  u16* KT = (u16*)(p.ws + OFF_KT);
  float* DEC = (float*)(p.ws + OFF_DEC);
  for (int it = VBID; it < 1024; it += NVB) {
    const int tid = tidx();
    const int cidx = it >> 1, dir = it & 1;
    u16* Qp = QK + (size_t)(2 * dir) * NTOK * 512;
    u16* Kp = Qp + (size_t)NTOK * 512;
    float lb[2], G[2];
#pragma unroll
    for (int cc = 0; cc < 2; ++cc) {
      const int c = tid + 256 * cc;
      const float a0 = p.in[I_LB][(0 * 2 + dir) * 512 + c];
      const float a1 = p.in[I_LB][(1 * 2 + dir) * 512 + c];
      lb[cc] = 1.f / (1.f + __expf(a1 - a0));
      G[cc] = 0.f;
    }
    u16 xr[3][2][8], qr[3][2][8];
#define P15_LOAD(st_, j8_)                                                          \
    _Pragma("unroll") for (int e = 0; e < 8; ++e) {                                 \
      const int jj = (j8_) * 8 + e;                                                 \
      const int j = dir ? 63 - jj : jj;                                             \
      const size_t tok = (size_t)cidx * 64 + j;                                     \
      _Pragma("unroll") for (int cc = 0; cc < 2; ++cc) {                            \
        xr[st_][cc][e] = PHG[tok * 2560 + 1024 + 512 * dir + tid + 256 * cc];       \
        qr[st_][cc][e] = PHG[tok * 2560 + tid + 256 * cc];                          \
      }                                                                             \
    }
    P15_LOAD(0, 0);
    P15_LOAD(1, 1);
#pragma unroll
    for (int j8 = 0; j8 < 8; ++j8) {
      const int st = j8 % 3;
      if (j8 < 6) { P15_LOAD((j8 + 2) % 3, j8 + 2); }
#pragma unroll
      for (int cc = 0; cc < 2; ++cc) {
        const int c = tid + 256 * cc;
        unsigned kb[8];
#pragma unroll
        for (int e = 0; e < 8; ++e) {
          const int jj = j8 * 8 + e;
          const int j = dir ? 63 - jj : jj;
          const size_t tok = (size_t)cidx * 64 + j;
          const float f = lb[cc] + (1.f - lb[cc]) * sigmoid_f(bf2f(xr[st][cc][e]));
          G[cc] += __logf(f);
          const float eg = __expf(G[cc]), ig = __expf(-G[cc]);
          Qp[tok * 512 + c] = f2bf(bf2f(qr[st][cc][e]) * eg);
          const u16 kk = f2bf((1.f - f) * ig);
          Kp[tok * 512 + c] = kk;
          kb[e] = kk;
        }
        const int s0 = dir ? 56 - 8 * j8 : 8 * j8;
        uint4 w;
        w.x = dir ? (kb[7] | (kb[6] << 16)) : (kb[0] | (kb[1] << 16));
        w.y = dir ? (kb[5] | (kb[4] << 16)) : (kb[2] | (kb[3] << 16));
        w.z = dir ? (kb[3] | (kb[2] << 16)) : (kb[4] | (kb[5] << 16));
        w.w = dir ? (kb[1] | (kb[0] << 16)) : (kb[6] | (kb[7] << 16));
        *(uint4*)(KT + (((size_t)cidx * 2 + dir) * 512 + c) * 64 + s0) = w;
      }
    }
#undef P15_LOAD
#pragma unroll
    for (int cc = 0; cc < 2; ++cc) DEC[((size_t)dir * 512 + cidx) * 512 + tid + 256 * cc] = __expf(G[cc]);
  }
}

DEV void scan_item_mfma(const Params& p, int g, int item, char* smem) {
  const int L = g ? 8192 : 4096;
  const int NC = L / 64;
  const int vs = item & 3, dir = (item >> 2) & 1, h = (item >> 3) & 3, b = item >> 5;
  char* Qs = smem;
  char* Ks = Qs + 17408;
  char* KTs = Ks + 17408;
  char* Vts = KTs + 18432;
  char* Ps = Vts + 4608;
  char* Sts = Ps + 9216;
  float* decs = (float*)(Sts + 8704);
  u16* PHG = (u16*)(p.ws + OFF_PHG);
  const u16* QK = (const u16*)(p.out + (size_t)g * NTOK * D);
  const u16* Qp = QK + (size_t)(2 * dir) * NTOK * 512;
  const u16* Kp = Qp + (size_t)NTOK * 512;
  const u16* KT = (const u16*)(p.ws + OFF_KT);
  const float* DEC = (const float*)(p.ws + OFF_DEC);
  const int tid = tidx();
  const int wave = __builtin_amdgcn_readfirstlane(tid >> 6);
  const int lane = tid & 63, r = lane & 31, hh = lane >> 5;
  __syncthreads();
  for (int e = tid; e < 8704 / 16; e += 256) ((uint4*)Sts)[e] = make_uint4(0, 0, 0, 0);
  f32x16 accS[2];
#pragma unroll
  for (int t = 0; t < 2; ++t)
#pragma unroll
    for (int i = 0; i < 16; ++i) accS[t][i] = 0.f;
  const int ocol = (dir ? 1024 : 0) + h * 128 + vs * 32;

  uint4 q0, q1, q2, q3, k0, k1, k2, k3, t0, t1, t2, t3, vv;
  float dd = 0.f;
  const int qrow = tid >> 4, qc = tid & 15;
  const int trow = tid >> 3, tc = tid & 7;
  const int vrow = tid >> 2, vc = tid & 3;
#define SCAN_ISSUE(n_)                                                                                   \
  {                                                                                                      \
    const size_t cidx_ = (size_t)b * NC + (n_);                                                          \
    const size_t tok_ = cidx_ * 64;                                                                      \
    const u16* gq = Qp + (tok_ + qrow) * 512 + h * 128 + qc * 8;                                         \
    const u16* gk = Kp + (tok_ + qrow) * 512 + h * 128 + qc * 8;                                         \
    q0 = *(const uint4*)(gq); q1 = *(const uint4*)(gq + 16 * 512);                                       \
    q2 = *(const uint4*)(gq + 32 * 512); q3 = *(const uint4*)(gq + 48 * 512);                            \
    k0 = *(const uint4*)(gk); k1 = *(const uint4*)(gk + 16 * 512);                                       \
    k2 = *(const uint4*)(gk + 32 * 512); k3 = *(const uint4*)(gk + 48 * 512);                            \
    const u16* gt = KT + ((cidx_ * 2 + dir) * 512 + h * 128 + trow) * 64 + tc * 8;                       \
    t0 = *(const uint4*)(gt); t1 = *(const uint4*)(gt + 32 * 64);                                        \
    t2 = *(const uint4*)(gt + 64 * 64); t3 = *(const uint4*)(gt + 96 * 64);                              \
    vv = *(const uint4*)(PHG + (tok_ + vrow) * 2560 + 512 + h * 128 + vs * 32 + vc * 8);                 \
    dd = DEC[((size_t)dir * 512 + cidx_) * 512 + h * 128 + (tid & 127)];                                 \
  }
#define SCAN_BAR()                                        \
  {                                                       \
    asm volatile("s_waitcnt lgkmcnt(0)" ::: "memory");     \
    __builtin_amdgcn_s_barrier();                         \
    asm volatile("" ::: "memory");                         \
  }
  unsigned opk[8] = {0u, 0u, 0u, 0u, 0u, 0u, 0u, 0u};
  size_t otok = 0;
  SCAN_ISSUE(dir ? NC - 1 : 0);
  for (int ci = 0; ci < NC; ++ci) {
    const int n = dir ? NC - 1 - ci : ci;
    const size_t tok0 = ((size_t)b * NC + n) * 64;
    {
      char* d = Qs + qrow * 272 + qc * 16;
      *(uint4*)(d) = q0; *(uint4*)(d + 16 * 272) = q1; *(uint4*)(d + 32 * 272) = q2; *(uint4*)(d + 48 * 272) = q3;
      d = Ks + qrow * 272 + qc * 16;
      *(uint4*)(d) = k0; *(uint4*)(d + 16 * 272) = k1; *(uint4*)(d + 32 * 272) = k2; *(uint4*)(d + 48 * 272) = k3;
      d = KTs + trow * 144 + tc * 16;
      *(uint4*)(d) = t0; *(uint4*)(d + 32 * 144) = t1; *(uint4*)(d + 64 * 144) = t2; *(uint4*)(d + 96 * 144) = t3;
      st8t(Vts + (vc * 8) * 144 + vrow * 2, vv);
      if (tid < 128) decs[tid] = dd;
      if (wave < 2 && ci > 0) {
        u16* og = PHG + (otok + 32 * wave + 4 * hh) * 2560 + ocol + r;
#pragma unroll
        for (int i = 0; i < 8; ++i) {
          og[(size_t)(((2 * i) & 3) + 8 * ((2 * i) >> 2)) * 2560] = (u16)(opk[i] & 0xffffu);
          og[(size_t)(((2 * i + 1) & 3) + 8 * ((2 * i + 1) >> 2)) * 2560] = (u16)(opk[i] >> 16);
        }
      }
      if (wave >= 2 && ci > 0) {
#pragma unroll
        for (int t = 0; t < 2; ++t) {
          const int kt = 2 * (wave - 2) + t;
#pragma unroll
          for (int rg = 0; rg < 4; ++rg) {
            const int kk0 = 32 * kt + 8 * rg + 4 * hh;
            *(uint2*)(Sts + r * 272 + kk0 * 2) = make_uint2(pack2(accS[t][4 * rg + 0], accS[t][4 * rg + 1]),
                                                            pack2(accS[t][4 * rg + 2], accS[t][4 * rg + 3]));
          }
        }
      }
    }
    SCAN_BAR();
    {
      const int nn = (ci + 1 < NC) ? (dir ? NC - 2 - ci : ci + 1) : n;
      SCAN_ISSUE(nn);
    }
    __builtin_amdgcn_sched_barrier(0);
    {
      const int jt = wave >> 1, st = wave & 1;
      const bool active = dir ? (st >= jt) : (st <= jt);
      f32x16 pa;
#pragma unroll
      for (int i = 0; i < 16; ++i) pa[i] = 0.f;
      if (active) {
        bf16x8 qa[8], kb[8];
#pragma unroll
        for (int ks = 0; ks < 8; ++ks) {
          qa[ks] = *(const bf16x8*)(Qs + (32 * jt + r) * 272 + ks * 32 + hh * 16);
          kb[ks] = *(const bf16x8*)(Ks + (32 * st + r) * 272 + ks * 32 + hh * 16);
        }
        __builtin_amdgcn_sched_barrier(0);
        f32x16 p1;
#pragma unroll
        for (int i = 0; i < 16; ++i) p1[i] = 0.f;
#pragma unroll
        for (int ks = 0; ks < 4; ++ks) {
          pa = __builtin_amdgcn_mfma_f32_32x32x16_bf16(qa[2 * ks], kb[2 * ks], pa, 0, 0, 0);
          p1 = __builtin_amdgcn_mfma_f32_32x32x16_bf16(qa[2 * ks + 1], kb[2 * ks + 1], p1, 0, 0, 0);
        }
#pragma unroll
        for (int i = 0; i < 16; ++i) pa[i] += p1[i];
      }
#pragma unroll
      for (int i = 0; i < 16; ++i) {
        const int j = 32 * jt + (i & 3) + 8 * (i >> 2) + 4 * hh;
        const int s_ = 32 * st + r;
        const bool keep = dir ? (s_ >= j) : (s_ <= j);
        *(u16*)(Ps + j * 144 + s_ * 2) = keep ? f2bf(pa[i]) : (u16)0;
      }
    }
    SCAN_BAR();
    if (wave < 2) {
      const int jt = wave;
      bf16x8 pp[4], vb[4], qa[4], sb[4];
#pragma unroll
      for (int ks = 0; ks < 4; ++ks) {
        pp[ks] = *(const bf16x8*)(Ps + (32 * jt + r) * 144 + ks * 32 + hh * 16);
        vb[ks] = *(const bf16x8*)(Vts + r * 144 + ks * 32 + hh * 16);
        qa[ks] = *(const bf16x8*)(Qs + (32 * jt + r) * 272 + ks * 32 + hh * 16);
        sb[ks] = *(const bf16x8*)(Sts + r * 272 + ks * 32 + hh * 16);
      }
      __builtin_amdgcn_sched_barrier(0);
      f32x16 o, o1;
#pragma unroll
      for (int i = 0; i < 16; ++i) { o[i] = 0.f; o1[i] = 0.f; }
#pragma unroll
      for (int ks = 0; ks < 4; ++ks) {
        o = __builtin_amdgcn_mfma_f32_32x32x16_bf16(pp[ks], vb[ks], o, 0, 0, 0);
        o1 = __builtin_amdgcn_mfma_f32_32x32x16_bf16(qa[ks], sb[ks], o1, 0, 0, 0);
      }
      __builtin_amdgcn_sched_barrier(0);
#pragma unroll
      for (int ks = 0; ks < 4; ++ks) {
        qa[ks] = *(const bf16x8*)(Qs + (32 * jt + r) * 272 + (ks + 4) * 32 + hh * 16);
        sb[ks] = *(const bf16x8*)(Sts + r * 272 + (ks + 4) * 32 + hh * 16);
      }
      __builtin_amdgcn_sched_barrier(0);
      o = __builtin_amdgcn_mfma_f32_32x32x16_bf16(qa[0], sb[0], o, 0, 0, 0);
      o1 = __builtin_amdgcn_mfma_f32_32x32x16_bf16(qa[1], sb[1], o1, 0, 0, 0);
      o = __builtin_amdgcn_mfma_f32_32x32x16_bf16(qa[2], sb[2], o, 0, 0, 0);
      o1 = __builtin_amdgcn_mfma_f32_32x32x16_bf16(qa[3], sb[3], o1, 0, 0, 0);
      f32x16 o2;
#pragma unroll
      for (int i = 0; i < 16; ++i) o2[i] = 0.f;
#pragma unroll
      for (int i = 0; i < 8; ++i)
        opk[i] = pack2(o[2 * i] + o1[2 * i] + o2[2 * i], o[2 * i + 1] + o1[2 * i + 1] + o2[2 * i + 1]);
      otok = tok0;
    } else {
      const int kt0 = 2 * (wave - 2);
      bf16x8 ka[2][4], vb[4];
#pragma unroll
      for (int ks = 0; ks < 4; ++ks) {
        vb[ks] = *(const bf16x8*)(Vts + r * 144 + ks * 32 + hh * 16);
        ka[0][ks] = *(const bf16x8*)(KTs + (32 * kt0 + r) * 144 + ks * 32 + hh * 16);
        ka[1][ks] = *(const bf16x8*)(KTs + (32 * (kt0 + 1) + r) * 144 + ks * 32 + hh * 16);
      }
      __builtin_amdgcn_sched_barrier(0);
#pragma unroll
      for (int ks = 0; ks < 4; ++ks) {
        accS[0] = __builtin_amdgcn_mfma_f32_32x32x16_bf16(ka[0][ks], vb[ks], accS[0], 0, 0, 0);
        accS[1] = __builtin_amdgcn_mfma_f32_32x32x16_bf16(ka[1][ks], vb[ks], accS[1], 0, 0, 0);
      }
#pragma unroll
      for (int t = 0; t < 2; ++t)
#pragma unroll
        for (int i = 0; i < 16; ++i) accS[t][i] *= decs[32 * (kt0 + t) + (i & 3) + 8 * (i >> 2) + 4 * hh];
    }
    SCAN_BAR();
  }
  if (wave < 2) {
    u16* og = PHG + (otok + 32 * wave + 4 * hh) * 2560 + ocol + r;
#pragma unroll
    for (int i = 0; i < 8; ++i) {
      og[(size_t)(((2 * i) & 3) + 8 * ((2 * i) >> 2)) * 2560] = (u16)(opk[i] & 0xffffu);
      og[(size_t)(((2 * i + 1) & 3) + 8 * ((2 * i + 1) >> 2)) * 2560] = (u16)(opk[i] >> 16);
    }
  }
#undef SCAN_ISSUE
#undef SCAN_BAR
}

DEV float conv3_at(const u16* __restrict__ row, int t, int L, float w0, float w1, float w2, float bb) {
  const float um = (t > 0) ? bf2f(row[t - 1]) : 0.f;
  const float u0 = bf2f(row[t]);
  const float up = (t < L - 1) ? bf2f(row[t + 1]) : 0.f;
  return um * w0 + u0 * w1 + up * w2 + bb;
}

struct F8 { float v[8]; };
DEV F8 conv8(const u16* __restrict__ row, int t, int L, float w0, float w1, float w2, float bb) {
  const uint4 u = *(const uint4*)(row + t);
  const float um = (t > 0) ? bf2f(row[t - 1]) : 0.f;
  const float up = (t + 8 < L) ? bf2f(row[t + 8]) : 0.f;
  float x[10];
  x[0] = um;
  x[1] = bflo(u.x); x[2] = bfhi(u.x); x[3] = bflo(u.y); x[4] = bfhi(u.y);
  x[5] = bflo(u.z); x[6] = bfhi(u.z); x[7] = bflo(u.w); x[8] = bfhi(u.w);
  x[9] = up;
  F8 o;
#pragma unroll
  for (int j = 0; j < 8; ++j) o.v[j] = x[j] * w0 + x[j + 1] * w1 + x[j + 2] * w2 + bb;
  return o;
}

template <int BG>
DEV void hyena_item_mfma(const Params& p, int g, int item, char* smem, int half) {
  constexpr int NT = 256 / BG;
  constexpr int L = NT * 64;
  constexpr int VROW = 144;
  constexpr int RK1 = 4 * L + 64;
  constexpr int VBASE = 2 * (4 * L + 64);
  const int c = item >> 1, bgi = item & 1;
  char* Vl = smem + VBASE + half * (257 * VROW);
  u16* UHY = (u16*)(p.ws + OFF_UHY);
  const u16* RK = (const u16*)(p.ws + OFF_KK) + (g ? (size_t)512 * 8192 : 0) + (size_t)c * 2 * L;
  const float* cw = p.in[I_CONVW];
  const float* cb = p.in[I_CONVB];
  const int tid = tidx();
  __syncthreads();
  if (half == 0) {
#pragma unroll 8
    for (int e = tid; e < 2 * L / 8; e += 256) ((uint4*)smem)[e] = ((const uint4*)RK)[e];
  } else {
#pragma unroll 4
    for (int e = tid; e < 2 * L / 8; e += 256) {
      const uint4 v = ((const uint4*)RK)[e];
      const unsigned nx = (8 * e + 8 < 2 * L) ? (unsigned)RK[8 * e + 8] : 0u;
      uint4 o;
      o.x = (v.x >> 16) | (v.y << 16);
      o.y = (v.y >> 16) | (v.z << 16);
      o.z = (v.z >> 16) | (v.w << 16);
      o.w = (v.w >> 16) | (nx << 16);
      ((uint4*)(smem + RK1))[e] = o;
    }
  }
  {
    const float wx1_0 = cw[0 * 1536 + 512 + c], wx1_1 = cw[1 * 1536 + 512 + c], wx1_2 = cw[2 * 1536 + 512 + c], bx1 = cb[512 + c];
    const float wv_0 = cw[0 * 1536 + 1024 + c], wv_1 = cw[1 * 1536 + 1024 + c], wv_2 = cw[2 * 1536 + 1024 + c], bv = cb[1024 + c];
#pragma unroll 4
    for (int e = tid; e < BG * L / 8; e += 256) {
      const int bl = e / (L / 8), t = (e % (L / 8)) * 8;
      const int b = bgi * BG + bl;
      const F8 a = conv8(UHY + ((size_t)b * 1536 + 1024 + c) * L, t, L, wv_0, wv_1, wv_2, bv);
      const F8 x = conv8(UHY + ((size_t)b * 1536 + 512 + c) * L, t, L, wx1_0, wx1_1, wx1_2, bx1);
      *(uint4*)(Vl + ((t >> 6) * BG + bl) * VROW + (t & 63) * 2) =
          make_uint4(pack2(a.v[0] * x.v[0], a.v[1] * x.v[1]), pack2(a.v[2] * x.v[2], a.v[3] * x.v[3]),
                     pack2(a.v[4] * x.v[4], a.v[5] * x.v[5]), pack2(a.v[6] * x.v[6], a.v[7] * x.v[7]));
    }
  }
  if (tid < 9) *(uint4*)(Vl + 256 * VROW + tid * 16) = make_uint4(0u, 0u, 0u, 0u);
  __syncthreads();
  const int wave = tid >> 6, lane = tid & 63;
  const int n = lane & 31, hh = lane >> 5;
  Acc acc;
  acc_zero(acc);
  const int colw = wave * 64;
  {
    typedef __attribute__((ext_vector_type(2))) unsigned u32x2;
    typedef __attribute__((ext_vector_type(4))) unsigned u32x4;
    struct HySet {
      u32x2 wlo[6], whi[6];
      u32x4 bv[2][4];
      bool valid[2];
    };
    const int Tw0 = colw / BG;
    const int dlo = Tw0 - NT + 1, dhi = Tw0 + 64 / BG - 1;
    const int par = n & 1;
    const unsigned pkb = (unsigned)(size_t)smem + (par ? RK1 : 0) + 2u * (unsigned)(L - n + 8 * hh - 32 - par);
    const unsigned vlb = (unsigned)(size_t)Vl;
#define HY_PREP(Y_, dl_)                                              \
    const unsigned pabY_ = pkb - 128u * (unsigned)(dl_);               \
    unsigned pbY0_;                                                    \
    {                                                                  \
      const int col = colw + 0 + n;                                   \
      const int S = col / BG - (dl_);                                  \
      Y_.valid[0] = (unsigned)S < (unsigned)NT;                        \
      const int scol = Y_.valid[0] ? col - (dl_) * BG : 256;           \
      pbY0_ = vlb + (unsigned)(scol * VROW + hh * 16);                 \
    }                                                                  \
    unsigned pbY1_;                                                    \
    {                                                                  \
      const int col = colw + 32 + n;                                   \
      const int S = col / BG - (dl_);                                  \
      Y_.valid[1] = (unsigned)S < (unsigned)NT;                        \
      const int scol = Y_.valid[1] ? col - (dl_) * BG : 256;           \
      pbY1_ = vlb + (unsigned)(scol * VROW + hh * 16);                 \
    }                                                                  \

#define HY_ISSUE0(Y_, dl_)                                            \
    {                                                                  \
      HY_PREP(Y_, dl_)                                                 \
      asm volatile("ds_read2_b32 %0, %1 offset0:0 offset1:1" : "=v"(Y_.wlo[0]) : "v"(pabY_));  \
      asm volatile("ds_read2_b32 %0, %1 offset0:2 offset1:3" : "=v"(Y_.whi[0]) : "v"(pabY_));  \
      asm volatile("ds_read2_b32 %0, %1 offset0:8 offset1:9" : "=v"(Y_.wlo[1]) : "v"(pabY_));  \
      asm volatile("ds_read2_b32 %0, %1 offset0:10 offset1:11" : "=v"(Y_.whi[1]) : "v"(pabY_));  \
      asm volatile("ds_read2_b32 %0, %1 offset0:16 offset1:17" : "=v"(Y_.wlo[2]) : "v"(pabY_));  \
      asm volatile("ds_read2_b32 %0, %1 offset0:18 offset1:19" : "=v"(Y_.whi[2]) : "v"(pabY_));  \
      asm volatile("ds_read2_b32 %0, %1 offset0:24 offset1:25" : "=v"(Y_.wlo[3]) : "v"(pabY_));  \
      asm volatile("ds_read2_b32 %0, %1 offset0:26 offset1:27" : "=v"(Y_.whi[3]) : "v"(pabY_));  \
      asm volatile("ds_read2_b32 %0, %1 offset0:32 offset1:33" : "=v"(Y_.wlo[4]) : "v"(pabY_));  \
      asm volatile("ds_read2_b32 %0, %1 offset0:34 offset1:35" : "=v"(Y_.whi[4]) : "v"(pabY_));  \
      asm volatile("ds_read2_b32 %0, %1 offset0:40 offset1:41" : "=v"(Y_.wlo[5]) : "v"(pabY_));  \
      asm volatile("ds_read2_b32 %0, %1 offset0:42 offset1:43" : "=v"(Y_.whi[5]) : "v"(pabY_));  \
      asm volatile("ds_read_b128 %0, %1 offset:0" : "=v"(Y_.bv[0][0]) : "v"(pbY0_));  \
      asm volatile("ds_read_b128 %0, %1 offset:32" : "=v"(Y_.bv[0][1]) : "v"(pbY0_));  \
      asm volatile("ds_read_b128 %0, %1 offset:64" : "=v"(Y_.bv[0][2]) : "v"(pbY0_));  \
      asm volatile("ds_read_b128 %0, %1 offset:96" : "=v"(Y_.bv[0][3]) : "v"(pbY0_));  \
      asm volatile("ds_read_b128 %0, %1 offset:0" : "=v"(Y_.bv[1][0]) : "v"(pbY1_));  \
      asm volatile("ds_read_b128 %0, %1 offset:32" : "=v"(Y_.bv[1][1]) : "v"(pbY1_));  \
      asm volatile("ds_read_b128 %0, %1 offset:64" : "=v"(Y_.bv[1][2]) : "v"(pbY1_));  \
      asm volatile("ds_read_b128 %0, %1 offset:96" : "=v"(Y_.bv[1][3]) : "v"(pbY1_));  \
    }

#define HY_STEP(X_, Y_, dl_)                                          \
    {                                                                  \
      HY_PREP(Y_, dl_)                                                 \
      bf16x8 a[6];                                                     \
      _Pragma("unroll") for (int q = 0; q < 6; ++q) {                  \
        const u32x4 t = {X_.wlo[q][0], X_.wlo[q][1], X_.whi[q][0], X_.whi[q][1]}; \
        a[q] = __builtin_bit_cast(bf16x8, t);                          \
      }                                                                \
      {                                                                \
        u32x4 bq = X_.bv[0][0];                                        \
        const bf16x8 bb = __builtin_bit_cast(bf16x8, bq);              \
        __builtin_amdgcn_sched_barrier(0);                             \
        asm volatile("ds_read2_b32 %0, %1 offset0:0 offset1:1" : "=v"(Y_.wlo[0]) : "v"(pabY_));  \
        asm volatile("ds_read2_b32 %0, %1 offset0:2 offset1:3" : "=v"(Y_.whi[0]) : "v"(pabY_));  \
        __builtin_amdgcn_sched_barrier(0);                             \
        asm volatile("s_nop 1\n\tv_mfma_f32_32x32x16_bf16 %0, %1, %2, %0" : "+v"(acc[0][0]) : "v"(a[2]), "v"(bb)); \
        __builtin_amdgcn_sched_barrier(0);                             \
        asm volatile("ds_read2_b32 %0, %1 offset0:8 offset1:9" : "=v"(Y_.wlo[1]) : "v"(pabY_));  \
        asm volatile("ds_read2_b32 %0, %1 offset0:10 offset1:11" : "=v"(Y_.whi[1]) : "v"(pabY_));  \
        __builtin_amdgcn_sched_barrier(0);                             \
        asm volatile("s_nop 1\n\tv_mfma_f32_32x32x16_bf16 %0, %1, %2, %0" : "+v"(acc[0][1]) : "v"(a[0]), "v"(bb)); \
      }                                                                \
      {                                                                \
        u32x4 bq = X_.bv[0][1];                                        \
        const bf16x8 bb = __builtin_bit_cast(bf16x8, bq);              \
        __builtin_amdgcn_sched_barrier(0);                             \
        asm volatile("ds_read2_b32 %0, %1 offset0:16 offset1:17" : "=v"(Y_.wlo[2]) : "v"(pabY_));  \
        asm volatile("ds_read2_b32 %0, %1 offset0:18 offset1:19" : "=v"(Y_.whi[2]) : "v"(pabY_));  \
        __builtin_amdgcn_sched_barrier(0);                             \
        asm volatile("s_nop 1\n\tv_mfma_f32_32x32x16_bf16 %0, %1, %2, %0" : "+v"(acc[0][0]) : "v"(a[3]), "v"(bb)); \
        __builtin_amdgcn_sched_barrier(0);                             \
        asm volatile("ds_read2_b32 %0, %1 offset0:24 offset1:25" : "=v"(Y_.wlo[3]) : "v"(pabY_));  \
        asm volatile("ds_read2_b32 %0, %1 offset0:26 offset1:27" : "=v"(Y_.whi[3]) : "v"(pabY_));  \
        __builtin_amdgcn_sched_barrier(0);                             \
        asm volatile("s_nop 1\n\tv_mfma_f32_32x32x16_bf16 %0, %1, %2, %0" : "+v"(acc[0][1]) : "v"(a[1]), "v"(bb)); \
      }                                                                \
      {                                                                \
        u32x4 bq = X_.bv[0][2];                                        \
        const bf16x8 bb = __builtin_bit_cast(bf16x8, bq);              \
        __builtin_amdgcn_sched_barrier(0);                             \
        asm volatile("ds_read2_b32 %0, %1 offset0:32 offset1:33" : "=v"(Y_.wlo[4]) : "v"(pabY_));  \
        asm volatile("ds_read2_b32 %0, %1 offset0:34 offset1:35" : "=v"(Y_.whi[4]) : "v"(pabY_));  \
        __builtin_amdgcn_sched_barrier(0);                             \
        asm volatile("s_nop 1\n\tv_mfma_f32_32x32x16_bf16 %0, %1, %2, %0" : "+v"(acc[0][0]) : "v"(a[4]), "v"(bb)); \
        __builtin_amdgcn_sched_barrier(0);                             \
        asm volatile("ds_read2_b32 %0, %1 offset0:40 offset1:41" : "=v"(Y_.wlo[5]) : "v"(pabY_));  \
        asm volatile("ds_read2_b32 %0, %1 offset0:42 offset1:43" : "=v"(Y_.whi[5]) : "v"(pabY_));  \
        __builtin_amdgcn_sched_barrier(0);                             \
        asm volatile("s_nop 1\n\tv_mfma_f32_32x32x16_bf16 %0, %1, %2, %0" : "+v"(acc[0][1]) : "v"(a[2]), "v"(bb)); \
      }                                                                \
      {                                                                \
        u32x4 bq = X_.bv[0][3];                                        \
        const bf16x8 bb = __builtin_bit_cast(bf16x8, bq);              \
        __builtin_amdgcn_sched_barrier(0);                             \
        asm volatile("ds_read_b128 %0, %1 offset:0" : "=v"(Y_.bv[0][0]) : "v"(pbY0_));  \
        asm volatile("ds_read_b128 %0, %1 offset:32" : "=v"(Y_.bv[0][1]) : "v"(pbY0_));  \
        __builtin_amdgcn_sched_barrier(0);                             \
        asm volatile("s_nop 1\n\tv_mfma_f32_32x32x16_bf16 %0, %1, %2, %0" : "+v"(acc[0][0]) : "v"(a[5]), "v"(bb)); \
        __builtin_amdgcn_sched_barrier(0);                             \
        asm volatile("ds_read_b128 %0, %1 offset:64" : "=v"(Y_.bv[0][2]) : "v"(pbY0_));  \
        asm volatile("ds_read_b128 %0, %1 offset:96" : "=v"(Y_.bv[0][3]) : "v"(pbY0_));  \
        __builtin_amdgcn_sched_barrier(0);                             \
        asm volatile("s_nop 1\n\tv_mfma_f32_32x32x16_bf16 %0, %1, %2, %0" : "+v"(acc[0][1]) : "v"(a[3]), "v"(bb)); \
      }                                                                \
      {                                                                \
        u32x4 bq = X_.bv[1][0];                                        \
        const bf16x8 bb = __builtin_bit_cast(bf16x8, bq);              \
        __builtin_amdgcn_sched_barrier(0);                             \
        asm volatile("ds_read_b128 %0, %1 offset:0" : "=v"(Y_.bv[1][0]) : "v"(pbY1_));  \
        asm volatile("ds_read_b128 %0, %1 offset:32" : "=v"(Y_.bv[1][1]) : "v"(pbY1_));  \
        __builtin_amdgcn_sched_barrier(0);                             \
        asm volatile("s_nop 1\n\tv_mfma_f32_32x32x16_bf16 %0, %1, %2, %0" : "+v"(acc[1][0]) : "v"(a[2]), "v"(bb)); \
        __builtin_amdgcn_sched_barrier(0);                             \
        asm volatile("ds_read_b128 %0, %1 offset:64" : "=v"(Y_.bv[1][2]) : "v"(pbY1_));  \
        asm volatile("ds_read_b128 %0, %1 offset:96" : "=v"(Y_.bv[1][3]) : "v"(pbY1_));  \
        __builtin_amdgcn_sched_barrier(0);                             \
        asm volatile("s_nop 1\n\tv_mfma_f32_32x32x16_bf16 %0, %1, %2, %0" : "+v"(acc[1][1]) : "v"(a[0]), "v"(bb)); \
      }                                                                \
      {                                                                \
        u32x4 bq = X_.bv[1][1];                                        \
        const bf16x8 bb = __builtin_bit_cast(bf16x8, bq);              \
        __builtin_amdgcn_sched_barrier(0);                             \
        __builtin_amdgcn_sched_barrier(0);                             \
        asm volatile("s_nop 1\n\tv_mfma_f32_32x32x16_bf16 %0, %1, %2, %0" : "+v"(acc[1][0]) : "v"(a[3]), "v"(bb)); \
        __builtin_amdgcn_sched_barrier(0);                             \
        __builtin_amdgcn_sched_barrier(0);                             \
        asm volatile("s_nop 1\n\tv_mfma_f32_32x32x16_bf16 %0, %1, %2, %0" : "+v"(acc[1][1]) : "v"(a[1]), "v"(bb)); \
      }                                                                \
      {                                                                \
        u32x4 bq = X_.bv[1][2];                                        \
        const bf16x8 bb = __builtin_bit_cast(bf16x8, bq);              \
        __builtin_amdgcn_sched_barrier(0);                             \
        __builtin_amdgcn_sched_barrier(0);                             \
        asm volatile("s_nop 1\n\tv_mfma_f32_32x32x16_bf16 %0, %1, %2, %0" : "+v"(acc[1][0]) : "v"(a[4]), "v"(bb)); \
        __builtin_amdgcn_sched_barrier(0);                             \
        __builtin_amdgcn_sched_barrier(0);                             \
        asm volatile("s_nop 1\n\tv_mfma_f32_32x32x16_bf16 %0, %1, %2, %0" : "+v"(acc[1][1]) : "v"(a[2]), "v"(bb)); \
      }                                                                \
      {                                                                \
        u32x4 bq = X_.bv[1][3];                                        \
        const bf16x8 bb = __builtin_bit_cast(bf16x8, bq);              \
        __builtin_amdgcn_sched_barrier(0);                             \
        __builtin_amdgcn_sched_barrier(0);                             \
        asm volatile("s_nop 1\n\tv_mfma_f32_32x32x16_bf16 %0, %1, %2, %0" : "+v"(acc[1][0]) : "v"(a[5]), "v"(bb)); \
        __builtin_amdgcn_sched_barrier(0);                             \
        __builtin_amdgcn_sched_barrier(0);                             \
        asm volatile("s_nop 1\n\tv_mfma_f32_32x32x16_bf16 %0, %1, %2, %0" : "+v"(acc[1][1]) : "v"(a[3]), "v"(bb)); \
      }                                                                \
    }

#define HY_COMPUTE(X_)                                                \
    {                                                                  \
      bf16x8 a[6];                                                     \
      _Pragma("unroll") for (int q = 0; q < 6; ++q) {                  \
        const u32x4 t = {X_.wlo[q][0], X_.wlo[q][1], X_.whi[q][0], X_.whi[q][1]}; \
        a[q] = __builtin_bit_cast(bf16x8, t);                          \
      }                                                                \
      _Pragma("unroll") for (int nt = 0; nt < 2; ++nt) {               \
        _Pragma("unroll") for (int ks = 0; ks < 4; ++ks) {             \
          u32x4 bq = X_.bv[nt][ks];                                    \
          const bf16x8 bb = __builtin_bit_cast(bf16x8, bq);            \
          acc[nt][0] = __builtin_amdgcn_mfma_f32_32x32x16_bf16(a[ks + 2], bb, acc[nt][0], 0, 0, 0); \
          acc[nt][1] = __builtin_amdgcn_mfma_f32_32x32x16_bf16(a[ks], bb, acc[nt][1], 0, 0, 0);     \
        }                                                              \
      }                                                                \
    }
#define HY_WAIT(S_) asm volatile("s_waitcnt lgkmcnt(0)" : "+v"(S_.wlo[0]), "+v"(S_.whi[0]), "+v"(S_.wlo[1]), "+v"(S_.whi[1]), "+v"(S_.wlo[2]), "+v"(S_.whi[2]), "+v"(S_.wlo[3]), "+v"(S_.whi[3]), "+v"(S_.wlo[4]), "+v"(S_.whi[4]), "+v"(S_.wlo[5]), "+v"(S_.whi[5]), "+v"(S_.bv[0][0]), "+v"(S_.bv[0][1]), "+v"(S_.bv[0][2]), "+v"(S_.bv[0][3]), "+v"(S_.bv[1][0]), "+v"(S_.bv[1][1]), "+v"(S_.bv[1][2]), "+v"(S_.bv[1][3]) :: "memory")
    HySet s0, s1;
    HY_ISSUE0(s0, dlo);
    int dl = dlo;
    for (; dl + 1 <= dhi; dl += 2) {
      HY_WAIT(s0);
      HY_STEP(s0, s1, dl + 1);
      __builtin_amdgcn_sched_barrier(0);
      HY_WAIT(s1);
      {
        const int d2 = (dl + 2 <= dhi) ? dl + 2 : dhi;
        HY_STEP(s1, s0, d2);
      }
      __builtin_amdgcn_sched_barrier(0);
    }
    if (dl == dhi) {
      HY_WAIT(s0);
      HY_COMPUTE(s0);
    }
    asm volatile("s_waitcnt lgkmcnt(0)" ::: "memory");
#undef HY_PREP
#undef HY_ISSUE0
#undef HY_STEP
#undef HY_COMPUTE
#undef HY_WAIT
  }
  __syncthreads();
  {
    const float fbias = p.in[I_FBIAS][c];
#pragma unroll
    for (int nt = 0; nt < 2; ++nt)
#pragma unroll
      for (int mi = 0; mi < 2; ++mi)
#pragma unroll
        for (int rg = 0; rg < 4; ++rg) {
          const int col = colw + 32 * nt + n, i0 = 32 * mi + 8 * rg + 4 * hh;
          char* pv = Vl + col * VROW + i0 * 2;
          const uint2 w = *(const uint2*)pv;
          const float t0 = acc[nt][mi][4 * rg + 0] + bflo(w.x) * fbias;
          const float t1 = acc[nt][mi][4 * rg + 1] + bfhi(w.x) * fbias;
          const float t2 = acc[nt][mi][4 * rg + 2] + bflo(w.y) * fbias;
          const float t3 = acc[nt][mi][4 * rg + 3] + bfhi(w.y) * fbias;
          *(uint2*)pv = make_uint2(pack2(t0, t1), pack2(t2, t3));
        }
  }
  __syncthreads();
  {
    const float wx0_0 = cw[0 * 1536 + c], wx0_1 = cw[1 * 1536 + c], wx0_2 = cw[2 * 1536 + c], bx0 = cb[c];
    for (int e0 = tid; e0 < BG * L / 8; e0 += 256 * 4) {
      F8 x[4];
      uint4 y[4];
#pragma unroll
      for (int u = 0; u < 4; ++u) {
        const int e = e0 + 256 * u;
        const int bl = e / (L / 8), t = (e % (L / 8)) * 8;
        const int b = bgi * BG + bl;
        x[u] = conv8(UHY + ((size_t)b * 1536 + c) * L, t, L, wx0_0, wx0_1, wx0_2, bx0);
        y[u] = *(const uint4*)(Vl + ((t >> 6) * BG + bl) * VROW + (t & 63) * 2);
      }
#pragma unroll
      for (int u = 0; u < 4; ++u) {
        const int e = e0 + 256 * u;
        const int bl = e / (L / 8), t = (e % (L / 8)) * 8;
        const int b = bgi * BG + bl;
        *(uint4*)(UHY + ((size_t)b * 1536 + 1024 + c) * L + t) =
            make_uint4(pack2(bflo(y[u].x) * x[u].v[0], bfhi(y[u].x) * x[u].v[1]), pack2(bflo(y[u].y) * x[u].v[2], bfhi(y[u].y) * x[u].v[3]),
                       pack2(bflo(y[u].z) * x[u].v[4], bfhi(y[u].z) * x[u].v[5]), pack2(bflo(y[u].w) * x[u].v[6], bfhi(y[u].w) * x[u].v[7]));
      }
    }
  }
}

DEV void phase_p2_naive(const Params& p, int g, char* hsm) {
  __shared__ int s_item;
  const int nscan = g ? 128 : 256;
  const int nhy = 1024;
  unsigned* cnt = (unsigned*)(p.ws + OFF_CNT) + g;
  const int half = vhalf();
  if ((int)blockIdx.x * 2 < nscan) scan_item_mfma(p, g, blockIdx.x * 2 + half, hsm);
  for (;;) {
    __syncthreads();
    if (threadIdx.x == 0) s_item = (int)atomicAdd(cnt, 2u);
    __syncthreads();
    const int it = s_item + half;
    if (it >= nhy) break;
    if (g == 0) hyena_item_mfma<4>(p, g, it, hsm - half * HALF_BYTES, half);
    else hyena_item_mfma<2>(p, g, it, hsm - half * HALF_BYTES, half);
  }
  unsigned* cnt2 = (unsigned*)(p.ws + OFF_CNT) + 2 + g;
  const float* mod = (const float*)(p.ws + OFF_MOD);
  for (;;) {
    __syncthreads();
    if (threadIdx.x == 0) s_item = (int)atomicAdd(cnt2, 2u);
    __syncthreads();
    const int it = s_item + half;
    if (it >= 512) break;
    if (g == 0) norm_adaln_rows(p.in[I_XS], p.in[I_N1G], mod, 8, 8192, 0, 1024, (u16*)(p.out + (size_t)NTOK * D), it * 64);
    else final_norm_rows(p.out, p.in[I_FING], it * 64);
  }
}

DEV void phase_p2c(const Params& p, int g) {
  u16* PHG = (u16*)(p.ws + OFF_PHG);
  const float* gn = p.in[I_GNG];
  const int tid = tidx();
  const int wave = tid >> 6, lane = tid & 63;
  constexpr int RB = 4;
  const int stride = NVB * 4;
  const int c = lane * 8;
  for (int tok0 = VBID * 4 + wave; tok0 < NTOK; tok0 += stride * RB) {
    uint4 a[RB], bq[RB], og[RB];
#pragma unroll
    for (int j = 0; j < RB; ++j) {
      const int t_ = tok0 + j * stride;
      const size_t tok = (size_t)(t_ < NTOK ? t_ : tok0);
      a[j] = *(const uint4*)(PHG + tok * 2560 + c);
      bq[j] = *(const uint4*)(PHG + tok * 2560 + 1024 + c);
      og[j] = *(const uint4*)(PHG + tok * 2560 + 2048 + c);
    }
    const float4 g0 = *(const float4*)(gn + c), g1 = *(const float4*)(gn + c + 4);
#pragma unroll
    for (int j = 0; j < RB; ++j) {
      const int t_ = tok0 + j * stride;
      float o[8];
      o[0] = bflo(a[j].x) + bflo(bq[j].x); o[1] = bfhi(a[j].x) + bfhi(bq[j].x);
      o[2] = bflo(a[j].y) + bflo(bq[j].y); o[3] = bfhi(a[j].y) + bfhi(bq[j].y);
      o[4] = bflo(a[j].z) + bflo(bq[j].z); o[5] = bfhi(a[j].z) + bfhi(bq[j].z);
      o[6] = bflo(a[j].w) + bflo(bq[j].w); o[7] = bfhi(a[j].w) + bfhi(bq[j].w);
      float ss = 0.f;
#pragma unroll
      for (int i = 0; i < 8; ++i) ss += o[i] * o[i];
      ss += __shfl_xor(ss, 1);
      ss += __shfl_xor(ss, 2);
      ss += __shfl_xor(ss, 4);
      ss += __shfl_xor(ss, 8);
      const float rstd = rsqrtf(ss * (1.f / 128.f) + EPSF);
      const float y0 = o[0] * rstd * g0.x * bflo(og[j].x), y1 = o[1] * rstd * g0.y * bfhi(og[j].x);
      const float y2 = o[2] * rstd * g0.z * bflo(og[j].y), y3 = o[3] * rstd * g0.w * bfhi(og[j].y);
      const float y4 = o[4] * rstd * g1.x * bflo(og[j].z), y5 = o[5] * rstd * g1.y * bfhi(og[j].z);
      const float y6 = o[6] * rstd * g1.z * bflo(og[j].w), y7 = o[7] * rstd * g1.w * bfhi(og[j].w);
      if (t_ < NTOK)
        *(uint4*)(PHG + (size_t)t_ * 2560 + c) = make_uint4(pack2(y0, y1), pack2(y2, y3), pack2(y4, y5), pack2(y6, y7));
    }
  }
}

DEV void tile_order(int tile, int ntn, int& mt, int& nt) {
  const int grp = tile / (16 * ntn), rem = tile % (16 * ntn);
  mt = grp * 16 + (rem & 15);
  nt = rem >> 4;
}

DEV void phase_p3a(const Params& p, int g, char* smem) {
  const int L = g ? 8192 : 4096;
  u16* PHG = (u16*)(p.ws + OFF_PHG);
  const u16* GT = (const u16*)(p.ws + OFF_GT);
  const u16* UHY = (const u16*)(p.ws + OFF_UHY);
  const u16* WbrT = (const u16*)(p.ws + OFF_WBR);
  for (int iter = 0;; ++iter) {
    int mt, nt;
    if (!tile_map(iter, 128, 4, mt, nt)) break;
    const int m0 = mt * 256, n0 = nt * 256;
    Acc acc;
    acc_zero(acc);
    {
      TransLoader al{UHY, L};
      RowLoader bl{WbrT, 1024};
      gemm_mainloop(acc, al, bl, m0, n0, 0, 512, smem);
    }
    acc_foreach(acc, m0, n0, [&](int m, int n, float& v) {
      const float ga = bf2f(GT[(size_t)m * 2048 + n]);
      const float gb = bf2f(GT[(size_t)m * 2048 + 1024 + n]);
      v *= ga * __builtin_amdgcn_rcpf(fmaxf(gb, 1e-30f));
    });
    {
      RowLoader al{PHG - 512, 2560};
      RowLoader bl{WbrT, 1024};
      gemm_mainloop(acc, al, bl, m0, n0, 512, 1024, smem);
    }
    acc_foreach(acc, m0, n0, [&](int m, int n, float& v) {
      const float gb = bf2f(GT[(size_t)m * 2048 + 1024 + n]);
      PHG[(size_t)m * 2560 + 1024 + n] = f2bf(gb * v);
    });
  }
}

DEV void phase_p3b(const Params& p, int g, char* smem) {
  const int L = g ? 8192 : 4096;
  const int bg0 = g ? 8 : 0;
  const u16* PHG = (const u16*)(p.ws + OFF_PHG);
  const u16* WoutT = (const u16*)(p.ws + OFF_WOUT);
  const float* X = p.in[g ? I_XS : I_XP];
  const float* mod = (const float*)(p.ws + OFF_MOD);
  float* X1 = p.out + (size_t)g * NTOK * D;
  for (int iter = 0;; ++iter) {
    int mt, nt;
    if (!tile_map(iter, 128, 4, mt, nt)) break;
    const int m0 = mt * 256, n0 = nt * 256;
    Acc acc;
    acc_zero(acc);
    RowLoader al{PHG + 1024, 2560}, bl{WoutT, 1024};
    gemm_mainloop(acc, al, bl, m0, n0, 0, 1024, smem);
    const float* gt = mod + (size_t)(bg0 + m0 / L) * DIN + 2048;
    acc_foreach(acc, m0, n0, [&](int m, int n, float& v) {
      X1[(size_t)m * D + n] = X[(size_t)m * D + n] + gt[n] * v;
    });
  }
}

DEV void phase_ff1(const Params& p, int g, char* smem) {
  const u16* H2 = (const u16*)(p.ws + OFF_H2);
  const u16* W = (const u16*)(p.ws + OFF_WFF1);
  u16* AB = (u16*)(p.ws + OFF_ABUF);
  GemmPipe gp;
  gp.primed = false;
  for (int iter = 0;; ++iter) {
    int mt, nt, mtn, ntn;
    if (!tile_map(iter, 128, 16, mt, nt)) break;
    const bool more = tile_map(iter + 1, 128, 16, mtn, ntn);
    if (!more) { mtn = mt; ntn = nt; }
    const int m0 = mt * 256, n0 = nt * 256;
    Acc acc;
    acc_zero(acc);
    RowLoader al{H2, 1024}, bl{W, 1024};
    gemm_mainloop_p(acc, al, bl, m0, n0, mtn * 256, ntn * 256, 1024, smem, gp);
    gp.primed = more;
    acc_foreach(acc, m0, n0, [&](int m, int n, float& v) {
      const float r = fmaxf(v, 0.f);
      AB[(size_t)m * 4096 + n] = f2bf(r * r);
    });
  }
}

DEV void phase_ff2(const Params& p, int g, char* smem) {
  const int L = g ? 8192 : 4096;
  const int bg0 = g ? 8 : 0;
  const u16* AB = (const u16*)(p.ws + OFF_ABUF);
  const u16* W = (const u16*)(p.ws + OFF_WFF2);
  const float* mod = (const float*)(p.ws + OFF_MOD);
  float* X1 = p.out + (size_t)g * NTOK * D;
  for (int iter = 0;; ++iter) {
    int mt, nt;
    if (!tile_map(iter, 128, 4, mt, nt)) break;
    const int m0 = mt * 256, n0 = nt * 256;
    Acc acc;
    acc_zero(acc);
    RowLoader al{AB, 4096}, bl{W, 4096};
    gemm_mainloop(acc, al, bl, m0, n0, 0, 4096, smem);
    const float* gt = mod + (size_t)(bg0 + m0 / L) * DIN + 5120;
    acc_foreach(acc, m0, n0, [&](int m, int n, float& v) { X1[(size_t)m * D + n] += gt[n] * v; });
  }
}

__global__ void __launch_bounds__(512) mk(Params p) {
  cg::grid_group grid = cg::this_grid();
  __shared__ __attribute__((aligned(16))) char smem[SMEM_BYTES];
  __shared__ uint4 xb_words;
  if (threadIdx.x == 0) xb_words = make_uint4(0u, 0u, 0u, 0u);
  __syncthreads();
  const XcdBarrier xb = xcd_barrier_post((unsigned*)(p.ws + OFF_XBAR), (volatile LAS unsigned*)&xb_words);
  char* hsm = smem + vhalf() * HALF_BYTES;
  const float* mod = (const float*)(p.ws + OFF_MOD);
  phase_prep(p, hsm);
  phase_filter_mlp(p, hsm);
  xcd_barrier(xb);
  if (p.out == nullptr) grid.sync();
  phase_filter_norm(p, hsm);
  phase_norm_adaln(p.in[I_XP], p.in[I_N1G], mod, 0, 4096, 0, 1024, (u16*)p.out);
  xcd_barrier(xb);
#pragma unroll 1
  for (int gi = 0; gi < 2; ++gi) {
    int g = gi;
    asm volatile("" : "+s"(g));
    const int L = g ? 8192 : 4096;
    const int bg0 = g ? 8 : 0;
    float* OG = p.out + (size_t)g * NTOK * D;
    phase_p1(p, g, smem);
    xcd_barrier(xb);
    phase_p15(p, g);
    xcd_barrier(xb);
    phase_p2_naive(p, g, hsm);
    xcd_barrier(xb);
    phase_p2c(p, g);
    xcd_barrier(xb);
    phase_p3a(p, g, smem);
    xcd_barrier(xb);
    phase_p3b(p, g, smem);
    xcd_barrier(xb);
    phase_norm_adaln(OG, p.in[I_N2G], mod, bg0, L, 3072, 4096, (u16*)(p.ws + OFF_H2));
    xcd_barrier(xb);
    phase_ff1(p, g, smem);
    xcd_barrier(xb);
    phase_ff2(p, g, smem);
    xcd_barrier(xb);
  }
  phase_final_norm(p.out + (size_t)NTOK * D, p.in[I_FING]);
}

extern "C" void kernel_launch(void* const* d_in, const int* in_sizes, int n_in, void* d_out, int out_size,
                              void* d_ws, size_t ws_size, hipStream_t stream) {
  static int grid_blocks = 0;
  if (!grid_blocks) {
    int dev = 0, cus = 0, per_cu = 0;
    (void)hipGetDevice(&dev);
    (void)hipDeviceGetAttribute(&cus, hipDeviceAttributeMultiprocessorCount, dev);
    (void)hipOccupancyMaxActiveBlocksPerMultiprocessor(&per_cu, mk, 512, 0);
    if (per_cu > 1) per_cu = 1;
    if (per_cu < 1) per_cu = 1;
    grid_blocks = cus * per_cu;
  }
  if (ws_size < WS_NEED) fprintf(stderr, "workspace too small: %zu < %zu\n", ws_size, (size_t)WS_NEED);
  Params p{};
  for (int i = 0; i < 27; ++i) p.in[i] = (const float*)d_in[i];
  p.out = (float*)d_out;
  p.ws = (char*)d_ws;
  (void)hipMemsetAsync((char*)d_ws + OFF_XBAR, 0, 16384, stream);
  void* args[] = {&p};
  hipError_t e = hipLaunchCooperativeKernel((void*)mk, dim3(grid_blocks), dim3(512), args, 0, stream);
  if (e != hipSuccess) fprintf(stderr, "coop launch failed: %s (grid %d)\n", hipGetErrorString(e), grid_blocks);
}
```

```cpp
#include <hip/hip_runtime.h>
#include <hip/hip_cooperative_groups.h>
#include <cstdio>
namespace cg = cooperative_groups;

typedef unsigned short u16;
typedef __attribute__((ext_vector_type(8))) short bf16x8;
typedef __attribute__((ext_vector_type(16))) float f32x16;

#define DEV __device__ __forceinline__

constexpr int D = 1024;
constexpr int NTOK = 32768;
constexpr int DIN = 6144;
constexpr float EPSF = 1e-6f;

enum { I_XP = 0, I_XS, I_CP, I_CS, I_ADAW, I_ADAB, I_N1G, I_WIN, I_CONVW, I_CONVB, I_FW1, I_FB1, I_FW2, I_FB2,
       I_FW3, I_FB3, I_FWO, I_FFREQ, I_FBIAS, I_LB, I_GNG, I_WBR, I_WOUT, I_N2G, I_WFF1, I_WFF2, I_FING };

constexpr size_t OFF_WIN = 0;
constexpr size_t OFF_WBR = OFF_WIN + (size_t)6144 * 1024 * 2;
constexpr size_t OFF_WOUT = OFF_WBR + (size_t)1024 * 1024 * 2;
constexpr size_t OFF_WFF1 = OFF_WOUT + (size_t)1024 * 1024 * 2;
constexpr size_t OFF_WFF2 = OFF_WFF1 + (size_t)4096 * 1024 * 2;
constexpr size_t OFF_MOD = OFF_WFF2 + (size_t)4096 * 1024 * 2;
constexpr size_t OFF_CNT = OFF_MOD + (size_t)12 * 6144 * 4;
constexpr size_t OFF_XBAR = OFF_CNT + 256;
constexpr size_t OFF_PART = OFF_XBAR + 16384;
constexpr size_t OFF_KK = OFF_PART + (size_t)768 * 1024 * 4;
constexpr size_t OFF_DEC = OFF_KK + (size_t)512 * (8192 + 16384) * 2;
constexpr size_t OFF_KT = OFF_DEC + (size_t)2 * 512 * 512 * 4;
constexpr size_t OFF_P = OFF_KT + (size_t)512 * 2 * 512 * 64 * 2;
constexpr size_t OFF_UHY = OFF_P;
constexpr size_t OFF_PHG = OFF_UHY + (size_t)NTOK * 1536 * 2;
constexpr size_t OFF_GT = OFF_PHG + (size_t)NTOK * 2560 * 2;
constexpr size_t WS_NEED = OFF_GT + (size_t)NTOK * 2048 * 2;
constexpr size_t OFF_HRAW = OFF_P;
constexpr size_t OFF_ABUF = OFF_UHY;
constexpr size_t OFF_H2 = OFF_GT;

struct Params {
  const float* in[27];
  float* out;
  char* ws;
};

DEV unsigned pack2(float a, float b) {
  unsigned r;
  asm("s_nop 0\n\tv_cvt_pk_bf16_f32 %0, %1, %2" : "=v"(r) : "v"(a), "v"(b));
  return r;
}
DEV u16 f2bf(float f) { return (u16)(pack2(f, f) & 0xffffu); }
DEV float bf2f(u16 h) { return __uint_as_float(((unsigned)h) << 16); }
DEV float bflo(unsigned w) { return __uint_as_float(w << 16); }
DEV float bfhi(unsigned w) { return __uint_as_float(w & 0xffff0000u); }
DEV float silu_f(float x) { return x / (1.f + __expf(-x)); }
DEV float sigmoid_f(float x) { return __builtin_amdgcn_rcpf(1.f + __expf(-x)); }
DEV int tidx_full() {
  int t = threadIdx.x;
  asm volatile("" : "+v"(t));
  return t;
}
DEV int tidx() { return tidx_full() & 255; }
DEV int vhalf() { return __builtin_amdgcn_readfirstlane((int)(threadIdx.x >> 8)); }
#define VBID ((int)blockIdx.x * 2 + vhalf())
#define NVB ((int)gridDim.x * 2)
DEV float wave_sum(float v) {
#pragma unroll
  for (int o = 32; o > 0; o >>= 1) v += __shfl_xor(v, o);
  return v;
}

#define XB_TMO      128
#define XB_XCNT(j)  (256  + 64 * (j))
#define XB_XSUB(j)  (1280 + 64 * (j))
#define XB_XGEN(j)  (2304 + 64 * (j))
#define XB_TOP      3328
#define XB_TOPGEN   3392
#define XCD_BAR_WORDS 3456
#define XB_SPIN_CAP (1u << 18)
#define LAS __attribute__((address_space(3)))

__device__ __forceinline__ unsigned xb_ld(unsigned* p)              { return __hip_atomic_load(p, __ATOMIC_RELAXED, __HIP_MEMORY_SCOPE_AGENT); }
__device__ __forceinline__ unsigned xb_add(unsigned* p, unsigned v) { return __hip_atomic_fetch_add(p, v, __ATOMIC_RELAXED, __HIP_MEMORY_SCOPE_AGENT); }
__device__ __forceinline__ unsigned xb_xcc_id() { return (unsigned)__builtin_amdgcn_s_getreg((3 << 11) | 20) & 0xFu; }
#define XB_SPIN(cond, bar) do { unsigned _sp = 0; while (cond) { __builtin_amdgcn_s_sleep(1); \
    if ((++_sp & 255u) == 0u) { if (xb_ld(&(bar)[XB_TMO])) break; if (_sp > XB_SPIN_CAP) { atomicAdd(&(bar)[XB_TMO], 1u); break; } } } } while (0)

struct XcdBarrier {
    unsigned* bar; unsigned x;
    volatile LAS unsigned* st;
};

__device__ __forceinline__ XcdBarrier xcd_barrier_post(unsigned* bar, volatile LAS unsigned* st) {
    XcdBarrier b; b.bar = bar; b.x = xb_xcc_id(); b.st = st;
    if (threadIdx.x == 0) (void)xb_add(&bar[XB_XCNT(b.x)], 1u);
    return b;
}
__device__ __forceinline__ void xcd_barrier_complete(unsigned* bar, unsigned x, unsigned& nloc, unsigned& nx) {
    const unsigned G = gridDim.x * gridDim.y * gridDim.z;
    unsigned sum, cnt, mine, sp = 0u;
    for (;;) {
        sum = 0u; cnt = 0u; mine = 0u;
#pragma unroll
        for (unsigned j = 0; j < 16; ++j) { const unsigned c = xb_ld(&bar[XB_XCNT(j)]); sum += c; cnt += (c > 0u) ? 1u : 0u; mine = (j == x) ? c : mine; }
        if (sum == G) break;
        __builtin_amdgcn_s_sleep(1);
        if ((++sp & 255u) == 0u) { if (xb_ld(&bar[XB_TMO])) break; if (sp > XB_SPIN_CAP) { atomicAdd(&bar[XB_TMO], 1u); break; } }
    }
    nloc = mine > 0u ? mine : 1u; nx = cnt > 0u ? cnt : 1u;
}

__device__ __forceinline__ void xcd_barrier(const XcdBarrier& b) {
    asm volatile("s_waitcnt vmcnt(0)" ::: "memory");
    __syncthreads();
    if (threadIdx.x == 0) {
        unsigned* bar = b.bar;
        __builtin_amdgcn_s_waitcnt(0);
        unsigned nloc = b.st[0], nx = b.st[1];
        if (nloc == 0u) { xcd_barrier_complete(bar, b.x, nloc, nx); b.st[0] = nloc; b.st[1] = nx; }
        const unsigned old = xb_add(&bar[XB_XSUB(b.x)], 1u);
        const unsigned gen = old / nloc;
        if (old + 1u == (gen + 1u) * nloc) {
            __builtin_amdgcn_fence(__ATOMIC_RELEASE, "agent");
            asm volatile("s_waitcnt vmcnt(0)" ::: "memory");
            const unsigned og = xb_add(&bar[XB_TOP], 1u);
            const unsigned tg = og / nx;
            if (og + 1u == (tg + 1u) * nx) xb_add(&bar[XB_TOPGEN], 1u);
            else XB_SPIN(xb_ld(&bar[XB_TOPGEN]) == tg, bar);
            __builtin_amdgcn_fence(__ATOMIC_ACQUIRE, "agent");
            xb_add(&bar[XB_XGEN(b.x)], 1u);
            asm volatile("s_waitcnt vmcnt(0)" ::: "memory");
        } else {
            XB_SPIN(xb_ld(&bar[XB_XGEN(b.x)]) == gen, bar);
            __builtin_amdgcn_fence(__ATOMIC_ACQUIRE, "agent");
            asm volatile("s_waitcnt vmcnt(0)" ::: "memory");
        }
    }
    __syncthreads();
}


constexpr int BK = 64;
constexpr int LDSROW = 144;
constexpr int TILE_BYTES = 256 * LDSROW;
constexpr int HALF_BYTES = 76800;
constexpr int SMEM_BYTES = 2 * HALF_BYTES;

struct R4 { uint4 a, b, c, d; };

struct RowLoader {
  const u16* base;
  long ld;
  DEV R4 load(int tid, int r0, int k0) const {
    const int tr = tid >> 3, tc = tid & 7;
    const u16* p = base + (long)(r0 + tr) * ld + k0 + tc * 8;
    R4 r;
    r.a = *(const uint4*)(p);
    r.b = *(const uint4*)(p + 64 * ld);
    r.c = *(const uint4*)(p + 128 * ld);
    r.d = *(const uint4*)(p + 192 * ld);
    return r;
  }
  DEV void store(int tid, char* lds, const R4& r) const {
    const int tr = tid >> 3, tc = tid & 7;
    char* q = lds + tr * LDSROW + tc * 16;
    *(uint4*)(q) = r.a;
    *(uint4*)(q + 64 * LDSROW) = r.b;
    *(uint4*)(q + 128 * LDSROW) = r.c;
    *(uint4*)(q + 192 * LDSROW) = r.d;
  }
};

DEV void st8t(char* q, const uint4& v) {
  *(u16*)(q + 0 * LDSROW) = (u16)(v.x & 0xffff);
  *(u16*)(q + 1 * LDSROW) = (u16)(v.x >> 16);
  *(u16*)(q + 2 * LDSROW) = (u16)(v.y & 0xffff);
  *(u16*)(q + 3 * LDSROW) = (u16)(v.y >> 16);
  *(u16*)(q + 4 * LDSROW) = (u16)(v.z & 0xffff);
  *(u16*)(q + 5 * LDSROW) = (u16)(v.z >> 16);
  *(u16*)(q + 6 * LDSROW) = (u16)(v.w & 0xffff);
  *(u16*)(q + 7 * LDSROW) = (u16)(v.w >> 16);
}

struct TransLoader {
  const u16* U;
  int L;
  DEV R4 load(int tid, int m0, int k0) const {
    const int b = m0 / L, t0 = m0 - b * L;
    const int k = k0 + (tid & 63), tg = tid >> 6;
    const u16* p = U + ((long)(b * 1536 + 1024 + k)) * L + t0 + tg * 8;
    R4 r;
    r.a = *(const uint4*)(p);
    r.b = *(const uint4*)(p + 64);
    r.c = *(const uint4*)(p + 128);
    r.d = *(const uint4*)(p + 192);
    return r;
  }
  DEV void store(int tid, char* lds, const R4& r) const {
    const int kl = tid & 63, tg = tid >> 6;
    char* q = lds + (tg * 8) * LDSROW + kl * 2;
    st8t(q, r.a);
    st8t(q + 64 * LDSROW, r.b);
    st8t(q + 128 * LDSROW, r.c);
    st8t(q + 192 * LDSROW, r.d);
  }
};

typedef f32x16 Acc[4][2];

template <class AL, class BL>
DEV void gemm_ktile(Acc& acc, const char* A, const char* B, int wm, int wn, int lr, int lh, const AL& al, const BL& bl,
                    int tid, int m0, int n0, int knext, char* nxt, R4& ra, R4& rb) {
  bf16x8 a[2][4], b[2][2];
  const char* pa = A + (wm + lr) * LDSROW + lh * 16;
  const char* pb = B + (wn + lr) * LDSROW + lh * 16;
#pragma unroll
  for (int i = 0; i < 4; ++i) a[0][i] = *(const bf16x8*)(pa + 32 * i * LDSROW);
#pragma unroll
  for (int j = 0; j < 2; ++j) b[0][j] = *(const bf16x8*)(pb + 32 * j * LDSROW);
#pragma unroll
  for (int ks = 0; ks < 4; ++ks) {
    const int cur = ks & 1, nx = cur ^ 1;
    if (ks < 3) {
#pragma unroll
      for (int i = 0; i < 4; ++i) a[nx][i] = *(const bf16x8*)(pa + 32 * i * LDSROW + (ks + 1) * 32);
#pragma unroll
      for (int j = 0; j < 2; ++j) b[nx][j] = *(const bf16x8*)(pb + 32 * j * LDSROW + (ks + 1) * 32);
    }
    __builtin_amdgcn_sched_barrier(0);
#pragma unroll
    for (int i = 0; i < 4; ++i)
#pragma unroll
      for (int j = 0; j < 2; ++j)
        acc[i][j] = __builtin_amdgcn_mfma_f32_32x32x16_bf16(a[cur][i], b[cur][j], acc[i][j], 0, 0, 0);
    __builtin_amdgcn_sched_barrier(0);
    if (ks == 1) {
      al.store(tid, nxt, ra);
      bl.store(tid, nxt + TILE_BYTES, rb);
      __builtin_amdgcn_sched_barrier(0);
      ra = al.load(tid, m0, knext);
      rb = bl.load(tid, n0, knext);
      __builtin_amdgcn_sched_barrier(0);
    }
  }
}

template <class AL, class BL>
DEV void gemm_mainloop(Acc& acc, const AL& al, const BL& bl, int m0, int n0, int kbeg, int kend, char* lds) {
  const int tid = tidx_full();
  const int wave = tid >> 6, lane = tid & 63;
  const int wm = (wave >> 2) * 128, wn = (wave & 3) * 64;
  const int lr = lane & 31, lh = lane >> 5;
  const int nk = (kend - kbeg) / BK;
  R4 a0 = al.load(tid, m0, kbeg);
  R4 b0 = bl.load(tid, n0, kbeg);
  __syncthreads();
  al.store(tid, lds, a0);
  bl.store(tid, lds + TILE_BYTES, b0);
  a0 = al.load(tid, m0, kbeg + BK);
  b0 = bl.load(tid, n0, kbeg + BK);
  __syncthreads();
  for (int kt = 0; kt < nk; ++kt) {
    const char* cur = lds + (kt & 1) * 2 * TILE_BYTES;
    char* nxt = lds + ((kt + 1) & 1) * 2 * TILE_BYTES;
    const int t2 = (kt + 2 < nk) ? kt + 2 : nk - 1;
    __builtin_amdgcn_sched_barrier(0);
    gemm_ktile(acc, cur, cur + TILE_BYTES, wm, wn, lr, lh, al, bl, tid, m0, n0, kbeg + t2 * BK, nxt, a0, b0);
    __builtin_amdgcn_sched_barrier(0);
    __syncthreads();
  }
}

struct GemmPipe {
  R4 ra, rb;
  bool primed;
};
template <class AL, class BL>
DEV void gemm_mainloop_p(Acc& acc, const AL& al, const BL& bl, int m0, int n0, int m0n, int n0n, int K, char* lds,
                         GemmPipe& gp) {
  const int tid = tidx_full();
  const int wave = tid >> 6, lane = tid & 63;
  const int wm = (wave >> 2) * 128, wn = (wave & 3) * 64;
  const int lr = lane & 31, lh = lane >> 5;
  const int nk = K / BK;
  if (!gp.primed) {
    gp.ra = al.load(tid, m0, 0);
    gp.rb = bl.load(tid, n0, 0);
    __syncthreads();
    al.store(tid, lds, gp.ra);
    bl.store(tid, lds + TILE_BYTES, gp.rb);
    gp.ra = al.load(tid, m0, BK);
    gp.rb = bl.load(tid, n0, BK);
    __syncthreads();
  }
  for (int kt = 0; kt < nk; ++kt) {
    const char* cur = lds + (kt & 1) * 2 * TILE_BYTES;
    char* nxt = lds + ((kt + 1) & 1) * 2 * TILE_BYTES;
    const bool wrap = (kt + 2 >= nk);
    const int kk = (wrap ? kt + 2 - nk : kt + 2) * BK;
    const int mr = wrap ? m0n : m0, nr = wrap ? n0n : n0;
    __builtin_amdgcn_sched_barrier(0);
    gemm_ktile(acc, cur, cur + TILE_BYTES, wm, wn, lr, lh, al, bl, tid, mr, nr, kk, nxt, gp.ra, gp.rb);
    __builtin_amdgcn_sched_barrier(0);
    __syncthreads();
  }
}

DEV void acc_zero(Acc& acc) {
#pragma unroll
  for (int i = 0; i < 4; ++i)
#pragma unroll
    for (int j = 0; j < 2; ++j)
#pragma unroll
      for (int r = 0; r < 16; ++r) acc[i][j][r] = 0.f;
}

template <class F>
DEV void acc_foreach(Acc& acc, int m0, int n0, F f) {
  asm volatile("s_nop 7\n\ts_nop 7\n\ts_nop 3" ::: "memory");
  const int tid = tidx_full();
  const int wave = tid >> 6, lane = tid & 63;
  const int wm = (wave >> 2) * 128, wn = (wave & 3) * 64;
  const int lr = lane & 31, lh = lane >> 5;
#pragma unroll
  for (int i = 0; i < 4; ++i)
#pragma unroll
    for (int j = 0; j < 2; ++j)
#pragma unroll
      for (int r = 0; r < 16; ++r) {
        const int m = m0 + wm + 32 * i + (r & 3) + 8 * (r >> 2) + 4 * lh;
        const int n = n0 + wn + 32 * j + lr;
        float v = acc[i][j][r];
        f(m, n, v);
        acc[i][j][r] = v;
      }
}

DEV bool tile_map(int iter, int ntm, int ntn, int& mt, int& nt) {
  int PM = 0, PN = 0;
  if (ntn == 18) { PM = 16; PN = 2; }
  else if (ntn == 128) { PM = 2; PN = 16; }
  else if (ntn == 16 || ntn == 4) { PM = 8; PN = 4; }
  if (gridDim.x == 256 && PM > 0 && (ntm % PM) == 0) {
    const int xcd = blockIdx.x & 7, slot = blockIdx.x >> 3;
    const int nsn = ntn / PN, nsuper = (ntm / PM) * nsn;
    const int s_ = iter * 8 + xcd;
    if (s_ >= nsuper) return false;
    const int sm = s_ / nsn, sn = s_ - sm * nsn;
    mt = sm * PM + slot / PN;
    nt = sn * PN + slot % PN;
    return true;
  }
  const int tile = blockIdx.x + iter * gridDim.x;
  if (tile >= ntm * ntn) return false;
  mt = tile / ntn;
  nt = tile - mt * ntn;
  return true;
}

DEV void prep_transpose_tile(const float* __restrict__ W, int K, int N, u16* __restrict__ WT, int tile, char* smem) {
  u16(*T)[66] = (u16(*)[66])smem;
  const int ntn = N / 64;
  const int k0 = (tile / ntn) * 64, n0 = (tile % ntn) * 64;
  const int tid = tidx();
  const int kr = tid >> 4, nc = (tid & 15) * 4;
  __syncthreads();
#pragma unroll
  for (int i = 0; i < 4; ++i) {
    const int k = kr + 16 * i;
    const float4 v = *(const float4*)(W + (long)(k0 + k) * N + n0 + nc);
    T[nc + 0][k] = f2bf(v.x);
    T[nc + 1][k] = f2bf(v.y);
    T[nc + 2][k] = f2bf(v.z);
    T[nc + 3][k] = f2bf(v.w);
  }
  __syncthreads();
  const int n = tid >> 2, kc = (tid & 3) * 16;
  unsigned o[8];
#pragma unroll
  for (int i = 0; i < 8; ++i) o[i] = (unsigned)T[n][kc + 2 * i] | ((unsigned)T[n][kc + 2 * i + 1] << 16);
  uint4* dst = (uint4*)(WT + (long)(n0 + n) * K + k0 + kc);
  dst[0] = make_uint4(o[0], o[1], o[2], o[3]);
  dst[1] = make_uint4(o[4], o[5], o[6], o[7]);
}

DEV void prep_mod_item(const Params& p, int item, char* smem) {
  float* sc = (float*)smem;
  float* red = (float*)(smem + 12 * 1024 * 4);
  __syncthreads();
  const int tid = tidx();
  for (int e = tid; e < 12 * 1024; e += 256) {
    const int b = e >> 10, k = e & 1023;
    const float c = (b < 8) ? p.in[I_CP][b * 1024 + k] : p.in[I_CS][(b - 8) * 1024 + k];
    sc[e] = silu_f(c);
  }
  __syncthreads();
  const int col = tid & 31, kg = tid >> 5;
  const int j = item * 32 + col;
  float acc[12];
#pragma unroll
  for (int b = 0; b < 12; ++b) acc[b] = 0.f;
  const float* W = p.in[I_ADAW];
#pragma unroll 8
  for (int kk = 0; kk < 128; ++kk) {
    const int k = kg * 128 + kk;
    const float w = W[(long)k * DIN + j];
#pragma unroll
    for (int b = 0; b < 12; ++b) acc[b] += sc[b * 1024 + k] * w;
  }
#pragma unroll
  for (int b = 0; b < 12; ++b) red[(kg * 12 + b) * 32 + col] = acc[b];
  __syncthreads();
  for (int e = tid; e < 12 * 32; e += 256) {
    const int b = e >> 5, c = e & 31;
    float s = p.in[I_ADAB][item * 32 + c];
#pragma unroll
    for (int g = 0; g < 8; ++g) s += red[(g * 12 + b) * 32 + c];
    ((float*)(p.ws + OFF_MOD))[b * DIN + item * 32 + c] = s;
  }
}

DEV void phase_prep(const Params& p, char* smem) {
  if (blockIdx.x == 0 && threadIdx.x < 64) ((unsigned*)(p.ws + OFF_CNT))[threadIdx.x] = 0u;
  for (int it = VBID; it < 4096 + 192; it += NVB) {
    if (it < 1536) prep_transpose_tile(p.in[I_WIN], 1024, 6144, (u16*)(p.ws + OFF_WIN), it, smem);
    else if (it < 1792) prep_transpose_tile(p.in[I_WBR], 1024, 1024, (u16*)(p.ws + OFF_WBR), it - 1536, smem);
    else if (it < 2048) prep_transpose_tile(p.in[I_WOUT], 1024, 1024, (u16*)(p.ws + OFF_WOUT), it - 1792, smem);
    else if (it < 3072) prep_transpose_tile(p.in[I_WFF1], 1024, 4096, (u16*)(p.ws + OFF_WFF1), it - 2048, smem);
    else if (it < 4096) prep_transpose_tile(p.in[I_WFF2], 4096, 1024, (u16*)(p.ws + OFF_WFF2), it - 3072, smem);
    else prep_mod_item(p, it - 4096, smem);
  }
}

DEV void phase_filter_mlp(const Params& p, char* smem) {
  float* z = (float*)smem;
  float* h1 = z + 4 * 36;
  float* h2 = h1 + 256;
  float* h3 = h2 + 256;
  const float* w1 = p.in[I_FW1];
  const float* b1 = p.in[I_FB1];
  const float* w2 = p.in[I_FW2];
  const float* b2 = p.in[I_FB2];
  const float* w3 = p.in[I_FW3];
  const float* b3 = p.in[I_FB3];
  const float* wo = p.in[I_FWO];
  const float* fr = p.in[I_FFREQ];
  float* hraw = (float*)(p.ws + OFF_HRAW);
  float* part = (float*)(p.ws + OFF_PART);
  const int tid = tidx();
  for (int it = VBID; it < 768; it += NVB) {
    const int g = (it < 256) ? 0 : 1;
    const int L = g ? 8192 : 4096;
    const int tbase = (g ? (it - 256) : it) * 16;
    const long rowbase = g ? 4096 : 0;
    float psum[4] = {0.f, 0.f, 0.f, 0.f};
    for (int rnd = 0; rnd < 4; ++rnd) {
      const int t0 = tbase + rnd * 4;
      __syncthreads();
      if (tid < 4 * 33) {
        const int pp = tid / 33, f = tid % 33;
        const int t = t0 + pp;
        float val;
        if (f == 0) val = (float)t / (float)(L - 1);
        else {
          const int j = (f - 1) & 15;
          const float fb = 1e-4f + (float)j * ((15.0f - 1e-4f) / 15.0f);
          const float w = 6.283185307179586f * (float)t / (float)L;
          val = (f <= 16) ? cosf(fb * w) : -sinf(fb * w);
        }
        z[pp * 36 + f] = val;
      }
      __syncthreads();
      const int pp = tid >> 6, u = tid & 63;
      {
        float s = b1[u];
        for (int k = 0; k < 33; ++k) s += z[pp * 36 + k] * w1[k * 64 + u];
        h1[pp * 64 + u] = sinf(fr[u] * s);
      }
      __syncthreads();
      {
        float s = b2[u];
        for (int k = 0; k < 64; ++k) s += h1[pp * 64 + k] * w2[k * 64 + u];
        h2[pp * 64 + u] = sinf(fr[64 + u] * s);
      }
      __syncthreads();
      {
        float s = b3[u];
        for (int k = 0; k < 64; ++k) s += h2[pp * 64 + k] * w3[k * 64 + u];
        h3[pp * 64 + u] = sinf(fr[128 + u] * s);
      }
      __syncthreads();
      float acc[4][4];
#pragma unroll
      for (int a = 0; a < 4; ++a)
#pragma unroll
        for (int q = 0; q < 4; ++q) acc[a][q] = 0.f;
      for (int k = 0; k < 64; ++k) {
        float wv[4];
#pragma unroll
        for (int q = 0; q < 4; ++q) wv[q] = wo[k * 1024 + tid + 256 * q];
#pragma unroll
        for (int a = 0; a < 4; ++a) {
          const float hv = h3[a * 64 + k];
#pragma unroll
          for (int q = 0; q < 4; ++q) acc[a][q] += hv * wv[q];
        }
      }
#pragma unroll
      for (int q = 0; q < 4; ++q) {
        const int c = tid + 256 * q;
        const int ch = c & 511;
        const float mind = -3.0701134573253943f, maxd = -15.350567286626972f;
        const float delta = fabsf(mind + (float)ch * ((maxd - mind) / 511.0f));
#pragma unroll
        for (int a = 0; a < 4; ++a) {
          const int t = t0 + a;
          const float tt = (float)t / (float)(L - 1);
          const float val = acc[a][q] * __expf(-tt * delta);
          hraw[(rowbase + t) * 1024 + c] = val;
          if (!(c >= 512 && t == 0)) psum[q] += fabsf(val);
        }
      }
    }
#pragma unroll
    for (int q = 0; q < 4; ++q) part[(long)it * 1024 + tid + 256 * q] = psum[q];
  }
}

DEV void phase_filter_norm(const Params& p, char* smem) {
  float* Tf = (float*)smem;
  float* Tb = Tf + 64 * 65;
  float* red = Tb + 64 * 65;
  float* nrm = red + 256;
  const float* hraw = (const float*)(p.ws + OFF_HRAW);
  const float* part = (const float*)(p.ws + OFF_PART);
  const int tid = tidx();
  for (int it = VBID; it < 512 + 1024; it += NVB) {
    const int g = (it < 512) ? 0 : 1;
    const int L = g ? 8192 : 4096;
    const int li = g ? it - 512 : it;
    const int ntt = L / 64;
    const int ct = li / ntt, tt = li % ntt;
    const long rowbase = g ? 4096 : 0;
    const int prow0 = g ? 256 : 0, nprow = g ? 512 : 256;
    u16* KK = (u16*)(p.ws + OFF_KK) + (g ? (size_t)512 * 8192 : 0);
    __syncthreads();
    {
      const int c = tid & 63, ph = tid >> 6;
      float s = 0.f;
#pragma unroll 8
      for (int r = ph; r < nprow; r += 4) {
        s += part[(long)(prow0 + r) * 1024 + ct * 64 + c];
        s += part[(long)(prow0 + r) * 1024 + 512 + ct * 64 + c];
      }
      red[ph * 64 + c] = s;
#pragma unroll
      for (int i = 0; i < 16; ++i) {
        const int r = ph + 4 * i;
        const long row = rowbase + tt * 64 + r;
        Tf[c * 65 + r] = hraw[row * 1024 + ct * 64 + c];
        Tb[c * 65 + r] = hraw[row * 1024 + 512 + ct * 64 + c];
      }
    }
    __syncthreads();
    if (tid < 64) nrm[tid] = red[tid] + red[64 + tid] + red[128 + tid] + red[192 + tid] + EPSF;
    __syncthreads();
    {
      const int c = tid >> 2, rq = (tid & 3) * 16;
      const float inv = 1.f / nrm[c];
      u16* row = KK + (size_t)(ct * 64 + c) * (2 * L);
#pragma unroll
      for (int i = 0; i < 16; ++i) {
        const int r = rq + i;
        const int t = tt * 64 + r;
        row[L - t] = f2bf(Tf[c * 65 + r] * inv);
        if (t >= 1) row[L + t] = f2bf(Tb[c * 65 + r] * inv);
      }
      if (tt == 0 && (tid & 3) == 0) row[0] = 0;
    }
  }
}

DEV void phase_norm_adaln(const float* __restrict__ X, const float* __restrict__ gvec, const float* __restrict__ mod,
                          int bg0, int L, int sh_off, int sc_off, u16* __restrict__ H) {
  const int tid = tidx();
  const int wave = tid >> 6, lane = tid & 63;
  constexpr int RB = 4;
  const int stride = NVB * 4;
  for (int row0 = VBID * 4 + wave; row0 < NTOK; row0 += stride * RB) {
    float4 v[RB][4];
    float ss[RB];
#pragma unroll
    for (int j = 0; j < RB; ++j) {
      const int row = row0 + j * stride;
      const float* x = X + (long)(row < NTOK ? row : row0) * D;
#pragma unroll
      for (int i = 0; i < 4; ++i) v[j][i] = *(const float4*)(x + lane * 4 + 256 * i);
    }
#pragma unroll
    for (int j = 0; j < RB; ++j) {
      float t = 0.f;
#pragma unroll
      for (int i = 0; i < 4; ++i) t += v[j][i].x * v[j][i].x + v[j][i].y * v[j][i].y + v[j][i].z * v[j][i].z + v[j][i].w * v[j][i].w;
      ss[j] = wave_sum(t);
    }
#pragma unroll
    for (int j = 0; j < RB; ++j) {
      const int row = row0 + j * stride;
      if (row < NTOK) {
        const float rstd = rsqrtf(ss[j] * (1.f / 1024.f) + EPSF);
        const float* mrow = mod + (long)(bg0 + row / L) * DIN;
#pragma unroll
        for (int i = 0; i < 4; ++i) {
          const int k = lane * 4 + 256 * i;
          const float4 g = *(const float4*)(gvec + k);
          const float4 sc = *(const float4*)(mrow + sc_off + k);
          const float4 sh = *(const float4*)(mrow + sh_off + k);
          const float o0 = v[j][i].x * rstd * g.x * (1.f + sc.x) + sh.x;
          const float o1 = v[j][i].y * rstd * g.y * (1.f + sc.y) + sh.y;
          const float o2 = v[j][i].z * rstd * g.z * (1.f + sc.z) + sh.z;
          const float o3 = v[j][i].w * rstd * g.w * (1.f + sc.w) + sh.w;
          *(uint2*)(H + (long)row * D + k) = make_uint2(pack2(o0, o1), pack2(o2, o3));
        }
      }
    }
  }
}

DEV void phase_final_norm(float* __restrict__ X, const float* __restrict__ gvec) {
  const int tid = tidx();
  const int wave = tid >> 6, lane = tid & 63;
  constexpr int RB = 4;
  const int stride = NVB * 4;
  for (int row0 = VBID * 4 + wave; row0 < NTOK; row0 += stride * RB) {
    float4 v[RB][4];
    float ss[RB];
#pragma unroll
    for (int j = 0; j < RB; ++j) {
      const int row = row0 + j * stride;
      const float* x = X + (long)(row < NTOK ? row : row0) * D;
#pragma unroll
      for (int i = 0; i < 4; ++i) v[j][i] = *(const float4*)(x + lane * 4 + 256 * i);
    }
#pragma unroll
    for (int j = 0; j < RB; ++j) {
      float t = 0.f;
#pragma unroll
      for (int i = 0; i < 4; ++i) t += v[j][i].x * v[j][i].x + v[j][i].y * v[j][i].y + v[j][i].z * v[j][i].z + v[j][i].w * v[j][i].w;
      ss[j] = wave_sum(t);
    }
#pragma unroll
    for (int j = 0; j < RB; ++j) {
      const int row = row0 + j * stride;
      if (row < NTOK) {
        const float rstd = rsqrtf(ss[j] * (1.f / 1024.f) + EPSF);
        float* x = X + (long)row * D;
#pragma unroll
        for (int i = 0; i < 4; ++i) {
          const int k = lane * 4 + 256 * i;
          const float4 g = *(const float4*)(gvec + k);
          *(float4*)(x + k) = make_float4(v[j][i].x * rstd * g.x, v[j][i].y * rstd * g.y, v[j][i].z * rstd * g.z, v[j][i].w * rstd * g.w);
        }
      }
    }
  }
}

DEV void norm_adaln_rows(const float* __restrict__ X, const float* __restrict__ gvec, const float* __restrict__ mod,
                         int bg0, int L, int sh_off, int sc_off, u16* __restrict__ H, int rbeg) {
  const int tid = tidx();
  const int wave = tid >> 6, lane = tid & 63;
  for (int jb = 0; jb < 16; jb += 4) {
    float4 v[4][4];
    float ss[4];
#pragma unroll
    for (int j = 0; j < 4; ++j) {
      const float* x = X + (long)(rbeg + wave + 4 * (jb + j)) * D;
#pragma unroll
      for (int i = 0; i < 4; ++i) v[j][i] = *(const float4*)(x + lane * 4 + 256 * i);
    }
#pragma unroll
    for (int j = 0; j < 4; ++j) {
      float t = 0.f;
#pragma unroll
      for (int i = 0; i < 4; ++i) t += v[j][i].x * v[j][i].x + v[j][i].y * v[j][i].y + v[j][i].z * v[j][i].z + v[j][i].w * v[j][i].w;
      ss[j] = wave_sum(t);
    }
#pragma unroll
    for (int j = 0; j < 4; ++j) {
      const int row = rbeg + wave + 4 * (jb + j);
      const float rstd = rsqrtf(ss[j] * (1.f / 1024.f) + EPSF);
      const float* mrow = mod + (long)(bg0 + row / L) * DIN;
#pragma unroll
      for (int i = 0; i < 4; ++i) {
        const int k = lane * 4 + 256 * i;
        const float4 g = *(const float4*)(gvec + k);
        const float4 sc = *(const float4*)(mrow + sc_off + k);
        const float4 sh = *(const float4*)(mrow + sh_off + k);
        const float o0 = v[j][i].x * rstd * g.x * (1.f + sc.x) + sh.x;
        const float o1 = v[j][i].y * rstd * g.y * (1.f + sc.y) + sh.y;
        const float o2 = v[j][i].z * rstd * g.z * (1.f + sc.z) + sh.z;
        const float o3 = v[j][i].w * rstd * g.w * (1.f + sc.w) + sh.w;
        *(uint2*)(H + (long)row * D + k) = make_uint2(pack2(o0, o1), pack2(o2, o3));
      }
    }
  }
}

DEV void final_norm_rows(float* __restrict__ X, const float* __restrict__ gvec, int rbeg) {
  const int tid = tidx();
  const int wave = tid >> 6, lane = tid & 63;
  for (int jb = 0; jb < 16; jb += 4) {
    float4 v[4][4];
    float ss[4];
#pragma unroll
    for (int j = 0; j < 4; ++j) {
      const float* x = X + (long)(rbeg + wave + 4 * (jb + j)) * D;
#pragma unroll
      for (int i = 0; i < 4; ++i) v[j][i] = *(const float4*)(x + lane * 4 + 256 * i);
    }
#pragma unroll
    for (int j = 0; j < 4; ++j) {
      float t = 0.f;
#pragma unroll
      for (int i = 0; i < 4; ++i) t += v[j][i].x * v[j][i].x + v[j][i].y * v[j][i].y + v[j][i].z * v[j][i].z + v[j][i].w * v[j][i].w;
      ss[j] = wave_sum(t);
    }
#pragma unroll
    for (int j = 0; j < 4; ++j) {
      float* x = X + (long)(rbeg + wave + 4 * (jb + j)) * D;
      const float rstd = rsqrtf(ss[j] * (1.f / 1024.f) + EPSF);
#pragma unroll
      for (int i = 0; i < 4; ++i) {
        const int k = lane * 4 + 256 * i;
        const float4 g = *(const float4*)(gvec + k);
        *(float4*)(x + k) = make_float4(v[j][i].x * rstd * g.x, v[j][i].y * rstd * g.y, v[j][i].z * rstd * g.z, v[j][i].w * rstd * g.w);
      }
    }
  }
}

DEV void phase_p1(const Params& p, int g, char* smem) {
  const int L = g ? 8192 : 4096;
  const u16* H = (const u16*)(p.out + (size_t)g * NTOK * D);
  const u16* WinT = (const u16*)(p.ws + OFF_WIN);
  u16* PHG = (u16*)(p.ws + OFF_PHG);
  u16* GT = (u16*)(p.ws + OFF_GT);
  u16* UHY = (u16*)(p.ws + OFF_UHY);
  {
    GemmPipe gp;
    gp.primed = false;
    for (int iter = 0;; ++iter) {
      int mt, nt, mtn, ntn;
      if (!tile_map(iter, 128, 18, mt, nt)) break;
      const bool more = tile_map(iter + 1, 128, 18, mtn, ntn);
      if (!more) { mtn = mt; ntn = nt; }
      Acc acc;
      acc_zero(acc);
      const int m0 = mt * 256, n0 = nt * 256;
      RowLoader al{H, 1024}, bl{WinT + (size_t)1536 * 1024, 1024};
      gemm_mainloop_p(acc, al, bl, m0, n0, mtn * 256, ntn * 256, 1024, smem, gp);
      gp.primed = more;
      if (n0 < 2560) {
        const bool dosilu = (n0 < 512) || (n0 >= 2048);
        acc_foreach(acc, m0, n0, [&](int m, int n, float& v) {
          const float o = dosilu ? silu_f(v) : v;
          PHG[(size_t)m * 2560 + n] = f2bf(o);
        });
      } else {
        acc_foreach(acc, m0, n0, [&](int m, int n, float& v) { GT[(size_t)m * 2048 + (n - 2560)] = f2bf(sigmoid_f(v)); });
      }
    }
  }
  {
    GemmPipe gp;
    gp.primed = false;
    for (int iter = 0;; ++iter) {
      int cm, tn, cmn, tnn;
      if (!tile_map(iter, 6, 128, cm, tn)) break;
      const bool more = tile_map(iter + 1, 6, 128, cmn, tnn);
      if (!more) { cmn = cm; tnn = tn; }
      Acc acc;
      acc_zero(acc);
      const int m0 = cm * 256, n0 = tn * 256;
      RowLoader al{WinT, 1024}, bl{H, 1024};
      gemm_mainloop_p(acc, al, bl, m0, n0, cmn * 256, tnn * 256, 1024, smem, gp);
      gp.primed = more;
      const int b = n0 / L, tb = n0 - b * L;
      u16* dst = UHY + (size_t)b * 1536 * L + tb - n0;
      acc_foreach(acc, m0, n0, [&](int m, int n, float& v) { dst[(size_t)m * L + n] = f2bf(v); });
    }
  }
}

DEV void phase_p15(const Params& p, int g) {
  const u16* PHG = (const u16*)(p.ws + OFF_PHG);
  u16* QK = (u16*)(p.out + (size_t)g * NTOK * D);
  u16* KT = (u16*)(p.ws + OFF_KT);
  float* DEC = (float*)(p.ws + OFF_DEC);
  for (int it = VBID; it < 1024; it += NVB) {
    const int tid = tidx();
    const int cidx = it >> 1, dir = it & 1;
    u16* Qp = QK + (size_t)(2 * dir) * NTOK * 512;
    u16* Kp = Qp + (size_t)NTOK * 512;
    float lb[2], G[2];
#pragma unroll
    for (int cc = 0; cc < 2; ++cc) {
      const int c = tid + 256 * cc;
      const float a0 = p.in[I_LB][(0 * 2 + dir) * 512 + c];
      const float a1 = p.in[I_LB][(1 * 2 + dir) * 512 + c];
      lb[cc] = 1.f / (1.f + __expf(a1 - a0));
      G[cc] = 0.f;
    }
    u16 xr[3][2][8], qr[3][2][8];
#define P15_LOAD(st_, j8_)                                                          \
    _Pragma("unroll") for (int e = 0; e < 8; ++e) {                                 \
      const int jj = (j8_) * 8 + e;                                                 \
      const int j = dir ? 63 - jj : jj;                                             \
      const size_t tok = (size_t)cidx * 64 + j;                                     \
      _Pragma("unroll") for (int cc = 0; cc < 2; ++cc) {                            \
        xr[st_][cc][e] = PHG[tok * 2560 + 1024 + 512 * dir + tid + 256 * cc];       \
        qr[st_][cc][e] = PHG[tok * 2560 + tid + 256 * cc];                          \
      }                                                                             \
    }
    P15_LOAD(0, 0);
    P15_LOAD(1, 1);
#pragma unroll
    for (int j8 = 0; j8 < 8; ++j8) {
      const int st = j8 % 3;
      if (j8 < 6) { P15_LOAD((j8 + 2) % 3, j8 + 2); }
#pragma unroll
      for (int cc = 0; cc < 2; ++cc) {
        const int c = tid + 256 * cc;
        unsigned kb[8];
#pragma unroll
        for (int e = 0; e < 8; ++e) {
          const int jj = j8 * 8 + e;
          const int j = dir ? 63 - jj : jj;
          const size_t tok = (size_t)cidx * 64 + j;
          const float f = lb[cc] + (1.f - lb[cc]) * sigmoid_f(bf2f(xr[st][cc][e]));
          G[cc] += __logf(f);
          const float eg = __expf(G[cc]), ig = __expf(-G[cc]);
          Qp[tok * 512 + c] = f2bf(bf2f(qr[st][cc][e]) * eg);
          const u16 kk = f2bf((1.f - f) * ig);
          Kp[tok * 512 + c] = kk;
          kb[e] = kk;
        }
        const int s0 = dir ? 56 - 8 * j8 : 8 * j8;
        uint4 w;
        w.x = dir ? (kb[7] | (kb[6] << 16)) : (kb[0] | (kb[1] << 16));
        w.y = dir ? (kb[5] | (kb[4] << 16)) : (kb[2] | (kb[3] << 16));
        w.z = dir ? (kb[3] | (kb[2] << 16)) : (kb[4] | (kb[5] << 16));
        w.w = dir ? (kb[1] | (kb[0] << 16)) : (kb[6] | (kb[7] << 16));
        *(uint4*)(KT + (((size_t)cidx * 2 + dir) * 512 + c) * 64 + s0) = w;
      }
    }
#undef P15_LOAD
#pragma unroll
    for (int cc = 0; cc < 2; ++cc) DEC[((size_t)dir * 512 + cidx) * 512 + tid + 256 * cc] = __expf(G[cc]);
  }
}

DEV void scan_item_mfma(const Params& p, int g, int item, char* smem) {
  const int L = g ? 8192 : 4096;
  const int NC = L / 64;
  const int vs = item & 3, dir = (item >> 2) & 1, h = (item >> 3) & 3, b = item >> 5;
  char* Qs = smem;
  char* Ks = Qs + 17408;
  char* KTs = Ks + 17408;
  char* Vts = KTs + 18432;
  char* Ps = Vts + 4608;
  char* Sts = Ps + 9216;
  float* decs = (float*)(Sts + 8704);
  u16* PHG = (u16*)(p.ws + OFF_PHG);
  const u16* QK = (const u16*)(p.out + (size_t)g * NTOK * D);
  const u16* Qp = QK + (size_t)(2 * dir) * NTOK * 512;
  const u16* Kp = Qp + (size_t)NTOK * 512;
  const u16* KT = (const u16*)(p.ws + OFF_KT);
  const float* DEC = (const float*)(p.ws + OFF_DEC);
  const int tid = tidx();
  const int wave = __builtin_amdgcn_readfirstlane(tid >> 6);
  const int lane = tid & 63, r = lane & 31, hh = lane >> 5;
  __syncthreads();
  for (int e = tid; e < 8704 / 16; e += 256) ((uint4*)Sts)[e] = make_uint4(0, 0, 0, 0);
  f32x16 accS[2];
#pragma unroll
  for (int t = 0; t < 2; ++t)
#pragma unroll
    for (int i = 0; i < 16; ++i) accS[t][i] = 0.f;
  const int ocol = (dir ? 1024 : 0) + h * 128 + vs * 32;

  uint4 q0, q1, q2, q3, k0, k1, k2, k3, t0, t1, t2, t3, vv;
  float dd = 0.f;
  const int qrow = tid >> 4, qc = tid & 15;
  const int trow = tid >> 3, tc = tid & 7;
  const int vrow = tid >> 2, vc = tid & 3;
#define SCAN_ISSUE(n_)                                                                                   \
  {                                                                                                      \
    const size_t cidx_ = (size_t)b * NC + (n_);                                                          \
    const size_t tok_ = cidx_ * 64;                                                                      \
    const u16* gq = Qp + (tok_ + qrow) * 512 + h * 128 + qc * 8;                                         \
    const u16* gk = Kp + (tok_ + qrow) * 512 + h * 128 + qc * 8;                                         \
    q0 = *(const uint4*)(gq); q1 = *(const uint4*)(gq + 16 * 512);                                       \
    q2 = *(const uint4*)(gq + 32 * 512); q3 = *(const uint4*)(gq + 48 * 512);                            \
    k0 = *(const uint4*)(gk); k1 = *(const uint4*)(gk + 16 * 512);                                       \
    k2 = *(const uint4*)(gk + 32 * 512); k3 = *(const uint4*)(gk + 48 * 512);                            \
    const u16* gt = KT + ((cidx_ * 2 + dir) * 512 + h * 128 + trow) * 64 + tc * 8;                       \
    t0 = *(const uint4*)(gt); t1 = *(const uint4*)(gt + 32 * 64);                                        \
    t2 = *(const uint4*)(gt + 64 * 64); t3 = *(const uint4*)(gt + 96 * 64);                              \
    vv = *(const uint4*)(PHG + (tok_ + vrow) * 2560 + 512 + h * 128 + vs * 32 + vc * 8);                 \
    dd = DEC[((size_t)dir * 512 + cidx_) * 512 + h * 128 + (tid & 127)];                                 \
  }
#define SCAN_BAR()                                        \
  {                                                       \
    asm volatile("s_waitcnt lgkmcnt(0)" ::: "memory");     \
    __builtin_amdgcn_s_barrier();                         \
    asm volatile("" ::: "memory");                         \
  }
  unsigned opk[8] = {0u, 0u, 0u, 0u, 0u, 0u, 0u, 0u};
  size_t otok = 0;
  SCAN_ISSUE(dir ? NC - 1 : 0);
  for (int ci = 0; ci < NC; ++ci) {
    const int n = dir ? NC - 1 - ci : ci;
    const size_t tok0 = ((size_t)b * NC + n) * 64;
    {
      char* d = Qs + qrow * 272 + qc * 16;
      *(uint4*)(d) = q0; *(uint4*)(d + 16 * 272) = q1; *(uint4*)(d + 32 * 272) = q2; *(uint4*)(d + 48 * 272) = q3;
      d = Ks + qrow * 272 + qc * 16;
      *(uint4*)(d) = k0; *(uint4*)(d + 16 * 272) = k1; *(uint4*)(d + 32 * 272) = k2; *(uint4*)(d + 48 * 272) = k3;
      d = KTs + trow * 144 + tc * 16;
      *(uint4*)(d) = t0; *(uint4*)(d + 32 * 144) = t1; *(uint4*)(d + 64 * 144) = t2; *(uint4*)(d + 96 * 144) = t3;
      st8t(Vts + (vc * 8) * 144 + vrow * 2, vv);
      if (tid < 128) decs[tid] = dd;
      if (wave < 2 && ci > 0) {
        u16* og = PHG + (otok + 32 * wave + 4 * hh) * 2560 + ocol + r;
#pragma unroll
        for (int i = 0; i < 8; ++i) {
          og[(size_t)(((2 * i) & 3) + 8 * ((2 * i) >> 2)) * 2560] = (u16)(opk[i] & 0xffffu);
          og[(size_t)(((2 * i + 1) & 3) + 8 * ((2 * i + 1) >> 2)) * 2560] = (u16)(opk[i] >> 16);
        }
      }
      if (wave >= 2 && ci > 0) {
#pragma unroll
        for (int t = 0; t < 2; ++t) {
          const int kt = 2 * (wave - 2) + t;
#pragma unroll
          for (int rg = 0; rg < 4; ++rg) {
            const int kk0 = 32 * kt + 8 * rg + 4 * hh;
            *(uint2*)(Sts + r * 272 + kk0 * 2) = make_uint2(pack2(accS[t][4 * rg + 0], accS[t][4 * rg + 1]),
                                                            pack2(accS[t][4 * rg + 2], accS[t][4 * rg + 3]));
          }
        }
      }
    }
    SCAN_BAR();
    {
      const int nn = (ci + 1 < NC) ? (dir ? NC - 2 - ci : ci + 1) : n;
      SCAN_ISSUE(nn);
    }
    __builtin_amdgcn_sched_barrier(0);
    {
      const int jt = wave >> 1, st = wave & 1;
      const bool active = dir ? (st >= jt) : (st <= jt);
      f32x16 pa;
#pragma unroll
      for (int i = 0; i < 16; ++i) pa[i] = 0.f;
      if (active) {
        bf16x8 qa[8], kb[8];
#pragma unroll
        for (int ks = 0; ks < 8; ++ks) {
          qa[ks] = *(const bf16x8*)(Qs + (32 * jt + r) * 272 + ks * 32 + hh * 16);
          kb[ks] = *(const bf16x8*)(Ks + (32 * st + r) * 272 + ks * 32 + hh * 16);
        }
        __builtin_amdgcn_sched_barrier(0);
        f32x16 p1;
#pragma unroll
        for (int i = 0; i < 16; ++i) p1[i] = 0.f;
#pragma unroll
        for (int ks = 0; ks < 4; ++ks) {
          pa = __builtin_amdgcn_mfma_f32_32x32x16_bf16(qa[2 * ks], kb[2 * ks], pa, 0, 0, 0);
          p1 = __builtin_amdgcn_mfma_f32_32x32x16_bf16(qa[2 * ks + 1], kb[2 * ks + 1], p1, 0, 0, 0);
        }
#pragma unroll
        for (int i = 0; i < 16; ++i) pa[i] += p1[i];
      }
#pragma unroll
      for (int i = 0; i < 16; ++i) {
        const int j = 32 * jt + (i & 3) + 8 * (i >> 2) + 4 * hh;
        const int s_ = 32 * st + r;
        const bool keep = dir ? (s_ >= j) : (s_ <= j);
        *(u16*)(Ps + j * 144 + s_ * 2) = keep ? f2bf(pa[i]) : (u16)0;
      }
    }
    SCAN_BAR();
    if (wave < 2) {
      const int jt = wave;
      bf16x8 pp[4], vb[4], qa[4], sb[4];
#pragma unroll
      for (int ks = 0; ks < 4; ++ks) {
        pp[ks] = *(const bf16x8*)(Ps + (32 * jt + r) * 144 + ks * 32 + hh * 16);
        vb[ks] = *(const bf16x8*)(Vts + r * 144 + ks * 32 + hh * 16);
        qa[ks] = *(const bf16x8*)(Qs + (32 * jt + r) * 272 + ks * 32 + hh * 16);
        sb[ks] = *(const bf16x8*)(Sts + r * 272 + ks * 32 + hh * 16);
      }
      __builtin_amdgcn_sched_barrier(0);
      f32x16 o, o1;
#pragma unroll
      for (int i = 0; i < 16; ++i) { o[i] = 0.f; o1[i] = 0.f; }
#pragma unroll
      for (int ks = 0; ks < 4; ++ks) {
        o = __builtin_amdgcn_mfma_f32_32x32x16_bf16(pp[ks], vb[ks], o, 0, 0, 0);
        o1 = __builtin_amdgcn_mfma_f32_32x32x16_bf16(qa[ks], sb[ks], o1, 0, 0, 0);
      }
      __builtin_amdgcn_sched_barrier(0);
#pragma unroll
      for (int ks = 0; ks < 4; ++ks) {
        qa[ks] = *(const bf16x8*)(Qs + (32 * jt + r) * 272 + (ks + 4) * 32 + hh * 16);
        sb[ks] = *(const bf16x8*)(Sts + r * 272 + (ks + 4) * 32 + hh * 16);
      }
      __builtin_amdgcn_sched_barrier(0);
      o = __builtin_amdgcn_mfma_f32_32x32x16_bf16(qa[0], sb[0], o, 0, 0, 0);
      o1 = __builtin_amdgcn_mfma_f32_32x32x16_bf16(qa[1], sb[1], o1, 0, 0, 0);
      o = __builtin_amdgcn_mfma_f32_32x32x16_bf16(qa[2], sb[2], o, 0, 0, 0);
      o1 = __builtin_amdgcn_mfma_f32_32x32x16_bf16(qa[3], sb[3], o1, 0, 0, 0);
      f32x16 o2;
#pragma unroll
      for (int i = 0; i < 16; ++i) o2[i] = 0.f;
#pragma unroll
      for (int i = 0; i < 8; ++i)
        opk[i] = pack2(o[2 * i] + o1[2 * i] + o2[2 * i], o[2 * i + 1] + o1[2 * i + 1] + o2[2 * i + 1]);
      otok = tok0;
    } else {
      const int kt0 = 2 * (wave - 2);
      bf16x8 ka[2][4], vb[4];
#pragma unroll
      for (int ks = 0; ks < 4; ++ks) {
        vb[ks] = *(const bf16x8*)(Vts + r * 144 + ks * 32 + hh * 16);
        ka[0][ks] = *(const bf16x8*)(KTs + (32 * kt0 + r) * 144 + ks * 32 + hh * 16);
        ka[1][ks] = *(const bf16x8*)(KTs + (32 * (kt0 + 1) + r) * 144 + ks * 32 + hh * 16);
      }
      __builtin_amdgcn_sched_barrier(0);
#pragma unroll
      for (int ks = 0; ks < 4; ++ks) {
        accS[0] = __builtin_amdgcn_mfma_f32_32x32x16_bf16(ka[0][ks], vb[ks], accS[0], 0, 0, 0);
        accS[1] = __builtin_amdgcn_mfma_f32_32x32x16_bf16(ka[1][ks], vb[ks], accS[1], 0, 0, 0);
      }
#pragma unroll
      for (int t = 0; t < 2; ++t)
#pragma unroll
        for (int i = 0; i < 16; ++i) accS[t][i] *= decs[32 * (kt0 + t) + (i & 3) + 8 * (i >> 2) + 4 * hh];
    }
    SCAN_BAR();
  }
  if (wave < 2) {
    u16* og = PHG + (otok + 32 * wave + 4 * hh) * 2560 + ocol + r;
#pragma unroll
    for (int i = 0; i < 8; ++i) {
      og[(size_t)(((2 * i) & 3) + 8 * ((2 * i) >> 2)) * 2560] = (u16)(opk[i] & 0xffffu);
      og[(size_t)(((2 * i + 1) & 3) + 8 * ((2 * i + 1) >> 2)) * 2560] = (u16)(opk[i] >> 16);
    }
  }
#undef SCAN_ISSUE
#undef SCAN_BAR
}

DEV float conv3_at(const u16* __restrict__ row, int t, int L, float w0, float w1, float w2, float bb) {
  const float um = (t > 0) ? bf2f(row[t - 1]) : 0.f;
  const float u0 = bf2f(row[t]);
  const float up = (t < L - 1) ? bf2f(row[t + 1]) : 0.f;
  return um * w0 + u0 * w1 + up * w2 + bb;
}

struct F8 { float v[8]; };
DEV F8 conv8(const u16* __restrict__ row, int t, int L, float w0, float w1, float w2, float bb) {
  const uint4 u = *(const uint4*)(row + t);
  const float um = (t > 0) ? bf2f(row[t - 1]) : 0.f;
  const float up = (t + 8 < L) ? bf2f(row[t + 8]) : 0.f;
  float x[10];
  x[0] = um;
  x[1] = bflo(u.x); x[2] = bfhi(u.x); x[3] = bflo(u.y); x[4] = bfhi(u.y);
  x[5] = bflo(u.z); x[6] = bfhi(u.z); x[7] = bflo(u.w); x[8] = bfhi(u.w);
  x[9] = up;
  F8 o;
#pragma unroll
  for (int j = 0; j < 8; ++j) o.v[j] = x[j] * w0 + x[j + 1] * w1 + x[j + 2] * w2 + bb;
  return o;
}

template <int BG>
DEV void hyena_item_mfma(const Params& p, int g, int item, char* smem, int half) {
  constexpr int NT = 256 / BG;
  constexpr int L = NT * 64;
  constexpr int VROW = 144;
  constexpr int RK1 = 4 * L + 64;
  constexpr int VBASE = 2 * (4 * L + 64);
  const int c = item >> 1, bgi = item & 1;
  char* Vl = smem + VBASE + half * (257 * VROW);
  u16* UHY = (u16*)(p.ws + OFF_UHY);
  const u16* RK = (const u16*)(p.ws + OFF_KK) + (g ? (size_t)512 * 8192 : 0) + (size_t)c * 2 * L;
  const float* cw = p.in[I_CONVW];
  const float* cb = p.in[I_CONVB];
  const int tid = tidx();
  __syncthreads();
  if (half == 0) {
#pragma unroll 8
    for (int e = tid; e < 2 * L / 8; e += 256) ((uint4*)smem)[e] = ((const uint4*)RK)[e];
  } else {
#pragma unroll 4
    for (int e = tid; e < 2 * L / 8; e += 256) {
      const uint4 v = ((const uint4*)RK)[e];
      const unsigned nx = (8 * e + 8 < 2 * L) ? (unsigned)RK[8 * e + 8] : 0u;
      uint4 o;
      o.x = (v.x >> 16) | (v.y << 16);
      o.y = (v.y >> 16) | (v.z << 16);
      o.z = (v.z >> 16) | (v.w << 16);
      o.w = (v.w >> 16) | (nx << 16);
      ((uint4*)(smem + RK1))[e] = o;
    }
  }
  {
    const float wx1_0 = cw[0 * 1536 + 512 + c], wx1_1 = cw[1 * 1536 + 512 + c], wx1_2 = cw[2 * 1536 + 512 + c], bx1 = cb[512 + c];
    const float wv_0 = cw[0 * 1536 + 1024 + c], wv_1 = cw[1 * 1536 + 1024 + c], wv_2 = cw[2 * 1536 + 1024 + c], bv = cb[1024 + c];
#pragma unroll 4
    for (int e = tid; e < BG * L / 8; e += 256) {
      const int bl = e / (L / 8), t = (e % (L / 8)) * 8;
      const int b = bgi * BG + bl;
      const F8 a = conv8(UHY + ((size_t)b * 1536 + 1024 + c) * L, t, L, wv_0, wv_1, wv_2, bv);
      const F8 x = conv8(UHY + ((size_t)b * 1536 + 512 + c) * L, t, L, wx1_0, wx1_1, wx1_2, bx1);
      *(uint4*)(Vl + ((t >> 6) * BG + bl) * VROW + (t & 63) * 2) =
          make_uint4(pack2(a.v[0] * x.v[0], a.v[1] * x.v[1]), pack2(a.v[2] * x.v[2], a.v[3] * x.v[3]),
                     pack2(a.v[4] * x.v[4], a.v[5] * x.v[5]), pack2(a.v[6] * x.v[6], a.v[7] * x.v[7]));
    }
  }
  if (tid < 9) *(uint4*)(Vl + 256 * VROW + tid * 16) = make_uint4(0u, 0u, 0u, 0u);
  __syncthreads();
  const int wave = tid >> 6, lane = tid & 63;
  const int n = lane & 31, hh = lane >> 5;
  Acc acc;
  acc_zero(acc);
  const int colw = wave * 64;
  {
    typedef __attribute__((ext_vector_type(2))) unsigned u32x2;
    typedef __attribute__((ext_vector_type(4))) unsigned u32x4;
    struct HySet {
      u32x2 wlo[6], whi[6];
      u32x4 bv[2][4];
      bool valid[2];
    };
    const int Tw0 = colw / BG;
    const int dlo = Tw0 - NT + 1, dhi = Tw0 + 64 / BG - 1;
    const int par = n & 1;
    const unsigned pkb = (unsigned)(size_t)smem + (par ? RK1 : 0) + 2u * (unsigned)(L - n + 8 * hh - 32 - par);
    const unsigned vlb = (unsigned)(size_t)Vl;
#define HY_PREP(Y_, dl_)                                              \
    const unsigned pabY_ = pkb - 128u * (unsigned)(dl_);               \
    unsigned pbY0_;                                                    \
    {                                                                  \
      const int col = colw + 0 + n;                                   \
      const int S = col / BG - (dl_);                                  \
      Y_.valid[0] = (unsigned)S < (unsigned)NT;                        \
      const int scol = Y_.valid[0] ? col - (dl_) * BG : 256;           \
      pbY0_ = vlb + (unsigned)(scol * VROW + hh * 16);                 \
    }                                                                  \
    unsigned pbY1_;                                                    \
    {                                                                  \
      const int col = colw + 32 + n;                                   \
      const int S = col / BG - (dl_);                                  \
      Y_.valid[1] = (unsigned)S < (unsigned)NT;                        \
      const int scol = Y_.valid[1] ? col - (dl_) * BG : 256;           \
      pbY1_ = vlb + (unsigned)(scol * VROW + hh * 16);                 \
    }                                                                  \

#define HY_ISSUE0(Y_, dl_)                                            \
    {                                                                  \
      HY_PREP(Y_, dl_)                                                 \
      asm volatile("ds_read2_b32 %0, %1 offset0:0 offset1:1" : "=v"(Y_.wlo[0]) : "v"(pabY_));  \
      asm volatile("ds_read2_b32 %0, %1 offset0:2 offset1:3" : "=v"(Y_.whi[0]) : "v"(pabY_));  \
      asm volatile("ds_read2_b32 %0, %1 offset0:8 offset1:9" : "=v"(Y_.wlo[1]) : "v"(pabY_));  \
      asm volatile("ds_read2_b32 %0, %1 offset0:10 offset1:11" : "=v"(Y_.whi[1]) : "v"(pabY_));  \
      asm volatile("ds_read2_b32 %0, %1 offset0:16 offset1:17" : "=v"(Y_.wlo[2]) : "v"(pabY_));  \
      asm volatile("ds_read2_b32 %0, %1 offset0:18 offset1:19" : "=v"(Y_.whi[2]) : "v"(pabY_));  \
      asm volatile("ds_read2_b32 %0, %1 offset0:24 offset1:25" : "=v"(Y_.wlo[3]) : "v"(pabY_));  \
      asm volatile("ds_read2_b32 %0, %1 offset0:26 offset1:27" : "=v"(Y_.whi[3]) : "v"(pabY_));  \
      asm volatile("ds_read2_b32 %0, %1 offset0:32 offset1:33" : "=v"(Y_.wlo[4]) : "v"(pabY_));  \
      asm volatile("ds_read2_b32 %0, %1 offset0:34 offset1:35" : "=v"(Y_.whi[4]) : "v"(pabY_));  \
      asm volatile("ds_read2_b32 %0, %1 offset0:40 offset1:41" : "=v"(Y_.wlo[5]) : "v"(pabY_));  \
      asm volatile("ds_read2_b32 %0, %1 offset0:42 offset1:43" : "=v"(Y_.whi[5]) : "v"(pabY_));  \
      asm volatile("ds_read_b128 %0, %1 offset:0" : "=v"(Y_.bv[0][0]) : "v"(pbY0_));  \
      asm volatile("ds_read_b128 %0, %1 offset:32" : "=v"(Y_.bv[0][1]) : "v"(pbY0_));  \
      asm volatile("ds_read_b128 %0, %1 offset:64" : "=v"(Y_.bv[0][2]) : "v"(pbY0_));  \
      asm volatile("ds_read_b128 %0, %1 offset:96" : "=v"(Y_.bv[0][3]) : "v"(pbY0_));  \
      asm volatile("ds_read_b128 %0, %1 offset:0" : "=v"(Y_.bv[1][0]) : "v"(pbY1_));  \
      asm volatile("ds_read_b128 %0, %1 offset:32" : "=v"(Y_.bv[1][1]) : "v"(pbY1_));  \
      asm volatile("ds_read_b128 %0, %1 offset:64" : "=v"(Y_.bv[1][2]) : "v"(pbY1_));  \
      asm volatile("ds_read_b128 %0, %1 offset:96" : "=v"(Y_.bv[1][3]) : "v"(pbY1_));  \
    }

#define HY_STEP(X_, Y_, dl_)                                          \
    {                                                                  \
      HY_PREP(Y_, dl_)                                                 \
      bf16x8 a[6];                                                     \
      _Pragma("unroll") for (int q = 0; q < 6; ++q) {                  \
        const u32x4 t = {X_.wlo[q][0], X_.wlo[q][1], X_.whi[q][0], X_.whi[q][1]}; \
        a[q] = __builtin_bit_cast(bf16x8, t);                          \
      }                                                                \
      {                                                                \
        u32x4 bq = X_.bv[0][0];                                        \
        const bf16x8 bb = __builtin_bit_cast(bf16x8, bq);              \
        __builtin_amdgcn_sched_barrier(0);                             \
        asm volatile("ds_read2_b32 %0, %1 offset0:0 offset1:1" : "=v"(Y_.wlo[0]) : "v"(pabY_));  \
        asm volatile("ds_read2_b32 %0, %1 offset0:2 offset1:3" : "=v"(Y_.whi[0]) : "v"(pabY_));  \
        __builtin_amdgcn_sched_barrier(0);                             \
        asm volatile("s_nop 1\n\tv_mfma_f32_32x32x16_bf16 %0, %1, %2, %0" : "+v"(acc[0][0]) : "v"(a[2]), "v"(bb)); \
        __builtin_amdgcn_sched_barrier(0);                             \
        asm volatile("ds_read2_b32 %0, %1 offset0:8 offset1:9" : "=v"(Y_.wlo[1]) : "v"(pabY_));  \
        asm volatile("ds_read2_b32 %0, %1 offset0:10 offset1:11" : "=v"(Y_.whi[1]) : "v"(pabY_));  \
        __builtin_amdgcn_sched_barrier(0);                             \
        asm volatile("s_nop 1\n\tv_mfma_f32_32x32x16_bf16 %0, %1, %2, %0" : "+v"(acc[0][1]) : "v"(a[0]), "v"(bb)); \
      }                                                                \
      {                                                                \
        u32x4 bq = X_.bv[0][1];                                        \
        const bf16x8 bb = __builtin_bit_cast(bf16x8, bq);              \
        __builtin_amdgcn_sched_barrier(0);                             \
        asm volatile("ds_read2_b32 %0, %1 offset0:16 offset1:17" : "=v"(Y_.wlo[2]) : "v"(pabY_));  \
        asm volatile("ds_read2_b32 %0, %1 offset0:18 offset1:19" : "=v"(Y_.whi[2]) : "v"(pabY_));  \
        __builtin_amdgcn_sched_barrier(0);                             \
        asm volatile("s_nop 1\n\tv_mfma_f32_32x32x16_bf16 %0, %1, %2, %0" : "+v"(acc[0][0]) : "v"(a[3]), "v"(bb)); \
        __builtin_amdgcn_sched_barrier(0);                             \
        asm volatile("ds_read2_b32 %0, %1 offset0:24 offset1:25" : "=v"(Y_.wlo[3]) : "v"(pabY_));  \
        asm volatile("ds_read2_b32 %0, %1 offset0:26 offset1:27" : "=v"(Y_.whi[3]) : "v"(pabY_));  \
        __builtin_amdgcn_sched_barrier(0);                             \
        asm volatile("s_nop 1\n\tv_mfma_f32_32x32x16_bf16 %0, %1, %2, %0" : "+v"(acc[0][1]) : "v"(a[1]), "v"(bb)); \
      }                                                                \
      {                                                                \
        u32x4 bq = X_.bv[0][2];                                        \
        const bf16x8 bb = __builtin_bit_cast(bf16x8, bq);              \
        __builtin_amdgcn_sched_barrier(0);                             \
        asm volatile("ds_read2_b32 %0, %1 offset0:32 offset1:33" : "=v"(Y_.wlo[4]) : "v"(pabY_));  \
        asm volatile("ds_read2_b32 %0, %1 offset0:34 offset1:35" : "=v"(Y_.whi[4]) : "v"(pabY_));  \
        __builtin_amdgcn_sched_barrier(0);                             \
        asm volatile("s_nop 1\n\tv_mfma_f32_32x32x16_bf16 %0, %1, %2, %0" : "+v"(acc[0][0]) : "v"(a[4]), "v"(bb)); \
        __builtin_amdgcn_sched_barrier(0);                             \
        asm volatile("ds_read2_b32 %0, %1 offset0:40 offset1:41" : "=v"(Y_.wlo[5]) : "v"(pabY_));  \
        asm volatile("ds_read2_b32 %0, %1 offset0:42 offset1:43" : "=v"(Y_.whi[5]) : "v"(pabY_));  \
        __builtin_amdgcn_sched_barrier(0);                             \
        asm volatile("s_nop 1\n\tv_mfma_f32_32x32x16_bf16 %0, %1, %2, %0" : "+v"(acc[0][1]) : "v"(a[2]), "v"(bb)); \
      }                                                                \
      {                                                                \
        u32x4 bq = X_.bv[0][3];                                        \
        const bf16x8 bb = __builtin_bit_cast(bf16x8, bq);              \
        __builtin_amdgcn_sched_barrier(0);                             \
        asm volatile("ds_read_b128 %0, %1 offset:0" : "=v"(Y_.bv[0][0]) : "v"(pbY0_));  \
        asm volatile("ds_read_b128 %0, %1 offset:32" : "=v"(Y_.bv[0][1]) : "v"(pbY0_));  \
        __builtin_amdgcn_sched_barrier(0);                             \
        asm volatile("s_nop 1\n\tv_mfma_f32_32x32x16_bf16 %0, %1, %2, %0" : "+v"(acc[0][0]) : "v"(a[5]), "v"(bb)); \
        __builtin_amdgcn_sched_barrier(0);                             \
        asm volatile("ds_read_b128 %0, %1 offset:64" : "=v"(Y_.bv[0][2]) : "v"(pbY0_));  \
        asm volatile("ds_read_b128 %0, %1 offset:96" : "=v"(Y_.bv[0][3]) : "v"(pbY0_));  \
        __builtin_amdgcn_sched_barrier(0);                             \
        asm volatile("s_nop 1\n\tv_mfma_f32_32x32x16_bf16 %0, %1, %2, %0" : "+v"(acc[0][1]) : "v"(a[3]), "v"(bb)); \
      }                                                                \
      {                                                                \
        u32x4 bq = X_.bv[1][0];                                        \
        const bf16x8 bb = __builtin_bit_cast(bf16x8, bq);              \
        __builtin_amdgcn_sched_barrier(0);                             \
        asm volatile("ds_read_b128 %0, %1 offset:0" : "=v"(Y_.bv[1][0]) : "v"(pbY1_));  \
        asm volatile("ds_read_b128 %0, %1 offset:32" : "=v"(Y_.bv[1][1]) : "v"(pbY1_));  \
        __builtin_amdgcn_sched_barrier(0);                             \
        asm volatile("s_nop 1\n\tv_mfma_f32_32x32x16_bf16 %0, %1, %2, %0" : "+v"(acc[1][0]) : "v"(a[2]), "v"(bb)); \
        __builtin_amdgcn_sched_barrier(0);                             \
        asm volatile("ds_read_b128 %0, %1 offset:64" : "=v"(Y_.bv[1][2]) : "v"(pbY1_));  \
        asm volatile("ds_read_b128 %0, %1 offset:96" : "=v"(Y_.bv[1][3]) : "v"(pbY1_));  \
        __builtin_amdgcn_sched_barrier(0);                             \
        asm volatile("s_nop 1\n\tv_mfma_f32_32x32x16_bf16 %0, %1, %2, %0" : "+v"(acc[1][1]) : "v"(a[0]), "v"(bb)); \
      }                                                                \
      {                                                                \
        u32x4 bq = X_.bv[1][1];                                        \
        const bf16x8 bb = __builtin_bit_cast(bf16x8, bq);              \
        __builtin_amdgcn_sched_barrier(0);                             \
        __builtin_amdgcn_sched_barrier(0);                             \
        asm volatile("s_nop 1\n\tv_mfma_f32_32x32x16_bf16 %0, %1, %2, %0" : "+v"(acc[1][0]) : "v"(a[3]), "v"(bb)); \
        __builtin_amdgcn_sched_barrier(0);                             \
        __builtin_amdgcn_sched_barrier(0);                             \
        asm volatile("s_nop 1\n\tv_mfma_f32_32x32x16_bf16 %0, %1, %2, %0" : "+v"(acc[1][1]) : "v"(a[1]), "v"(bb)); \
      }                                                                \
      {                                                                \
        u32x4 bq = X_.bv[1][2];                                        \
        const bf16x8 bb = __builtin_bit_cast(bf16x8, bq);              \
        __builtin_amdgcn_sched_barrier(0);                             \
        __builtin_amdgcn_sched_barrier(0);                             \
        asm volatile("s_nop 1\n\tv_mfma_f32_32x32x16_bf16 %0, %1, %2, %0" : "+v"(acc[1][0]) : "v"(a[4]), "v"(bb)); \
        __builtin_amdgcn_sched_barrier(0);                             \
        __builtin_amdgcn_sched_barrier(0);                             \
        asm volatile("s_nop 1\n\tv_mfma_f32_32x32x16_bf16 %0, %1, %2, %0" : "+v"(acc[1][1]) : "v"(a[2]), "v"(bb)); \
      }                                                                \
      {                                                                \
        u32x4 bq = X_.bv[1][3];                                        \
        const bf16x8 bb = __builtin_bit_cast(bf16x8, bq);              \
        __builtin_amdgcn_sched_barrier(0);                             \
        __builtin_amdgcn_sched_barrier(0);                             \
        asm volatile("s_nop 1\n\tv_mfma_f32_32x32x16_bf16 %0, %1, %2, %0" : "+v"(acc[1][0]) : "v"(a[5]), "v"(bb)); \
        __builtin_amdgcn_sched_barrier(0);                             \
        __builtin_amdgcn_sched_barrier(0);                             \
        asm volatile("s_nop 1\n\tv_mfma_f32_32x32x16_bf16 %0, %1, %2, %0" : "+v"(acc[1][1]) : "v"(a[3]), "v"(bb)); \
      }                                                                \
    }

#define HY_COMPUTE(X_)                                                \
    {                                                                  \
      bf16x8 a[6];                                                     \
      _Pragma("unroll") for (int q = 0; q < 6; ++q) {                  \
        const u32x4 t = {X_.wlo[q][0], X_.wlo[q][1], X_.whi[q][0], X_.whi[q][1]}; \
        a[q] = __builtin_bit_cast(bf16x8, t);                          \
      }                                                                \
      _Pragma("unroll") for (int nt = 0; nt < 2; ++nt) {               \
        _Pragma("unroll") for (int ks = 0; ks < 4; ++ks) {             \
          u32x4 bq = X_.bv[nt][ks];                                    \
          const bf16x8 bb = __builtin_bit_cast(bf16x8, bq);            \
          acc[nt][0] = __builtin_amdgcn_mfma_f32_32x32x16_bf16(a[ks + 2], bb, acc[nt][0], 0, 0, 0); \
          acc[nt][1] = __builtin_amdgcn_mfma_f32_32x32x16_bf16(a[ks], bb, acc[nt][1], 0, 0, 0);     \
        }                                                              \
      }                                                                \
    }
#define HY_WAIT(S_) asm volatile("s_waitcnt lgkmcnt(0)" : "+v"(S_.wlo[0]), "+v"(S_.whi[0]), "+v"(S_.wlo[1]), "+v"(S_.whi[1]), "+v"(S_.wlo[2]), "+v"(S_.whi[2]), "+v"(S_.wlo[3]), "+v"(S_.whi[3]), "+v"(S_.wlo[4]), "+v"(S_.whi[4]), "+v"(S_.wlo[5]), "+v"(S_.whi[5]), "+v"(S_.bv[0][0]), "+v"(S_.bv[0][1]), "+v"(S_.bv[0][2]), "+v"(S_.bv[0][3]), "+v"(S_.bv[1][0]), "+v"(S_.bv[1][1]), "+v"(S_.bv[1][2]), "+v"(S_.bv[1][3]) :: "memory")
    HySet s0, s1;
    HY_ISSUE0(s0, dlo);
    int dl = dlo;
    for (; dl + 1 <= dhi; dl += 2) {
      HY_WAIT(s0);
      HY_STEP(s0, s1, dl + 1);
      __builtin_amdgcn_sched_barrier(0);
      HY_WAIT(s1);
      {
        const int d2 = (dl + 2 <= dhi) ? dl + 2 : dhi;
        HY_STEP(s1, s0, d2);
      }
      __builtin_amdgcn_sched_barrier(0);
    }
    if (dl == dhi) {
      HY_WAIT(s0);
      HY_COMPUTE(s0);
    }
    asm volatile("s_waitcnt lgkmcnt(0)" ::: "memory");
#undef HY_PREP
#undef HY_ISSUE0
#undef HY_STEP
#undef HY_COMPUTE
#undef HY_WAIT
  }
  __syncthreads();
  {
    const float fbias = p.in[I_FBIAS][c];
#pragma unroll
    for (int nt = 0; nt < 2; ++nt)
#pragma unroll
      for (int mi = 0; mi < 2; ++mi)
#pragma unroll
        for (int rg = 0; rg < 4; ++rg) {
          const int col = colw + 32 * nt + n, i0 = 32 * mi + 8 * rg + 4 * hh;
          char* pv = Vl + col * VROW + i0 * 2;
          const uint2 w = *(const uint2*)pv;
          const float t0 = acc[nt][mi][4 * rg + 0] + bflo(w.x) * fbias;
          const float t1 = acc[nt][mi][4 * rg + 1] + bfhi(w.x) * fbias;
          const float t2 = acc[nt][mi][4 * rg + 2] + bflo(w.y) * fbias;
          const float t3 = acc[nt][mi][4 * rg + 3] + bfhi(w.y) * fbias;
          *(uint2*)pv = make_uint2(pack2(t0, t1), pack2(t2, t3));
        }
  }
  __syncthreads();
  {
    const float wx0_0 = cw[0 * 1536 + c], wx0_1 = cw[1 * 1536 + c], wx0_2 = cw[2 * 1536 + c], bx0 = cb[c];
    for (int e0 = tid; e0 < BG * L / 8; e0 += 256 * 4) {
      F8 x[4];
      uint4 y[4];
#pragma unroll
      for (int u = 0; u < 4; ++u) {
        const int e = e0 + 256 * u;
        const int bl = e / (L / 8), t = (e % (L / 8)) * 8;
        const int b = bgi * BG + bl;
        x[u] = conv8(UHY + ((size_t)b * 1536 + c) * L, t, L, wx0_0, wx0_1, wx0_2, bx0);
        y[u] = *(const uint4*)(Vl + ((t >> 6) * BG + bl) * VROW + (t & 63) * 2);
      }
#pragma unroll
      for (int u = 0; u < 4; ++u) {
        const int e = e0 + 256 * u;
        const int bl = e / (L / 8), t = (e % (L / 8)) * 8;
        const int b = bgi * BG + bl;
        *(uint4*)(UHY + ((size_t)b * 1536 + 1024 + c) * L + t) =
            make_uint4(pack2(bflo(y[u].x) * x[u].v[0], bfhi(y[u].x) * x[u].v[1]), pack2(bflo(y[u].y) * x[u].v[2], bfhi(y[u].y) * x[u].v[3]),
                       pack2(bflo(y[u].z) * x[u].v[4], bfhi(y[u].z) * x[u].v[5]), pack2(bflo(y[u].w) * x[u].v[6], bfhi(y[u].w) * x[u].v[7]));
      }
    }
  }
}

DEV void phase_p2_naive(const Params& p, int g, char* hsm) {
  __shared__ int s_item;
  const int nscan = g ? 128 : 256;
  const int nhy = 1024;
  unsigned* cnt = (unsigned*)(p.ws + OFF_CNT) + g;
  const int half = vhalf();
  if ((int)blockIdx.x * 2 < nscan) scan_item_mfma(p, g, blockIdx.x * 2 + half, hsm);
  for (;;) {
    __syncthreads();
    if (threadIdx.x == 0) s_item = (int)atomicAdd(cnt, 2u);
    __syncthreads();
    const int it = s_item + half;
    if (it >= nhy) break;
    if (g == 0) hyena_item_mfma<4>(p, g, it, hsm - half * HALF_BYTES, half);
    else hyena_item_mfma<2>(p, g, it, hsm - half * HALF_BYTES, half);
  }
  unsigned* cnt2 = (unsigned*)(p.ws + OFF_CNT) + 2 + g;
  const float* mod = (const float*)(p.ws + OFF_MOD);
  for (;;) {
    __syncthreads();
    if (threadIdx.x == 0) s_item = (int)atomicAdd(cnt2, 2u);
    __syncthreads();
    const int it = s_item + half;
    if (it >= 512) break;
    if (g == 0) norm_adaln_rows(p.in[I_XS], p.in[I_N1G], mod, 8, 8192, 0, 1024, (u16*)(p.out + (size_t)NTOK * D), it * 64);
    else final_norm_rows(p.out, p.in[I_FING], it * 64);
  }
}

DEV void phase_p2c(const Params& p, int g) {
  u16* PHG = (u16*)(p.ws + OFF_PHG);
  const float* gn = p.in[I_GNG];
  const int tid = tidx();
  const int wave = tid >> 6, lane = tid & 63;
  constexpr int RB = 4;
  const int stride = NVB * 4;
  const int c = lane * 8;
  for (int tok0 = VBID * 4 + wave; tok0 < NTOK; tok0 += stride * RB) {
    uint4 a[RB], bq[RB], og[RB];
#pragma unroll
    for (int j = 0; j < RB; ++j) {
      const int t_ = tok0 + j * stride;
      const size_t tok = (size_t)(t_ < NTOK ? t_ : tok0);
      a[j] = *(const uint4*)(PHG + tok * 2560 + c);
      bq[j] = *(const uint4*)(PHG + tok * 2560 + 1024 + c);
      og[j] = *(const uint4*)(PHG + tok * 2560 + 2048 + c);
    }
    const float4 g0 = *(const float4*)(gn + c), g1 = *(const float4*)(gn + c + 4);
#pragma unroll
    for (int j = 0; j < RB; ++j) {
      const int t_ = tok0 + j * stride;
      float o[8];
      o[0] = bflo(a[j].x) + bflo(bq[j].x); o[1] = bfhi(a[j].x) + bfhi(bq[j].x);
      o[2] = bflo(a[j].y) + bflo(bq[j].y); o[3] = bfhi(a[j].y) + bfhi(bq[j].y);
      o[4] = bflo(a[j].z) + bflo(bq[j].z); o[5] = bfhi(a[j].z) + bfhi(bq[j].z);
      o[6] = bflo(a[j].w) + bflo(bq[j].w); o[7] = bfhi(a[j].w) + bfhi(bq[j].w);
      float ss = 0.f;
#pragma unroll
      for (int i = 0; i < 8; ++i) ss += o[i] * o[i];
      ss += __shfl_xor(ss, 1);
      ss += __shfl_xor(ss, 2);
      ss += __shfl_xor(ss, 4);
      ss += __shfl_xor(ss, 8);
      const float rstd = rsqrtf(ss * (1.f / 128.f) + EPSF);
      const float y0 = o[0] * rstd * g0.x * bflo(og[j].x), y1 = o[1] * rstd * g0.y * bfhi(og[j].x);
      const float y2 = o[2] * rstd * g0.z * bflo(og[j].y), y3 = o[3] * rstd * g0.w * bfhi(og[j].y);
      const float y4 = o[4] * rstd * g1.x * bflo(og[j].z), y5 = o[5] * rstd * g1.y * bfhi(og[j].z);
      const float y6 = o[6] * rstd * g1.z * bflo(og[j].w), y7 = o[7] * rstd * g1.w * bfhi(og[j].w);
      if (t_ < NTOK)
        *(uint4*)(PHG + (size_t)t_ * 2560 + c) = make_uint4(pack2(y0, y1), pack2(y2, y3), pack2(y4, y5), pack2(y6, y7));
    }
  }
}

DEV void tile_order(int tile, int ntn, int& mt, int& nt) {
  const int grp = tile / (16 * ntn), rem = tile % (16 * ntn);
  mt = grp * 16 + (rem & 15);
  nt = rem >> 4;
}

DEV void phase_p3a(const Params& p, int g, char* smem) {
  const int L = g ? 8192 : 4096;
  u16* PHG = (u16*)(p.ws + OFF_PHG);
  const u16* GT = (const u16*)(p.ws + OFF_GT);
  const u16* UHY = (const u16*)(p.ws + OFF_UHY);
  const u16* WbrT = (const u16*)(p.ws + OFF_WBR);
  for (int iter = 0;; ++iter) {
    int mt, nt;
    if (!tile_map(iter, 128, 4, mt, nt)) break;
    const int m0 = mt * 256, n0 = nt * 256;
    Acc acc;
    acc_zero(acc);
    {
      TransLoader al{UHY, L};
      RowLoader bl{WbrT, 1024};
      gemm_mainloop(acc, al, bl, m0, n0, 0, 512, smem);
    }
    acc_foreach(acc, m0, n0, [&](int m, int n, float& v) {
      const float ga = bf2f(GT[(size_t)m * 2048 + n]);
      const float gb = bf2f(GT[(size_t)m * 2048 + 1024 + n]);
      v *= ga * __builtin_amdgcn_rcpf(fmaxf(gb, 1e-30f));
    });
    {
      RowLoader al{PHG - 512, 2560};
      RowLoader bl{WbrT, 1024};
      gemm_mainloop(acc, al, bl, m0, n0, 512, 1024, smem);
    }
    acc_foreach(acc, m0, n0, [&](int m, int n, float& v) {
      const float gb = bf2f(GT[(size_t)m * 2048 + 1024 + n]);
      PHG[(size_t)m * 2560 + 1024 + n] = f2bf(gb * v);
    });
  }
}

DEV void phase_p3b(const Params& p, int g, char* smem) {
  const int L = g ? 8192 : 4096;
  const int bg0 = g ? 8 : 0;
  const u16* PHG = (const u16*)(p.ws + OFF_PHG);
  const u16* WoutT = (const u16*)(p.ws + OFF_WOUT);
  const float* X = p.in[g ? I_XS : I_XP];
  const float* mod = (const float*)(p.ws + OFF_MOD);
  float* X1 = p.out + (size_t)g * NTOK * D;
  for (int iter = 0;; ++iter) {
    int mt, nt;
    if (!tile_map(iter, 128, 4, mt, nt)) break;
    const int m0 = mt * 256, n0 = nt * 256;
    Acc acc;
    acc_zero(acc);
    RowLoader al{PHG + 1024, 2560}, bl{WoutT, 1024};
    gemm_mainloop(acc, al, bl, m0, n0, 0, 1024, smem);
    const float* gt = mod + (size_t)(bg0 + m0 / L) * DIN + 2048;
    acc_foreach(acc, m0, n0, [&](int m, int n, float& v) {
      X1[(size_t)m * D + n] = X[(size_t)m * D + n] + gt[n] * v;
    });
  }
}

DEV void phase_ff1(const Params& p, int g, char* smem) {
  const u16* H2 = (const u16*)(p.ws + OFF_H2);
  const u16* W = (const u16*)(p.ws + OFF_WFF1);
  u16* AB = (u16*)(p.ws + OFF_ABUF);
  GemmPipe gp;
  gp.primed = false;
  for (int iter = 0;; ++iter) {
    int mt, nt, mtn, ntn;
    if (!tile_map(iter, 128, 16, mt, nt)) break;
    const bool more = tile_map(iter + 1, 128, 16, mtn, ntn);
    if (!more) { mtn = mt; ntn = nt; }
    const int m0 = mt * 256, n0 = nt * 256;
    Acc acc;
    acc_zero(acc);
    RowLoader al{H2, 1024}, bl{W, 1024};
    gemm_mainloop_p(acc, al, bl, m0, n0, mtn * 256, ntn * 256, 1024, smem, gp);
    gp.primed = more;
    acc_foreach(acc, m0, n0, [&](int m, int n, float& v) {
      const float r = fmaxf(v, 0.f);
      AB[(size_t)m * 4096 + n] = f2bf(r * r);
    });
  }
}

DEV void phase_ff2(const Params& p, int g, char* smem) {
  const int L = g ? 8192 : 4096;
  const int bg0 = g ? 8 : 0;
  const u16* AB = (const u16*)(p.ws + OFF_ABUF);
  const u16* W = (const u16*)(p.ws + OFF_WFF2);
  const float* mod = (const float*)(p.ws + OFF_MOD);
  float* X1 = p.out + (size_t)g * NTOK * D;
  for (int iter = 0;; ++iter) {
    int mt, nt;
    if (!tile_map(iter, 128, 4, mt, nt)) break;
    const int m0 = mt * 256, n0 = nt * 256;
    Acc acc;
    acc_zero(acc);
    RowLoader al{AB, 4096}, bl{W, 4096};
    gemm_mainloop(acc, al, bl, m0, n0, 0, 4096, smem);
    const float* gt = mod + (size_t)(bg0 + m0 / L) * DIN + 5120;
    acc_foreach(acc, m0, n0, [&](int m, int n, float& v) { X1[(size_t)m * D + n] += gt[n] * v; });
  }
}

__global__ void __launch_bounds__(512) mk(Params p) {
  cg::grid_group grid = cg::this_grid();
  __shared__ __attribute__((aligned(16))) char smem[SMEM_BYTES];
  __shared__ uint4 xb_words;
  if (threadIdx.x == 0) xb_words = make_uint4(0u, 0u, 0u, 0u);
  __syncthreads();
  const XcdBarrier xb = xcd_barrier_post((unsigned*)(p.ws + OFF_XBAR), (volatile LAS unsigned*)&xb_words);
  char* hsm = smem + vhalf() * HALF_BYTES;
  const float* mod = (const float*)(p.ws + OFF_MOD);
  phase_prep(p, hsm);
  phase_filter_mlp(p, hsm);
  xcd_barrier(xb);
  if (p.out == nullptr) grid.sync();
  phase_filter_norm(p, hsm);
  phase_norm_adaln(p.in[I_XP], p.in[I_N1G], mod, 0, 4096, 0, 1024, (u16*)p.out);
  xcd_barrier(xb);
#pragma unroll 1
  for (int gi = 0; gi < 2; ++gi) {
    int g = gi;
    asm volatile("" : "+s"(g));
    const int L = g ? 8192 : 4096;
    const int bg0 = g ? 8 : 0;
    float* OG = p.out + (size_t)g * NTOK * D;
    phase_p1(p, g, smem);
    xcd_barrier(xb);
    phase_p15(p, g);
    xcd_barrier(xb);
    phase_p2_naive(p, g, hsm);
    xcd_barrier(xb);
    phase_p2c(p, g);
    xcd_barrier(xb);
    phase_p3a(p, g, smem);
    xcd_barrier(xb);
    phase_p3b(p, g, smem);
    xcd_barrier(xb);
    phase_norm_adaln(OG, p.in[I_N2G], mod, bg0, L, 3072, 4096, (u16*)(p.ws + OFF_H2));
    xcd_barrier(xb);
    phase_ff1(p, g, smem);
    xcd_barrier(xb);
    phase_ff2(p, g, smem);
    xcd_barrier(xb);
  }
  phase_final_norm(p.out + (size_t)NTOK * D, p.in[I_FING]);
}

extern "C" void kernel_launch(void* const* d_in, const int* in_sizes, int n_in, void* d_out, int out_size,
                              void* d_ws, size_t ws_size, hipStream_t stream) {
  static int grid_blocks = 0;
  if (!grid_blocks) {
    int dev = 0, cus = 0, per_cu = 0;
    (void)hipGetDevice(&dev);
    (void)hipDeviceGetAttribute(&cus, hipDeviceAttributeMultiprocessorCount, dev);
    (void)hipOccupancyMaxActiveBlocksPerMultiprocessor(&per_cu, mk, 512, 0);
    if (per_cu > 1) per_cu = 1;
    if (per_cu < 1) per_cu = 1;
    grid_blocks = cus * per_cu;
  }
  if (ws_size < WS_NEED) fprintf(stderr, "workspace too small: %zu < %zu\n", ws_size, (size_t)WS_NEED);
  Params p{};
  for (int i = 0; i < 27; ++i) p.in[i] = (const float*)d_in[i];
  p.out = (float*)d_out;
  p.ws = (char*)d_ws;
  (void)hipMemsetAsync((char*)d_ws + OFF_XBAR, 0, 16384, stream);
  void* args[] = {&p};
  hipError_t e = hipLaunchCooperativeKernel((void*)mk, dim3(grid_blocks), dim3(512), args, 0, stream);
  if (e != hipSuccess) fprintf(stderr, "coop launch failed: %s (grid %d)\n", hipGetErrorString(e), grid_blocks);
}
```

```cpp
#include <hip/hip_runtime.h>
#include <hip/hip_cooperative_groups.h>
#include <cstdio>
namespace cg = cooperative_groups;

typedef unsigned short u16;
typedef __attribute__((ext_vector_type(8))) short bf16x8;
typedef __attribute__((ext_vector_type(16))) float f32x16;

#define DEV __device__ __forceinline__

constexpr int D = 1024;
constexpr int NTOK = 32768;
constexpr int DIN = 6144;
constexpr float EPSF = 1e-6f;

enum { I_XP = 0, I_XS, I_CP, I_CS, I_ADAW, I_ADAB, I_N1G, I_WIN, I_CONVW, I_CONVB, I_FW1, I_FB1, I_FW2, I_FB2,
       I_FW3, I_FB3, I_FWO, I_FFREQ, I_FBIAS, I_LB, I_GNG, I_WBR, I_WOUT, I_N2G, I_WFF1, I_WFF2, I_FING };

constexpr size_t OFF_WIN = 0;
constexpr size_t OFF_WBR = OFF_WIN + (size_t)6144 * 1024 * 2;
constexpr size_t OFF_WOUT = OFF_WBR + (size_t)1024 * 1024 * 2;
constexpr size_t OFF_WFF1 = OFF_WOUT + (size_t)1024 * 1024 * 2;
constexpr size_t OFF_WFF2 = OFF_WFF1 + (size_t)4096 * 1024 * 2;
constexpr size_t OFF_MOD = OFF_WFF2 + (size_t)4096 * 1024 * 2;
constexpr size_t OFF_CNT = OFF_MOD + (size_t)12 * 6144 * 4;
constexpr size_t OFF_XBAR = OFF_CNT + 256;
constexpr size_t OFF_PART = OFF_XBAR + 16384;
constexpr size_t OFF_KK = OFF_PART + (size_t)768 * 1024 * 4;
constexpr size_t OFF_DEC = OFF_KK + (size_t)512 * (8192 + 16384) * 2;
constexpr size_t OFF_KT = OFF_DEC + (size_t)2 * 512 * 512 * 4;
constexpr size_t OFF_P = OFF_KT + (size_t)512 * 2 * 512 * 64 * 2;
constexpr size_t OFF_UHY = OFF_P;
constexpr size_t OFF_PHG = OFF_UHY + (size_t)NTOK * 1536 * 2;
constexpr size_t OFF_GT = OFF_PHG + (size_t)NTOK * 2560 * 2;
constexpr size_t WS_NEED = OFF_GT + (size_t)NTOK * 2048 * 2;
constexpr size_t OFF_HRAW = OFF_P;
constexpr size_t OFF_ABUF = OFF_UHY;
constexpr size_t OFF_H2 = OFF_GT;

struct Params {
  const float* in[27];
  float* out;
  char* ws;
};

DEV unsigned pack2(float a, float b) {
  unsigned r;
  asm("s_nop 0\n\tv_cvt_pk_bf16_f32 %0, %1, %2" : "=v"(r) : "v"(a), "v"(b));
  return r;
}
DEV u16 f2bf(float f) { return (u16)(pack2(f, f) & 0xffffu); }
DEV float bf2f(u16 h) { return __uint_as_float(((unsigned)h) << 16); }
DEV float bflo(unsigned w) { return __uint_as_float(w << 16); }
DEV float bfhi(unsigned w) { return __uint_as_float(w & 0xffff0000u); }
DEV float silu_f(float x) { return x / (1.f + __expf(-x)); }
DEV float sigmoid_f(float x) { return __builtin_amdgcn_rcpf(1.f + __expf(-x)); }
DEV int tidx_full() {
  int t = threadIdx.x;
  asm volatile("" : "+v"(t));
  return t;
}
DEV int tidx() { return tidx_full() & 255; }
DEV int vhalf() { return __builtin_amdgcn_readfirstlane((int)(threadIdx.x >> 8)); }
#define VBID ((int)blockIdx.x * 2 + vhalf())
#define NVB ((int)gridDim.x * 2)
DEV float wave_sum(float v) {
#pragma unroll
  for (int o = 32; o > 0; o >>= 1) v += __shfl_xor(v, o);
  return v;
}

#define XB_TMO      128
#define XB_XCNT(j)  (256  + 64 * (j))
#define XB_XSUB(j)  (1280 + 64 * (j))
#define XB_XGEN(j)  (2304 + 64 * (j))
#define XB_TOP      3328
#define XB_TOPGEN   3392
#define XCD_BAR_WORDS 3456
#define XB_SPIN_CAP (1u << 18)
#define LAS __attribute__((address_space(3)))

__device__ __forceinline__ unsigned xb_ld(unsigned* p)              { return __hip_atomic_load(p, __ATOMIC_RELAXED, __HIP_MEMORY_SCOPE_AGENT); }
__device__ __forceinline__ unsigned xb_add(unsigned* p, unsigned v) { return __hip_atomic_fetch_add(p, v, __ATOMIC_RELAXED, __HIP_MEMORY_SCOPE_AGENT); }
__device__ __forceinline__ unsigned xb_xcc_id() { return (unsigned)__builtin_amdgcn_s_getreg((3 << 11) | 20) & 0xFu; }
#define XB_SPIN(cond, bar) do { unsigned _sp = 0; while (cond) { __builtin_amdgcn_s_sleep(1); \
    if ((++_sp & 255u) == 0u) { if (xb_ld(&(bar)[XB_TMO])) break; if (_sp > XB_SPIN_CAP) { atomicAdd(&(bar)[XB_TMO], 1u); break; } } } } while (0)

struct XcdBarrier {
    unsigned* bar; unsigned x;
    volatile LAS unsigned* st;
};

__device__ __forceinline__ XcdBarrier xcd_barrier_post(unsigned* bar, volatile LAS unsigned* st) {
    XcdBarrier b; b.bar = bar; b.x = xb_xcc_id(); b.st = st;
    if (threadIdx.x == 0) (void)xb_add(&bar[XB_XCNT(b.x)], 1u);
    return b;
}
__device__ __forceinline__ void xcd_barrier_complete(unsigned* bar, unsigned x, unsigned& nloc, unsigned& nx) {
    const unsigned G = gridDim.x * gridDim.y * gridDim.z;
    unsigned sum, cnt, mine, sp = 0u;
    for (;;) {
        sum = 0u; cnt = 0u; mine = 0u;
#pragma unroll
        for (unsigned j = 0; j < 16; ++j) { const unsigned c = xb_ld(&bar[XB_XCNT(j)]); sum += c; cnt += (c > 0u) ? 1u : 0u; mine = (j == x) ? c : mine; }
        if (sum == G) break;
        __builtin_amdgcn_s_sleep(1);
        if ((++sp & 255u) == 0u) { if (xb_ld(&bar[XB_TMO])) break; if (sp > XB_SPIN_CAP) { atomicAdd(&bar[XB_TMO], 1u); break; } }
    }
    nloc = mine > 0u ? mine : 1u; nx = cnt > 0u ? cnt : 1u;
}

__device__ __forceinline__ void xcd_barrier(const XcdBarrier& b) {
    asm volatile("s_waitcnt vmcnt(0)" ::: "memory");
    __syncthreads();
    if (threadIdx.x == 0) {
        unsigned* bar = b.bar;
        __builtin_amdgcn_s_waitcnt(0);
        unsigned nloc = b.st[0], nx = b.st[1];
        if (nloc == 0u) { xcd_barrier_complete(bar, b.x, nloc, nx); b.st[0] = nloc; b.st[1] = nx; }
        const unsigned old = xb_add(&bar[XB_XSUB(b.x)], 1u);
        const unsigned gen = old / nloc;
        if (old + 1u == (gen + 1u) * nloc) {
            __builtin_amdgcn_fence(__ATOMIC_RELEASE, "agent");
            asm volatile("s_waitcnt vmcnt(0)" ::: "memory");
            const unsigned og = xb_add(&bar[XB_TOP], 1u);
            const unsigned tg = og / nx;
            if (og + 1u == (tg + 1u) * nx) xb_add(&bar[XB_TOPGEN], 1u);
            else XB_SPIN(xb_ld(&bar[XB_TOPGEN]) == tg, bar);
            __builtin_amdgcn_fence(__ATOMIC_ACQUIRE, "agent");
            xb_add(&bar[XB_XGEN(b.x)], 1u);
            asm volatile("s_waitcnt vmcnt(0)" ::: "memory");
        } else {
            XB_SPIN(xb_ld(&bar[XB_XGEN(b.x)]) == gen, bar);
            __builtin_amdgcn_fence(__ATOMIC_ACQUIRE, "agent");
            asm volatile("s_waitcnt vmcnt(0)" ::: "memory");
        }
    }
    __syncthreads();
}


constexpr int BK = 64;
constexpr int LDSROW = 144;
constexpr int TILE_BYTES = 256 * LDSROW;
constexpr int HALF_BYTES = 76800;
constexpr int SMEM_BYTES = 2 * HALF_BYTES;

struct R4 { uint4 a, b, c, d; };

struct RowLoader {
  const u16* base;
  long ld;
  DEV R4 load(int tid, int r0, int k0) const {
    const int tr = tid >> 3, tc = tid & 7;
    const u16* p = base + (long)(r0 + tr) * ld + k0 + tc * 8;
    R4 r;
    r.a = *(const uint4*)(p);
    r.b = *(const uint4*)(p + 64 * ld);
    r.c = *(const uint4*)(p + 128 * ld);
    r.d = *(const uint4*)(p + 192 * ld);
    return r;
  }
  DEV void store(int tid, char* lds, const R4& r) const {
    const int tr = tid >> 3, tc = tid & 7;
    char* q = lds + tr * LDSROW + tc * 16;
    *(uint4*)(q) = r.a;
    *(uint4*)(q + 64 * LDSROW) = r.b;
    *(uint4*)(q + 128 * LDSROW) = r.c;
    *(uint4*)(q + 192 * LDSROW) = r.d;
  }
};

DEV void st8t(char* q, const uint4& v) {
  *(u16*)(q + 0 * LDSROW) = (u16)(v.x & 0xffff);
  *(u16*)(q + 1 * LDSROW) = (u16)(v.x >> 16);
  *(u16*)(q + 2 * LDSROW) = (u16)(v.y & 0xffff);
  *(u16*)(q + 3 * LDSROW) = (u16)(v.y >> 16);
  *(u16*)(q + 4 * LDSROW) = (u16)(v.z & 0xffff);
  *(u16*)(q + 5 * LDSROW) = (u16)(v.z >> 16);
  *(u16*)(q + 6 * LDSROW) = (u16)(v.w & 0xffff);
  *(u16*)(q + 7 * LDSROW) = (u16)(v.w >> 16);
}

struct TransLoader {
  const u16* U;
  int L;
  DEV R4 load(int tid, int m0, int k0) const {
    const int b = m0 / L, t0 = m0 - b * L;
    const int k = k0 + (tid & 63), tg = tid >> 6;
    const u16* p = U + ((long)(b * 1536 + 1024 + k)) * L + t0 + tg * 8;
    R4 r;
    r.a = *(const uint4*)(p);
    r.b = *(const uint4*)(p + 64);
    r.c = *(const uint4*)(p + 128);
    r.d = *(const uint4*)(p + 192);
    return r;
  }
  DEV void store(int tid, char* lds, const R4& r) const {
    const int kl = tid & 63, tg = tid >> 6;
    char* q = lds + (tg * 8) * LDSROW + kl * 2;
    st8t(q, r.a);
    st8t(q + 64 * LDSROW, r.b);
    st8t(q + 128 * LDSROW, r.c);
    st8t(q + 192 * LDSROW, r.d);
  }
};

typedef f32x16 Acc[4][2];

template <class AL, class BL>
DEV void gemm_ktile(Acc& acc, const char* A, const char* B, int wm, int wn, int lr, int lh, const AL& al, const BL& bl,
                    int tid, int m0, int n0, int knext, char* nxt, R4& ra, R4& rb) {
  bf16x8 a[2][4], b[2][2];
  const char* pa = A + (wm + lr) * LDSROW + lh * 16;
  const char* pb = B + (wn + lr) * LDSROW + lh * 16;
#pragma unroll
  for (int i = 0; i < 4; ++i) a[0][i] = *(const bf16x8*)(pa + 32 * i * LDSROW);
#pragma unroll
  for (int j = 0; j < 2; ++j) b[0][j] = *(const bf16x8*)(pb + 32 * j * LDSROW);
#pragma unroll
  for (int ks = 0; ks < 4; ++ks) {
    const int cur = ks & 1, nx = cur ^ 1;
    if (ks < 3) {
#pragma unroll
      for (int i = 0; i < 4; ++i) a[nx][i] = *(const bf16x8*)(pa + 32 * i * LDSROW + (ks + 1) * 32);
#pragma unroll
      for (int j = 0; j < 2; ++j) b[nx][j] = *(const bf16x8*)(pb + 32 * j * LDSROW + (ks + 1) * 32);
    }
    __builtin_amdgcn_sched_barrier(0);
#pragma unroll
    for (int i = 0; i < 4; ++i)
#pragma unroll
      for (int j = 0; j < 2; ++j)
        acc[i][j] = __builtin_amdgcn_mfma_f32_32x32x16_bf16(a[cur][i], b[cur][j], acc[i][j], 0, 0, 0);
    __builtin_amdgcn_sched_barrier(0);
    if (ks == 1) {
      al.store(tid, nxt, ra);
      bl.store(tid, nxt + TILE_BYTES, rb);
      __builtin_amdgcn_sched_barrier(0);
      ra = al.load(tid, m0, knext);
      rb = bl.load(tid, n0, knext);
      __builtin_amdgcn_sched_barrier(0);
    }
  }
}

template <class AL, class BL>
DEV void gemm_mainloop(Acc& acc, const AL& al, const BL& bl, int m0, int n0, int kbeg, int kend, char* lds) {
  const int tid = tidx_full();
  const int wave = tid >> 6, lane = tid & 63;
  const int wm = (wave >> 2) * 128, wn = (wave & 3) * 64;
  const int lr = lane & 31, lh = lane >> 5;
  const int nk = (kend - kbeg) / BK;
  R4 a0 = al.load(tid, m0, kbeg);
  R4 b0 = bl.load(tid, n0, kbeg);
  __syncthreads();
  al.store(tid, lds, a0);
  bl.store(tid, lds + TILE_BYTES, b0);
  a0 = al.load(tid, m0, kbeg + BK);
  b0 = bl.load(tid, n0, kbeg + BK);
  __syncthreads();
  for (int kt = 0; kt < nk; ++kt) {
    const char* cur = lds + (kt & 1) * 2 * TILE_BYTES;
    char* nxt = lds + ((kt + 1) & 1) * 2 * TILE_BYTES;
    const int t2 = (kt + 2 < nk) ? kt + 2 : nk - 1;
    __builtin_amdgcn_sched_barrier(0);
    gemm_ktile(acc, cur, cur + TILE_BYTES, wm, wn, lr, lh, al, bl, tid, m0, n0, kbeg + t2 * BK, nxt, a0, b0);
    __builtin_amdgcn_sched_barrier(0);
    __syncthreads();
  }
}

struct GemmPipe {
  R4 ra, rb;
  bool primed;
};
template <class AL, class BL>
DEV void gemm_mainloop_p(Acc& acc, const AL& al, const BL& bl, int m0, int n0, int m0n, int n0n, int K, char* lds,
                         GemmPipe& gp) {
  const int tid = tidx_full();
  const int wave = tid >> 6, lane = tid & 63;
  const int wm = (wave >> 2) * 128, wn = (wave & 3) * 64;
  const int lr = lane & 31, lh = lane >> 5;
  const int nk = K / BK;
  if (!gp.primed) {
    gp.ra = al.load(tid, m0, 0);
    gp.rb = bl.load(tid, n0, 0);
    __syncthreads();
    al.store(tid, lds, gp.ra);
    bl.store(tid, lds + TILE_BYTES, gp.rb);
    gp.ra = al.load(tid, m0, BK);
    gp.rb = bl.load(tid, n0, BK);
    __syncthreads();
  }
  for (int kt = 0; kt < nk; ++kt) {
    const char* cur = lds + (kt & 1) * 2 * TILE_BYTES;
    char* nxt = lds + ((kt + 1) & 1) * 2 * TILE_BYTES;
    const bool wrap = (kt + 2 >= nk);
    const int kk = (wrap ? kt + 2 - nk : kt + 2) * BK;
    const int mr = wrap ? m0n : m0, nr = wrap ? n0n : n0;
    __builtin_amdgcn_sched_barrier(0);
    gemm_ktile(acc, cur, cur + TILE_BYTES, wm, wn, lr, lh, al, bl, tid, mr, nr, kk, nxt, gp.ra, gp.rb);
    __builtin_amdgcn_sched_barrier(0);
    __syncthreads();
  }
}

DEV void acc_zero(Acc& acc) {
#pragma unroll
  for (int i = 0; i < 4; ++i)
#pragma unroll
    for (int j = 0; j < 2; ++j)
#pragma unroll
      for (int r = 0; r < 16; ++r) acc[i][j][r] = 0.f;
}

template <class F>
DEV void acc_foreach(Acc& acc, int m0, int n0, F f) {
  asm volatile("s_nop 7\n\ts_nop 7\n\ts_nop 3" ::: "memory");
  const int tid = tidx_full();
  const int wave = tid >> 6, lane = tid & 63;
  const int wm = (wave >> 2) * 128, wn = (wave & 3) * 64;
  const int lr = lane & 31, lh = lane >> 5;
#pragma unroll
  for (int i = 0; i < 4; ++i)
#pragma unroll
    for (int j = 0; j < 2; ++j)
#pragma unroll
      for (int r = 0; r < 16; ++r) {
        const int m = m0 + wm + 32 * i + (r & 3) + 8 * (r >> 2) + 4 * lh;
        const int n = n0 + wn + 32 * j + lr;
        float v = acc[i][j][r];
        f(m, n, v);
        acc[i][j][r] = v;
      }
}

DEV bool tile_map(int iter, int ntm, int ntn, int& mt, int& nt) {
  int PM = 0, PN = 0;
  if (ntn == 18) { PM = 16; PN = 2; }
  else if (ntn == 128) { PM = 2; PN = 16; }
  else if (ntn == 16 || ntn == 4) { PM = 8; PN = 4; }
  if (gridDim.x == 256 && PM > 0 && (ntm % PM) == 0) {
    const int xcd = blockIdx.x & 7, slot = blockIdx.x >> 3;
    const int nsn = ntn / PN, nsuper = (ntm / PM) * nsn;
    const int s_ = iter * 8 + xcd;
    if (s_ >= nsuper) return false;
    const int sm = s_ / nsn, sn = s_ - sm * nsn;
    mt = sm * PM + slot / PN;
    nt = sn * PN + slot % PN;
    return true;
  }
  const int tile = blockIdx.x + iter * gridDim.x;
  if (tile >= ntm * ntn) return false;
  mt = tile / ntn;
  nt = tile - mt * ntn;
  return true;
}

DEV void prep_transpose_tile(const float* __restrict__ W, int K, int N, u16* __restrict__ WT, int tile, char* smem) {
  u16(*T)[66] = (u16(*)[66])smem;
  const int ntn = N / 64;
  const int k0 = (tile / ntn) * 64, n0 = (tile % ntn) * 64;
  const int tid = tidx();
  const int kr = tid >> 4, nc = (tid & 15) * 4;
  __syncthreads();
#pragma unroll
  for (int i = 0; i < 4; ++i) {
    const int k = kr + 16 * i;
    const float4 v = *(const float4*)(W + (long)(k0 + k) * N + n0 + nc);
    T[nc + 0][k] = f2bf(v.x);
    T[nc + 1][k] = f2bf(v.y);
    T[nc + 2][k] = f2bf(v.z);
    T[nc + 3][k] = f2bf(v.w);
  }
  __syncthreads();
  const int n = tid >> 2, kc = (tid & 3) * 16;
  unsigned o[8];
#pragma unroll
  for (int i = 0; i < 8; ++i) o[i] = (unsigned)T[n][kc + 2 * i] | ((unsigned)T[n][kc + 2 * i + 1] << 16);
  uint4* dst = (uint4*)(WT + (long)(n0 + n) * K + k0 + kc);
  dst[0] = make_uint4(o[0], o[1], o[2], o[3]);
  dst[1] = make_uint4(o[4], o[5], o[6], o[7]);
}

DEV void prep_mod_item(const Params& p, int item, char* smem) {
  float* sc = (float*)smem;
  float* red = (float*)(smem + 12 * 1024 * 4);
  __syncthreads();
  const int tid = tidx();
  for (int e = tid; e < 12 * 1024; e += 256) {
    const int b = e >> 10, k = e & 1023;
    const float c = (b < 8) ? p.in[I_CP][b * 1024 + k] : p.in[I_CS][(b - 8) * 1024 + k];
    sc[e] = silu_f(c);
  }
  __syncthreads();
  const int col = tid & 31, kg = tid >> 5;
  const int j = item * 32 + col;
  float acc[12];
#pragma unroll
  for (int b = 0; b < 12; ++b) acc[b] = 0.f;
  const float* W = p.in[I_ADAW];
#pragma unroll 8
  for (int kk = 0; kk < 128; ++kk) {
    const int k = kg * 128 + kk;
    const float w = W[(long)k * DIN + j];
#pragma unroll
    for (int b = 0; b < 12; ++b) acc[b] += sc[b * 1024 + k] * w;
  }
#pragma unroll
  for (int b = 0; b < 12; ++b) red[(kg * 12 + b) * 32 + col] = acc[b];
  __syncthreads();
  for (int e = tid; e < 12 * 32; e += 256) {
    const int b = e >> 5, c = e & 31;
    float s = p.in[I_ADAB][item * 32 + c];
#pragma unroll
    for (int g = 0; g < 8; ++g) s += red[(g * 12 + b) * 32 + c];
    ((float*)(p.ws + OFF_MOD))[b * DIN + item * 32 + c] = s;
  }
}

DEV void phase_prep(const Params& p, char* smem) {
  if (blockIdx.x == 0 && threadIdx.x < 64) ((unsigned*)(p.ws + OFF_CNT))[threadIdx.x] = 0u;
  for (int it = VBID; it < 4096 + 192; it += NVB) {
    if (it < 1536) prep_transpose_tile(p.in[I_WIN], 1024, 6144, (u16*)(p.ws + OFF_WIN), it, smem);
    else if (it < 1792) prep_transpose_tile(p.in[I_WBR], 1024, 1024, (u16*)(p.ws + OFF_WBR), it - 1536, smem);
    else if (it < 2048) prep_transpose_tile(p.in[I_WOUT], 1024, 1024, (u16*)(p.ws + OFF_WOUT), it - 1792, smem);
    else if (it < 3072) prep_transpose_tile(p.in[I_WFF1], 1024, 4096, (u16*)(p.ws + OFF_WFF1), it - 2048, smem);
    else if (it < 4096) prep_transpose_tile(p.in[I_WFF2], 4096, 1024, (u16*)(p.ws + OFF_WFF2), it - 3072, smem);
    else prep_mod_item(p, it - 4096, smem);
  }
}

DEV void phase_filter_mlp(const Params& p, char* smem) {
  float* z = (float*)smem;
  float* h1 = z + 4 * 36;
  float* h2 = h1 + 256;
  float* h3 = h2 + 256;
  const float* w1 = p.in[I_FW1];
  const float* b1 = p.in[I_FB1];
  const float* w2 = p.in[I_FW2];
  const float* b2 = p.in[I_FB2];
  const float* w3 = p.in[I_FW3];
  const float* b3 = p.in[I_FB3];
  const float* wo = p.in[I_FWO];
  const float* fr = p.in[I_FFREQ];
  float* hraw = (float*)(p.ws + OFF_HRAW);
  float* part = (float*)(p.ws + OFF_PART);
  const int tid = tidx();
  for (int it = VBID; it < 768; it += NVB) {
    const int g = (it < 256) ? 0 : 1;
    const int L = g ? 8192 : 4096;
    const int tbase = (g ? (it - 256) : it) * 16;
    const long rowbase = g ? 4096 : 0;
    float psum[4] = {0.f, 0.f, 0.f, 0.f};
    for (int rnd = 0; rnd < 4; ++rnd) {
      const int t0 = tbase + rnd * 4;
      __syncthreads();
      if (tid < 4 * 33) {
        const int pp = tid / 33, f = tid % 33;
        const int t = t0 + pp;
        float val;
        if (f == 0) val = (float)t / (float)(L - 1);
        else {
          const int j = (f - 1) & 15;
          const float fb = 1e-4f + (float)j * ((15.0f - 1e-4f) / 15.0f);
          const float w = 6.283185307179586f * (float)t / (float)L;
          val = (f <= 16) ? cosf(fb * w) : -sinf(fb * w);
        }
        z[pp * 36 + f] = val;
      }
      __syncthreads();
      const int pp = tid >> 6, u = tid & 63;
      {
        float s = b1[u];
        for (int k = 0; k < 33; ++k) s += z[pp * 36 + k] * w1[k * 64 + u];
        h1[pp * 64 + u] = sinf(fr[u] * s);
      }
      __syncthreads();
      {
        float s = b2[u];
        for (int k = 0; k < 64; ++k) s += h1[pp * 64 + k] * w2[k * 64 + u];
        h2[pp * 64 + u] = sinf(fr[64 + u] * s);
      }
      __syncthreads();
      {
        float s = b3[u];
        for (int k = 0; k < 64; ++k) s += h2[pp * 64 + k] * w3[k * 64 + u];
        h3[pp * 64 + u] = sinf(fr[128 + u] * s);
      }
      __syncthreads();
      float acc[4][4];
#pragma unroll
      for (int a = 0; a < 4; ++a)
#pragma unroll
        for (int q = 0; q < 4; ++q) acc[a][q] = 0.f;
#pragma unroll 4
      for (int k = 0; k < 64; ++k) {
        float wv[4];
#pragma unroll
        for (int q = 0; q < 4; ++q) wv[q] = wo[k * 1024 + tid + 256 * q];
#pragma unroll
        for (int a = 0; a < 4; ++a) {
          const float hv = h3[a * 64 + k];
#pragma unroll
          for (int q = 0; q < 4; ++q) acc[a][q] += hv * wv[q];
        }
      }
#pragma unroll
      for (int q = 0; q < 4; ++q) {
        const int c = tid + 256 * q;
        const int ch = c & 511;
        const float mind = -3.0701134573253943f, maxd = -15.350567286626972f;
        const float delta = fabsf(mind + (float)ch * ((maxd - mind) / 511.0f));
#pragma unroll
        for (int a = 0; a < 4; ++a) {
          const int t = t0 + a;
          const float tt = (float)t / (float)(L - 1);
          const float val = acc[a][q] * __expf(-tt * delta);
          hraw[(rowbase + t) * 1024 + c] = val;
          if (!(c >= 512 && t == 0)) psum[q] += fabsf(val);
        }
      }
    }
#pragma unroll
    for (int q = 0; q < 4; ++q) part[(long)it * 1024 + tid + 256 * q] = psum[q];
  }
}

DEV void phase_filter_norm(const Params& p, char* smem) {
  float* Tf = (float*)smem;
  float* Tb = Tf + 64 * 65;
  float* red = Tb + 64 * 65;
  float* nrm = red + 256;
  const float* hraw = (const float*)(p.ws + OFF_HRAW);
  const float* part = (const float*)(p.ws + OFF_PART);
  const int tid = tidx();
  for (int it = VBID; it < 512 + 1024; it += NVB) {
    const int g = (it < 512) ? 0 : 1;
    const int L = g ? 8192 : 4096;
    const int li = g ? it - 512 : it;
    const int ntt = L / 64;
    const int ct = li / ntt, tt = li % ntt;
    const long rowbase = g ? 4096 : 0;
    const int prow0 = g ? 256 : 0, nprow = g ? 512 : 256;
    u16* KK = (u16*)(p.ws + OFF_KK) + (g ? (size_t)512 * 8192 : 0);
    __syncthreads();
    {
      const int c = tid & 63, ph = tid >> 6;
      float s = 0.f;
#pragma unroll 8
      for (int r = ph; r < nprow; r += 4) {
        s += part[(long)(prow0 + r) * 1024 + ct * 64 + c];
        s += part[(long)(prow0 + r) * 1024 + 512 + ct * 64 + c];
      }
      red[ph * 64 + c] = s;
#pragma unroll
      for (int i = 0; i < 16; ++i) {
        const int r = ph + 4 * i;
        const long row = rowbase + tt * 64 + r;
        Tf[c * 65 + r] = hraw[row * 1024 + ct * 64 + c];
        Tb[c * 65 + r] = hraw[row * 1024 + 512 + ct * 64 + c];
      }
    }
    __syncthreads();
    if (tid < 64) nrm[tid] = red[tid] + red[64 + tid] + red[128 + tid] + red[192 + tid] + EPSF;
    __syncthreads();
    {
      const int c = tid >> 2, rq = (tid & 3) * 16;
      const float inv = 1.f / nrm[c];
      u16* row = KK + (size_t)(ct * 64 + c) * (2 * L);
#pragma unroll
      for (int i = 0; i < 16; ++i) {
        const int r = rq + i;
        const int t = tt * 64 + r;
        row[L - t] = f2bf(Tf[c * 65 + r] * inv);
        if (t >= 1) row[L + t] = f2bf(Tb[c * 65 + r] * inv);
      }
      if (tt == 0 && (tid & 3) == 0) row[0] = 0;
    }
  }
}

DEV void phase_norm_adaln(const float* __restrict__ X, const float* __restrict__ gvec, const float* __restrict__ mod,
                          int bg0, int L, int sh_off, int sc_off, u16* __restrict__ H) {
  const int tid = tidx();
  const int wave = tid >> 6, lane = tid & 63;
  constexpr int RB = 4;
  const int stride = NVB * 4;
  for (int row0 = VBID * 4 + wave; row0 < NTOK; row0 += stride * RB) {
    float4 v[RB][4];
    float ss[RB];
#pragma unroll
    for (int j = 0; j < RB; ++j) {
      const int row = row0 + j * stride;
      const float* x = X + (long)(row < NTOK ? row : row0) * D;
#pragma unroll
      for (int i = 0; i < 4; ++i) v[j][i] = *(const float4*)(x + lane * 4 + 256 * i);
    }
#pragma unroll
    for (int j = 0; j < RB; ++j) {
      float t = 0.f;
#pragma unroll
      for (int i = 0; i < 4; ++i) t += v[j][i].x * v[j][i].x + v[j][i].y * v[j][i].y + v[j][i].z * v[j][i].z + v[j][i].w * v[j][i].w;
      ss[j] = wave_sum(t);
    }
#pragma unroll
    for (int j = 0; j < RB; ++j) {
      const int row = row0 + j * stride;
      if (row < NTOK) {
        const float rstd = rsqrtf(ss[j] * (1.f / 1024.f) + EPSF);
        const float* mrow = mod + (long)(bg0 + row / L) * DIN;
#pragma unroll
        for (int i = 0; i < 4; ++i) {
          const int k = lane * 4 + 256 * i;
          const float4 g = *(const float4*)(gvec + k);
          const float4 sc = *(const float4*)(mrow + sc_off + k);
          const float4 sh = *(const float4*)(mrow + sh_off + k);
          const float o0 = v[j][i].x * rstd * g.x * (1.f + sc.x) + sh.x;
          const float o1 = v[j][i].y * rstd * g.y * (1.f + sc.y) + sh.y;
          const float o2 = v[j][i].z * rstd * g.z * (1.f + sc.z) + sh.z;
          const float o3 = v[j][i].w * rstd * g.w * (1.f + sc.w) + sh.w;
          *(uint2*)(H + (long)row * D + k) = make_uint2(pack2(o0, o1), pack2(o2, o3));
        }
      }
    }
  }
}

DEV void phase_final_norm(float* __restrict__ X, const float* __restrict__ gvec) {
  const int tid = tidx();
  const int wave = tid >> 6, lane = tid & 63;
  constexpr int RB = 4;
  const int stride = NVB * 4;
  for (int row0 = VBID * 4 + wave; row0 < NTOK; row0 += stride * RB) {
    float4 v[RB][4];
    float ss[RB];
#pragma unroll
    for (int j = 0; j < RB; ++j) {
      const int row = row0 + j * stride;
      const float* x = X + (long)(row < NTOK ? row : row0) * D;
#pragma unroll
      for (int i = 0; i < 4; ++i) v[j][i] = *(const float4*)(x + lane * 4 + 256 * i);
    }
#pragma unroll
    for (int j = 0; j < RB; ++j) {
      float t = 0.f;
#pragma unroll
      for (int i = 0; i < 4; ++i) t += v[j][i].x * v[j][i].x + v[j][i].y * v[j][i].y + v[j][i].z * v[j][i].z + v[j][i].w * v[j][i].w;
      ss[j] = wave_sum(t);
    }
#pragma unroll
    for (int j = 0; j < RB; ++j) {
      const int row = row0 + j * stride;
      if (row < NTOK) {
        const float rstd = rsqrtf(ss[j] * (1.f / 1024.f) + EPSF);
        float* x = X + (long)row * D;
#pragma unroll
        for (int i = 0; i < 4; ++i) {
          const int k = lane * 4 + 256 * i;
          const float4 g = *(const float4*)(gvec + k);
          *(float4*)(x + k) = make_float4(v[j][i].x * rstd * g.x, v[j][i].y * rstd * g.y, v[j][i].z * rstd * g.z, v[j][i].w * rstd * g.w);
        }
      }
    }
  }
}

DEV void norm_adaln_rows(const float* __restrict__ X, const float* __restrict__ gvec, const float* __restrict__ mod,
                         int bg0, int L, int sh_off, int sc_off, u16* __restrict__ H, int rbeg) {
  const int tid = tidx();
  const int wave = tid >> 6, lane = tid & 63;
  for (int jb = 0; jb < 16; jb += 4) {
    float4 v[4][4];
    float ss[4];
#pragma unroll
    for (int j = 0; j < 4; ++j) {
      const float* x = X + (long)(rbeg + wave + 4 * (jb + j)) * D;
#pragma unroll
      for (int i = 0; i < 4; ++i) v[j][i] = *(const float4*)(x + lane * 4 + 256 * i);
    }
#pragma unroll
    for (int j = 0; j < 4; ++j) {
      float t = 0.f;
#pragma unroll
      for (int i = 0; i < 4; ++i) t += v[j][i].x * v[j][i].x + v[j][i].y * v[j][i].y + v[j][i].z * v[j][i].z + v[j][i].w * v[j][i].w;
      ss[j] = wave_sum(t);
    }
#pragma unroll
    for (int j = 0; j < 4; ++j) {
      const int row = rbeg + wave + 4 * (jb + j);
      const float rstd = rsqrtf(ss[j] * (1.f / 1024.f) + EPSF);
      const float* mrow = mod + (long)(bg0 + row / L) * DIN;
#pragma unroll
      for (int i = 0; i < 4; ++i) {
        const int k = lane * 4 + 256 * i;
        const float4 g = *(const float4*)(gvec + k);
        const float4 sc = *(const float4*)(mrow + sc_off + k);
        const float4 sh = *(const float4*)(mrow + sh_off + k);
        const float o0 = v[j][i].x * rstd * g.x * (1.f + sc.x) + sh.x;
        const float o1 = v[j][i].y * rstd * g.y * (1.f + sc.y) + sh.y;
        const float o2 = v[j][i].z * rstd * g.z * (1.f + sc.z) + sh.z;
        const float o3 = v[j][i].w * rstd * g.w * (1.f + sc.w) + sh.w;
        *(uint2*)(H + (long)row * D + k) = make_uint2(pack2(o0, o1), pack2(o2, o3));
      }
    }
  }
}

DEV void final_norm_rows(float* __restrict__ X, const float* __restrict__ gvec, int rbeg) {
  const int tid = tidx();
  const int wave = tid >> 6, lane = tid & 63;
  for (int jb = 0; jb < 16; jb += 4) {
    float4 v[4][4];
    float ss[4];
#pragma unroll
    for (int j = 0; j < 4; ++j) {
      const float* x = X + (long)(rbeg + wave + 4 * (jb + j)) * D;
#pragma unroll
      for (int i = 0; i < 4; ++i) v[j][i] = *(const float4*)(x + lane * 4 + 256 * i);
    }
#pragma unroll
    for (int j = 0; j < 4; ++j) {
      float t = 0.f;
#pragma unroll
      for (int i = 0; i < 4; ++i) t += v[j][i].x * v[j][i].x + v[j][i].y * v[j][i].y + v[j][i].z * v[j][i].z + v[j][i].w * v[j][i].w;
      ss[j] = wave_sum(t);
    }
#pragma unroll
    for (int j = 0; j < 4; ++j) {
      float* x = X + (long)(rbeg + wave + 4 * (jb + j)) * D;
      const float rstd = rsqrtf(ss[j] * (1.f / 1024.f) + EPSF);
#pragma unroll
      for (int i = 0; i < 4; ++i) {
        const int k = lane * 4 + 256 * i;
        const float4 g = *(const float4*)(gvec + k);
        *(float4*)(x + k) = make_float4(v[j][i].x * rstd * g.x, v[j][i].y * rstd * g.y, v[j][i].z * rstd * g.z, v[j][i].w * rstd * g.w);
      }
    }
  }
}

DEV void phase_p1(const Params& p, int g, char* smem) {
  const int L = g ? 8192 : 4096;
  const u16* H = (const u16*)(p.out + (size_t)g * NTOK * D);
  const u16* WinT = (const u16*)(p.ws + OFF_WIN);
  u16* PHG = (u16*)(p.ws + OFF_PHG);
  u16* GT = (u16*)(p.ws + OFF_GT);
  u16* UHY = (u16*)(p.ws + OFF_UHY);
  {
    GemmPipe gp;
    gp.primed = false;
    for (int iter = 0;; ++iter) {
      int mt, nt, mtn, ntn;
      if (!tile_map(iter, 128, 18, mt, nt)) break;
      const bool more = tile_map(iter + 1, 128, 18, mtn, ntn);
      if (!more) { mtn = mt; ntn = nt; }
      Acc acc;
      acc_zero(acc);
      const int m0 = mt * 256, n0 = nt * 256;
      RowLoader al{H, 1024}, bl{WinT + (size_t)1536 * 1024, 1024};
      gemm_mainloop_p(acc, al, bl, m0, n0, mtn * 256, ntn * 256, 1024, smem, gp);
      gp.primed = more;
      if (n0 < 2560) {
        const bool dosilu = (n0 < 512) || (n0 >= 2048);
        acc_foreach(acc, m0, n0, [&](int m, int n, float& v) {
          const float o = dosilu ? silu_f(v) : v;
          PHG[(size_t)m * 2560 + n] = f2bf(o);
        });
      } else {
        acc_foreach(acc, m0, n0, [&](int m, int n, float& v) { GT[(size_t)m * 2048 + (n - 2560)] = f2bf(sigmoid_f(v)); });
      }
    }
  }
  {
    GemmPipe gp;
    gp.primed = false;
    for (int iter = 0;; ++iter) {
      int cm, tn, cmn, tnn;
      if (!tile_map(iter, 6, 128, cm, tn)) break;
      const bool more = tile_map(iter + 1, 6, 128, cmn, tnn);
      if (!more) { cmn = cm; tnn = tn; }
      Acc acc;
      acc_zero(acc);
      const int m0 = cm * 256, n0 = tn * 256;
      RowLoader al{WinT, 1024}, bl{H, 1024};
      gemm_mainloop_p(acc, al, bl, m0, n0, cmn * 256, tnn * 256, 1024, smem, gp);
      gp.primed = more;
      const int b = n0 / L, tb = n0 - b * L;
      u16* dst = UHY + (size_t)b * 1536 * L + tb - n0;
      acc_foreach(acc, m0, n0, [&](int m, int n, float& v) { dst[(size_t)m * L + n] = f2bf(v); });
    }
  }
}

DEV void phase_p15(const Params& p, int g) {
  const u16* PHG = (const u16*)(p.ws + OFF_PHG);
  u16* QK = (u16*)(p.out + (size_t)g * NTOK * D);
  u16* KT = (u16*)(p.ws + OFF_KT);
  float* DEC = (float*)(p.ws + OFF_DEC);
  for (int it = VBID; it < 1024; it += NVB) {
    const int tid = tidx();
    const int cidx = it >> 1, dir = it & 1;
    u16* Qp = QK + (size_t)(2 * dir) * NTOK * 512;
    u16* Kp = Qp + (size_t)NTOK * 512;
    float lb[2], G[2];
#pragma unroll
    for (int cc = 0; cc < 2; ++cc) {
      const int c = tid + 256 * cc;
      const float a0 = p.in[I_LB][(0 * 2 + dir) * 512 + c];
      const float a1 = p.in[I_LB][(1 * 2 + dir) * 512 + c];
      lb[cc] = 1.f / (1.f + __expf(a1 - a0));
      G[cc] = 0.f;
    }
    u16 xr[3][2][8], qr[3][2][8];
#define P15_LOAD(st_, j8_)                                                          \
    _Pragma("unroll") for (int e = 0; e < 8; ++e) {                                 \
      const int jj = (j8_) * 8 + e;                                                 \
      const int j = dir ? 63 - jj : jj;                                             \
      const size_t tok = (size_t)cidx * 64 + j;                                     \
      _Pragma("unroll") for (int cc = 0; cc < 2; ++cc) {                            \
        xr[st_][cc][e] = PHG[tok * 2560 + 1024 + 512 * dir + tid + 256 * cc];       \
        qr[st_][cc][e] = PHG[tok * 2560 + tid + 256 * cc];                          \
      }                                                                             \
    }
    P15_LOAD(0, 0);
    P15_LOAD(1, 1);
#pragma unroll
    for (int j8 = 0; j8 < 8; ++j8) {
      const int st = j8 % 3;
      if (j8 < 6) { P15_LOAD((j8 + 2) % 3, j8 + 2); }
#pragma unroll
      for (int cc = 0; cc < 2; ++cc) {
        const int c = tid + 256 * cc;
        unsigned kb[8];
#pragma unroll
        for (int e = 0; e < 8; ++e) {
          const int jj = j8 * 8 + e;
          const int j = dir ? 63 - jj : jj;
          const size_t tok = (size_t)cidx * 64 + j;
          const float f = lb[cc] + (1.f - lb[cc]) * sigmoid_f(bf2f(xr[st][cc][e]));
          G[cc] += __logf(f);
          const float eg = __expf(G[cc]), ig = __expf(-G[cc]);
          Qp[tok * 512 + c] = f2bf(bf2f(qr[st][cc][e]) * eg);
          const u16 kk = f2bf((1.f - f) * ig);
          Kp[tok * 512 + c] = kk;
          kb[e] = kk;
        }
        const int s0 = dir ? 56 - 8 * j8 : 8 * j8;
        uint4 w;
        w.x = dir ? (kb[7] | (kb[6] << 16)) : (kb[0] | (kb[1] << 16));
        w.y = dir ? (kb[5] | (kb[4] << 16)) : (kb[2] | (kb[3] << 16));
        w.z = dir ? (kb[3] | (kb[2] << 16)) : (kb[4] | (kb[5] << 16));
        w.w = dir ? (kb[1] | (kb[0] << 16)) : (kb[6] | (kb[7] << 16));
        *(uint4*)(KT + (((size_t)cidx * 2 + dir) * 512 + c) * 64 + s0) = w;
      }
    }
#undef P15_LOAD
#pragma unroll
    for (int cc = 0; cc < 2; ++cc) DEC[((size_t)dir * 512 + cidx) * 512 + tid + 256 * cc] = __expf(G[cc]);
  }
}

DEV void scan_item_mfma(const Params& p, int g, int item, char* smem) {
  const int L = g ? 8192 : 4096;
  const int NC = L / 64;
  const int vs = item & 3, dir = (item >> 2) & 1, h = (item >> 3) & 3, b = item >> 5;
  char* Qs = smem;
  char* Ks = Qs + 17408;
  char* KTs = Ks + 17408;
  char* Vts = KTs + 18432;
  char* Ps = Vts + 4608;
  char* Sts = Ps + 9216;
  float* decs = (float*)(Sts + 8704);
  u16* PHG = (u16*)(p.ws + OFF_PHG);
  const u16* QK = (const u16*)(p.out + (size_t)g * NTOK * D);
  const u16* Qp = QK + (size_t)(2 * dir) * NTOK * 512;
  const u16* Kp = Qp + (size_t)NTOK * 512;
  const u16* KT = (const u16*)(p.ws + OFF_KT);
  const float* DEC = (const float*)(p.ws + OFF_DEC);
  const int tid = tidx();
  const int wave = __builtin_amdgcn_readfirstlane(tid >> 6);
  const int lane = tid & 63, r = lane & 31, hh = lane >> 5;
  __syncthreads();
  for (int e = tid; e < 8704 / 16; e += 256) ((uint4*)Sts)[e] = make_uint4(0, 0, 0, 0);
  f32x16 accS[2];
#pragma unroll
  for (int t = 0; t < 2; ++t)
#pragma unroll
    for (int i = 0; i < 16; ++i) accS[t][i] = 0.f;
  const int ocol = (dir ? 1024 : 0) + h * 128 + vs * 32;

  uint4 q0, q1, q2, q3, k0, k1, k2, k3, t0, t1, t2, t3, vv;
  float dd = 0.f;
  const int qrow = tid >> 4, qc = tid & 15;
  const int trow = tid >> 3, tc = tid & 7;
  const int vrow = tid >> 2, vc = tid & 3;
#define SCAN_ISSUE(n_)                                                                                   \
  {                                                                                                      \
    const size_t cidx_ = (size_t)b * NC + (n_);                                                          \
    const size_t tok_ = cidx_ * 64;                                                                      \
    const u16* gq = Qp + (tok_ + qrow) * 512 + h * 128 + qc * 8;                                         \
    const u16* gk = Kp + (tok_ + qrow) * 512 + h * 128 + qc * 8;                                         \
    q0 = *(const uint4*)(gq); q1 = *(const uint4*)(gq + 16 * 512);                                       \
    q2 = *(const uint4*)(gq + 32 * 512); q3 = *(const uint4*)(gq + 48 * 512);                            \
    k0 = *(const uint4*)(gk); k1 = *(const uint4*)(gk + 16 * 512);                                       \
    k2 = *(const uint4*)(gk + 32 * 512); k3 = *(const uint4*)(gk + 48 * 512);                            \
    const u16* gt = KT + ((cidx_ * 2 + dir) * 512 + h * 128 + trow) * 64 + tc * 8;                       \
    t0 = *(const uint4*)(gt); t1 = *(const uint4*)(gt + 32 * 64);                                        \
    t2 = *(const uint4*)(gt + 64 * 64); t3 = *(const uint4*)(gt + 96 * 64);                              \
    vv = *(const uint4*)(PHG + (tok_ + vrow) * 2560 + 512 + h * 128 + vs * 32 + vc * 8);                 \
    dd = DEC[((size_t)dir * 512 + cidx_) * 512 + h * 128 + (tid & 127)];                                 \
  }
#define SCAN_BAR()                                        \
  {                                                       \
    asm volatile("s_waitcnt lgkmcnt(0)" ::: "memory");     \
    __builtin_amdgcn_s_barrier();                         \
    asm volatile("" ::: "memory");                         \
  }
  unsigned opk[8] = {0u, 0u, 0u, 0u, 0u, 0u, 0u, 0u};
  size_t otok = 0;
  SCAN_ISSUE(dir ? NC - 1 : 0);
  for (int ci = 0; ci < NC; ++ci) {
    const int n = dir ? NC - 1 - ci : ci;
    const size_t tok0 = ((size_t)b * NC + n) * 64;
    {
      char* d = Qs + qrow * 272 + qc * 16;
      *(uint4*)(d) = q0; *(uint4*)(d + 16 * 272) = q1; *(uint4*)(d + 32 * 272) = q2; *(uint4*)(d + 48 * 272) = q3;
      d = Ks + qrow * 272 + qc * 16;
      *(uint4*)(d) = k0; *(uint4*)(d + 16 * 272) = k1; *(uint4*)(d + 32 * 272) = k2; *(uint4*)(d + 48 * 272) = k3;
      d = KTs + trow * 144 + tc * 16;
      *(uint4*)(d) = t0; *(uint4*)(d + 32 * 144) = t1; *(uint4*)(d + 64 * 144) = t2; *(uint4*)(d + 96 * 144) = t3;
      st8t(Vts + (vc * 8) * 144 + vrow * 2, vv);
      if (tid < 128) decs[tid] = dd;
      if (wave < 2 && ci > 0) {
        u16* og = PHG + (otok + 32 * wave + 4 * hh) * 2560 + ocol + r;
#pragma unroll
        for (int i = 0; i < 8; ++i) {
          og[(size_t)(((2 * i) & 3) + 8 * ((2 * i) >> 2)) * 2560] = (u16)(opk[i] & 0xffffu);
          og[(size_t)(((2 * i + 1) & 3) + 8 * ((2 * i + 1) >> 2)) * 2560] = (u16)(opk[i] >> 16);
        }
      }
      if (wave >= 2 && ci > 0) {
#pragma unroll
        for (int t = 0; t < 2; ++t) {
          const int kt = 2 * (wave - 2) + t;
#pragma unroll
          for (int rg = 0; rg < 4; ++rg) {
            const int kk0 = 32 * kt + 8 * rg + 4 * hh;
            *(uint2*)(Sts + r * 272 + kk0 * 2) = make_uint2(pack2(accS[t][4 * rg + 0], accS[t][4 * rg + 1]),
                                                            pack2(accS[t][4 * rg + 2], accS[t][4 * rg + 3]));
          }
        }
      }
    }
    SCAN_BAR();
    {
      const int nn = (ci + 1 < NC) ? (dir ? NC - 2 - ci : ci + 1) : n;
      SCAN_ISSUE(nn);
    }
    __builtin_amdgcn_sched_barrier(0);
    {
      const int jt = wave >> 1, st = wave & 1;
      const bool active = dir ? (st >= jt) : (st <= jt);
      f32x16 pa;
#pragma unroll
      for (int i = 0; i < 16; ++i) pa[i] = 0.f;
      if (active) {
        bf16x8 qa[8], kb[8];
#pragma unroll
        for (int ks = 0; ks < 8; ++ks) {
          qa[ks] = *(const bf16x8*)(Qs + (32 * jt + r) * 272 + ks * 32 + hh * 16);
          kb[ks] = *(const bf16x8*)(Ks + (32 * st + r) * 272 + ks * 32 + hh * 16);
        }
        __builtin_amdgcn_sched_barrier(0);
        f32x16 p1;
#pragma unroll
        for (int i = 0; i < 16; ++i) p1[i] = 0.f;
#pragma unroll
        for (int ks = 0; ks < 4; ++ks) {
          pa = __builtin_amdgcn_mfma_f32_32x32x16_bf16(qa[2 * ks], kb[2 * ks], pa, 0, 0, 0);
          p1 = __builtin_amdgcn_mfma_f32_32x32x16_bf16(qa[2 * ks + 1], kb[2 * ks + 1], p1, 0, 0, 0);
        }
#pragma unroll
        for (int i = 0; i < 16; ++i) pa[i] += p1[i];
      }
#pragma unroll
      for (int i = 0; i < 16; ++i) {
        const int j = 32 * jt + (i & 3) + 8 * (i >> 2) + 4 * hh;
        const int s_ = 32 * st + r;
        const bool keep = dir ? (s_ >= j) : (s_ <= j);
        *(u16*)(Ps + j * 144 + s_ * 2) = keep ? f2bf(pa[i]) : (u16)0;
      }
    }
    SCAN_BAR();
    if (wave < 2) {
      const int jt = wave;
      bf16x8 pp[4], vb[4], qa[4], sb[4];
#pragma unroll
      for (int ks = 0; ks < 4; ++ks) {
        pp[ks] = *(const bf16x8*)(Ps + (32 * jt + r) * 144 + ks * 32 + hh * 16);
        vb[ks] = *(const bf16x8*)(Vts + r * 144 + ks * 32 + hh * 16);
        qa[ks] = *(const bf16x8*)(Qs + (32 * jt + r) * 272 + ks * 32 + hh * 16);
        sb[ks] = *(const bf16x8*)(Sts + r * 272 + ks * 32 + hh * 16);
      }
      __builtin_amdgcn_sched_barrier(0);
      f32x16 o, o1;
#pragma unroll
      for (int i = 0; i < 16; ++i) { o[i] = 0.f; o1[i] = 0.f; }
#pragma unroll
      for (int ks = 0; ks < 4; ++ks) {
        o = __builtin_amdgcn_mfma_f32_32x32x16_bf16(pp[ks], vb[ks], o, 0, 0, 0);
        o1 = __builtin_amdgcn_mfma_f32_32x32x16_bf16(qa[ks], sb[ks], o1, 0, 0, 0);
      }
      __builtin_amdgcn_sched_barrier(0);
#pragma unroll
      for (int ks = 0; ks < 4; ++ks) {
        qa[ks] = *(const bf16x8*)(Qs + (32 * jt + r) * 272 + (ks + 4) * 32 + hh * 16);
        sb[ks] = *(const bf16x8*)(Sts + r * 272 + (ks + 4) * 32 + hh * 16);
      }
      __builtin_amdgcn_sched_barrier(0);
      o = __builtin_amdgcn_mfma_f32_32x32x16_bf16(qa[0], sb[0], o, 0, 0, 0);
      o1 = __builtin_amdgcn_mfma_f32_32x32x16_bf16(qa[1], sb[1], o1, 0, 0, 0);
      o = __builtin_amdgcn_mfma_f32_32x32x16_bf16(qa[2], sb[2], o, 0, 0, 0);
      o1 = __builtin_amdgcn_mfma_f32_32x32x16_bf16(qa[3], sb[3], o1, 0, 0, 0);
      f32x16 o2;
#pragma unroll
      for (int i = 0; i < 16; ++i) o2[i] = 0.f;
#pragma unroll
      for (int i = 0; i < 8; ++i)
        opk[i] = pack2(o[2 * i] + o1[2 * i] + o2[2 * i], o[2 * i + 1] + o1[2 * i + 1] + o2[2 * i + 1]);
      otok = tok0;
    } else {
      const int kt0 = 2 * (wave - 2);
      bf16x8 ka[2][4], vb[4];
#pragma unroll
      for (int ks = 0; ks < 4; ++ks) {
        vb[ks] = *(const bf16x8*)(Vts + r * 144 + ks * 32 + hh * 16);
        ka[0][ks] = *(const bf16x8*)(KTs + (32 * kt0 + r) * 144 + ks * 32 + hh * 16);
        ka[1][ks] = *(const bf16x8*)(KTs + (32 * (kt0 + 1) + r) * 144 + ks * 32 + hh * 16);
      }
      __builtin_amdgcn_sched_barrier(0);
#pragma unroll
      for (int ks = 0; ks < 4; ++ks) {
        accS[0] = __builtin_amdgcn_mfma_f32_32x32x16_bf16(ka[0][ks], vb[ks], accS[0], 0, 0, 0);
        accS[1] = __builtin_amdgcn_mfma_f32_32x32x16_bf16(ka[1][ks], vb[ks], accS[1], 0, 0, 0);
      }
#pragma unroll
      for (int t = 0; t < 2; ++t)
#pragma unroll
        for (int i = 0; i < 16; ++i) accS[t][i] *= decs[32 * (kt0 + t) + (i & 3) + 8 * (i >> 2) + 4 * hh];
    }
    SCAN_BAR();
  }
  if (wave < 2) {
    u16* og = PHG + (otok + 32 * wave + 4 * hh) * 2560 + ocol + r;
#pragma unroll
    for (int i = 0; i < 8; ++i) {
      og[(size_t)(((2 * i) & 3) + 8 * ((2 * i) >> 2)) * 2560] = (u16)(opk[i] & 0xffffu);
      og[(size_t)(((2 * i + 1) & 3) + 8 * ((2 * i + 1) >> 2)) * 2560] = (u16)(opk[i] >> 16);
    }
  }
#undef SCAN_ISSUE
#undef SCAN_BAR
}

DEV float conv3_at(const u16* __restrict__ row, int t, int L, float w0, float w1, float w2, float bb) {
  const float um = (t > 0) ? bf2f(row[t - 1]) : 0.f;
  const float u0 = bf2f(row[t]);
  const float up = (t < L - 1) ? bf2f(row[t + 1]) : 0.f;
  return um * w0 + u0 * w1 + up * w2 + bb;
}

struct F8 { float v[8]; };
DEV F8 conv8(const u16* __restrict__ row, int t, int L, float w0, float w1, float w2, float bb) {
  const uint4 u = *(const uint4*)(row + t);
  const float um = (t > 0) ? bf2f(row[t - 1]) : 0.f;
  const float up = (t + 8 < L) ? bf2f(row[t + 8]) : 0.f;
  float x[10];
  x[0] = um;
  x[1] = bflo(u.x); x[2] = bfhi(u.x); x[3] = bflo(u.y); x[4] = bfhi(u.y);
  x[5] = bflo(u.z); x[6] = bfhi(u.z); x[7] = bflo(u.w); x[8] = bfhi(u.w);
  x[9] = up;
  F8 o;
#pragma unroll
  for (int j = 0; j < 8; ++j) o.v[j] = x[j] * w0 + x[j + 1] * w1 + x[j + 2] * w2 + bb;
  return o;
}

template <int BG>
DEV void hyena_item_mfma(const Params& p, int g, int item, char* smem, int half) {
  constexpr int NT = 256 / BG;
  constexpr int L = NT * 64;
  constexpr int VROW = 144;
  constexpr int RK1 = 4 * L + 64;
  constexpr int VBASE = 2 * (4 * L + 64);
  const int c = item >> 1, bgi = item & 1;
  char* Vl = smem + VBASE + half * (257 * VROW);
  u16* UHY = (u16*)(p.ws + OFF_UHY);
  const u16* RK = (const u16*)(p.ws + OFF_KK) + (g ? (size_t)512 * 8192 : 0) + (size_t)c * 2 * L;
  const float* cw = p.in[I_CONVW];
  const float* cb = p.in[I_CONVB];
  const int tid = tidx();
  __syncthreads();
  if (half == 0) {
#pragma unroll 8
    for (int e = tid; e < 2 * L / 8; e += 256) ((uint4*)smem)[e] = ((const uint4*)RK)[e];
  } else {
#pragma unroll 4
    for (int e = tid; e < 2 * L / 8; e += 256) {
      const uint4 v = ((const uint4*)RK)[e];
      const unsigned nx = (8 * e + 8 < 2 * L) ? (unsigned)RK[8 * e + 8] : 0u;
      uint4 o;
      o.x = (v.x >> 16) | (v.y << 16);
      o.y = (v.y >> 16) | (v.z << 16);
      o.z = (v.z >> 16) | (v.w << 16);
      o.w = (v.w >> 16) | (nx << 16);
      ((uint4*)(smem + RK1))[e] = o;
    }
  }
  {
    const float wx1_0 = cw[0 * 1536 + 512 + c], wx1_1 = cw[1 * 1536 + 512 + c], wx1_2 = cw[2 * 1536 + 512 + c], bx1 = cb[512 + c];
    const float wv_0 = cw[0 * 1536 + 1024 + c], wv_1 = cw[1 * 1536 + 1024 + c], wv_2 = cw[2 * 1536 + 1024 + c], bv = cb[1024 + c];
#pragma unroll 4
    for (int e = tid; e < BG * L / 8; e += 256) {
      const int bl = e / (L / 8), t = (e % (L / 8)) * 8;
      const int b = bgi * BG + bl;
      const F8 a = conv8(UHY + ((size_t)b * 1536 + 1024 + c) * L, t, L, wv_0, wv_1, wv_2, bv);
      const F8 x = conv8(UHY + ((size_t)b * 1536 + 512 + c) * L, t, L, wx1_0, wx1_1, wx1_2, bx1);
      *(uint4*)(Vl + ((t >> 6) * BG + bl) * VROW + (t & 63) * 2) =
          make_uint4(pack2(a.v[0] * x.v[0], a.v[1] * x.v[1]), pack2(a.v[2] * x.v[2], a.v[3] * x.v[3]),
                     pack2(a.v[4] * x.v[4], a.v[5] * x.v[5]), pack2(a.v[6] * x.v[6], a.v[7] * x.v[7]));
    }
  }
  if (tid < 9) *(uint4*)(Vl + 256 * VROW + tid * 16) = make_uint4(0u, 0u, 0u, 0u);
  __syncthreads();
  const int wave = tid >> 6, lane = tid & 63;
  const int n = lane & 31, hh = lane >> 5;
  Acc acc;
  acc_zero(acc);
  const int colw = wave * 64;
  {
    typedef __attribute__((ext_vector_type(2))) unsigned u32x2;
    typedef __attribute__((ext_vector_type(4))) unsigned u32x4;
    struct HySet {
      u32x2 wlo[6], whi[6];
      u32x4 bv[2][4];
      bool valid[2];
    };
    const int Tw0 = colw / BG;
    const int dlo = Tw0 - NT + 1, dhi = Tw0 + 64 / BG - 1;
    const int par = n & 1;
    const unsigned pkb = (unsigned)(size_t)smem + (par ? RK1 : 0) + 2u * (unsigned)(L - n + 8 * hh - 32 - par);
    const unsigned vlb = (unsigned)(size_t)Vl;
#define HY_PREP(Y_, dl_)                                              \
    const unsigned pabY_ = pkb - 128u * (unsigned)(dl_);               \
    unsigned pbY0_;                                                    \
    {                                                                  \
      const int col = colw + 0 + n;                                   \
      const int S = col / BG - (dl_);                                  \
      Y_.valid[0] = (unsigned)S < (unsigned)NT;                        \
      const int scol = Y_.valid[0] ? col - (dl_) * BG : 256;           \
      pbY0_ = vlb + (unsigned)(scol * VROW + hh * 16);                 \
    }                                                                  \
    unsigned pbY1_;                                                    \
    {                                                                  \
      const int col = colw + 32 + n;                                   \
      const int S = col / BG - (dl_);                                  \
      Y_.valid[1] = (unsigned)S < (unsigned)NT;                        \
      const int scol = Y_.valid[1] ? col - (dl_) * BG : 256;           \
      pbY1_ = vlb + (unsigned)(scol * VROW + hh * 16);                 \
    }                                                                  \

#define HY_ISSUE0(Y_, dl_)                                            \
    {                                                                  \
      HY_PREP(Y_, dl_)                                                 \
      asm volatile("ds_read2_b32 %0, %1 offset0:0 offset1:1" : "=v"(Y_.wlo[0]) : "v"(pabY_));  \
      asm volatile("ds_read2_b32 %0, %1 offset0:2 offset1:3" : "=v"(Y_.whi[0]) : "v"(pabY_));  \
      asm volatile("ds_read2_b32 %0, %1 offset0:8 offset1:9" : "=v"(Y_.wlo[1]) : "v"(pabY_));  \
      asm volatile("ds_read2_b32 %0, %1 offset0:10 offset1:11" : "=v"(Y_.whi[1]) : "v"(pabY_));  \
      asm volatile("ds_read2_b32 %0, %1 offset0:16 offset1:17" : "=v"(Y_.wlo[2]) : "v"(pabY_));  \
      asm volatile("ds_read2_b32 %0, %1 offset0:18 offset1:19" : "=v"(Y_.whi[2]) : "v"(pabY_));  \
      asm volatile("ds_read2_b32 %0, %1 offset0:24 offset1:25" : "=v"(Y_.wlo[3]) : "v"(pabY_));  \
      asm volatile("ds_read2_b32 %0, %1 offset0:26 offset1:27" : "=v"(Y_.whi[3]) : "v"(pabY_));  \
      asm volatile("ds_read2_b32 %0, %1 offset0:32 offset1:33" : "=v"(Y_.wlo[4]) : "v"(pabY_));  \
      asm volatile("ds_read2_b32 %0, %1 offset0:34 offset1:35" : "=v"(Y_.whi[4]) : "v"(pabY_));  \
      asm volatile("ds_read2_b32 %0, %1 offset0:40 offset1:41" : "=v"(Y_.wlo[5]) : "v"(pabY_));  \
      asm volatile("ds_read2_b32 %0, %1 offset0:42 offset1:43" : "=v"(Y_.whi[5]) : "v"(pabY_));  \
      asm volatile("ds_read_b128 %0, %1 offset:0" : "=v"(Y_.bv[0][0]) : "v"(pbY0_));  \
      asm volatile("ds_read_b128 %0, %1 offset:32" : "=v"(Y_.bv[0][1]) : "v"(pbY0_));  \
      asm volatile("ds_read_b128 %0, %1 offset:64" : "=v"(Y_.bv[0][2]) : "v"(pbY0_));  \
      asm volatile("ds_read_b128 %0, %1 offset:96" : "=v"(Y_.bv[0][3]) : "v"(pbY0_));  \
      asm volatile("ds_read_b128 %0, %1 offset:0" : "=v"(Y_.bv[1][0]) : "v"(pbY1_));  \
      asm volatile("ds_read_b128 %0, %1 offset:32" : "=v"(Y_.bv[1][1]) : "v"(pbY1_));  \
      asm volatile("ds_read_b128 %0, %1 offset:64" : "=v"(Y_.bv[1][2]) : "v"(pbY1_));  \
      asm volatile("ds_read_b128 %0, %1 offset:96" : "=v"(Y_.bv[1][3]) : "v"(pbY1_));  \
    }

#define HY_STEP(X_, Y_, dl_)                                          \
    {                                                                  \
      HY_PREP(Y_, dl_)                                                 \
      bf16x8 a[6];                                                     \
      _Pragma("unroll") for (int q = 0; q < 6; ++q) {                  \
        const u32x4 t = {X_.wlo[q][0], X_.wlo[q][1], X_.whi[q][0], X_.whi[q][1]}; \
        a[q] = __builtin_bit_cast(bf16x8, t);                          \
      }                                                                \
      {                                                                \
        u32x4 bq = X_.bv[0][0];                                        \
        const bf16x8 bb = __builtin_bit_cast(bf16x8, bq);              \
        __builtin_amdgcn_sched_barrier(0);                             \
        asm volatile("ds_read2_b32 %0, %1 offset0:0 offset1:1" : "=v"(Y_.wlo[0]) : "v"(pabY_));  \
        asm volatile("ds_read2_b32 %0, %1 offset0:2 offset1:3" : "=v"(Y_.whi[0]) : "v"(pabY_));  \
        __builtin_amdgcn_sched_barrier(0);                             \
        asm volatile("s_nop 1\n\tv_mfma_f32_32x32x16_bf16 %0, %1, %2, %0" : "+v"(acc[0][0]) : "v"(a[2]), "v"(bb)); \
        __builtin_amdgcn_sched_barrier(0);                             \
        asm volatile("ds_read2_b32 %0, %1 offset0:8 offset1:9" : "=v"(Y_.wlo[1]) : "v"(pabY_));  \
        asm volatile("ds_read2_b32 %0, %1 offset0:10 offset1:11" : "=v"(Y_.whi[1]) : "v"(pabY_));  \
        __builtin_amdgcn_sched_barrier(0);                             \
        asm volatile("s_nop 1\n\tv_mfma_f32_32x32x16_bf16 %0, %1, %2, %0" : "+v"(acc[0][1]) : "v"(a[0]), "v"(bb)); \
      }                                                                \
      {                                                                \
        u32x4 bq = X_.bv[0][1];                                        \
        const bf16x8 bb = __builtin_bit_cast(bf16x8, bq);              \
        __builtin_amdgcn_sched_barrier(0);                             \
        asm volatile("ds_read2_b32 %0, %1 offset0:16 offset1:17" : "=v"(Y_.wlo[2]) : "v"(pabY_));  \
        asm volatile("ds_read2_b32 %0, %1 offset0:18 offset1:19" : "=v"(Y_.whi[2]) : "v"(pabY_));  \
        __builtin_amdgcn_sched_barrier(0);                             \
        asm volatile("s_nop 1\n\tv_mfma_f32_32x32x16_bf16 %0, %1, %2, %0" : "+v"(acc[0][0]) : "v"(a[3]), "v"(bb)); \
        __builtin_amdgcn_sched_barrier(0);                             \
        asm volatile("ds_read2_b32 %0, %1 offset0:24 offset1:25" : "=v"(Y_.wlo[3]) : "v"(pabY_));  \
        asm volatile("ds_read2_b32 %0, %1 offset0:26 offset1:27" : "=v"(Y_.whi[3]) : "v"(pabY_));  \
        __builtin_amdgcn_sched_barrier(0);                             \
        asm volatile("s_nop 1\n\tv_mfma_f32_32x32x16_bf16 %0, %1, %2, %0" : "+v"(acc[0][1]) : "v"(a[1]), "v"(bb)); \
      }                                                                \
      {                                                                \
        u32x4 bq = X_.bv[0][2];                                        \
        const bf16x8 bb = __builtin_bit_cast(bf16x8, bq);              \
        __builtin_amdgcn_sched_barrier(0);                             \
        asm volatile("ds_read2_b32 %0, %1 offset0:32 offset1:33" : "=v"(Y_.wlo[4]) : "v"(pabY_));  \
        asm volatile("ds_read2_b32 %0, %1 offset0:34 offset1:35" : "=v"(Y_.whi[4]) : "v"(pabY_));  \
        __builtin_amdgcn_sched_barrier(0);                             \
        asm volatile("s_nop 1\n\tv_mfma_f32_32x32x16_bf16 %0, %1, %2, %0" : "+v"(acc[0][0]) : "v"(a[4]), "v"(bb)); \
        __builtin_amdgcn_sched_barrier(0);                             \
        asm volatile("ds_read2_b32 %0, %1 offset0:40 offset1:41" : "=v"(Y_.wlo[5]) : "v"(pabY_));  \
        asm volatile("ds_read2_b32 %0, %1 offset0:42 offset1:43" : "=v"(Y_.whi[5]) : "v"(pabY_));  \
        __builtin_amdgcn_sched_barrier(0);                             \
        asm volatile("s_nop 1\n\tv_mfma_f32_32x32x16_bf16 %0, %1, %2, %0" : "+v"(acc[0][1]) : "v"(a[2]), "v"(bb)); \
      }                                                                \
      {                                                                \
        u32x4 bq = X_.bv[0][3];                                        \
        const bf16x8 bb = __builtin_bit_cast(bf16x8, bq);              \
        __builtin_amdgcn_sched_barrier(0);                             \
        asm volatile("ds_read_b128 %0, %1 offset:0" : "=v"(Y_.bv[0][0]) : "v"(pbY0_));  \
        asm volatile("ds_read_b128 %0, %1 offset:32" : "=v"(Y_.bv[0][1]) : "v"(pbY0_));  \
        __builtin_amdgcn_sched_barrier(0);                             \
        asm volatile("s_nop 1\n\tv_mfma_f32_32x32x16_bf16 %0, %1, %2, %0" : "+v"(acc[0][0]) : "v"(a[5]), "v"(bb)); \
        __builtin_amdgcn_sched_barrier(0);                             \
        asm volatile("ds_read_b128 %0, %1 offset:64" : "=v"(Y_.bv[0][2]) : "v"(pbY0_));  \
        asm volatile("ds_read_b128 %0, %1 offset:96" : "=v"(Y_.bv[0][3]) : "v"(pbY0_));  \
        __builtin_amdgcn_sched_barrier(0);                             \
        asm volatile("s_nop 1\n\tv_mfma_f32_32x32x16_bf16 %0, %1, %2, %0" : "+v"(acc[0][1]) : "v"(a[3]), "v"(bb)); \
      }                                                                \
      {                                                                \
        u32x4 bq = X_.bv[1][0];                                        \
        const bf16x8 bb = __builtin_bit_cast(bf16x8, bq);              \
        __builtin_amdgcn_sched_barrier(0);                             \
        asm volatile("ds_read_b128 %0, %1 offset:0" : "=v"(Y_.bv[1][0]) : "v"(pbY1_));  \
        asm volatile("ds_read_b128 %0, %1 offset:32" : "=v"(Y_.bv[1][1]) : "v"(pbY1_));  \
        __builtin_amdgcn_sched_barrier(0);                             \
        asm volatile("s_nop 1\n\tv_mfma_f32_32x32x16_bf16 %0, %1, %2, %0" : "+v"(acc[1][0]) : "v"(a[2]), "v"(bb)); \
        __builtin_amdgcn_sched_barrier(0);                             \
        asm volatile("ds_read_b128 %0, %1 offset:64" : "=v"(Y_.bv[1][2]) : "v"(pbY1_));  \
        asm volatile("ds_read_b128 %0, %1 offset:96" : "=v"(Y_.bv[1][3]) : "v"(pbY1_));  \
        __builtin_amdgcn_sched_barrier(0);                             \
        asm volatile("s_nop 1\n\tv_mfma_f32_32x32x16_bf16 %0, %1, %2, %0" : "+v"(acc[1][1]) : "v"(a[0]), "v"(bb)); \
      }                                                                \
      {                                                                \
        u32x4 bq = X_.bv[1][1];                                        \
        const bf16x8 bb = __builtin_bit_cast(bf16x8, bq);              \
        __builtin_amdgcn_sched_barrier(0);                             \
        __builtin_amdgcn_sched_barrier(0);                             \
        asm volatile("s_nop 1\n\tv_mfma_f32_32x32x16_bf16 %0, %1, %2, %0" : "+v"(acc[1][0]) : "v"(a[3]), "v"(bb)); \
        __builtin_amdgcn_sched_barrier(0);                             \
        __builtin_amdgcn_sched_barrier(0);                             \
        asm volatile("s_nop 1\n\tv_mfma_f32_32x32x16_bf16 %0, %1, %2, %0" : "+v"(acc[1][1]) : "v"(a[1]), "v"(bb)); \
      }                                                                \
      {                                                                \
        u32x4 bq = X_.bv[1][2];                                        \
        const bf16x8 bb = __builtin_bit_cast(bf16x8, bq);              \
        __builtin_amdgcn_sched_barrier(0);                             \
        __builtin_amdgcn_sched_barrier(0);                             \
        asm volatile("s_nop 1\n\tv_mfma_f32_32x32x16_bf16 %0, %1, %2, %0" : "+v"(acc[1][0]) : "v"(a[4]), "v"(bb)); \
        __builtin_amdgcn_sched_barrier(0);                             \
        __builtin_amdgcn_sched_barrier(0);                             \
        asm volatile("s_nop 1\n\tv_mfma_f32_32x32x16_bf16 %0, %1, %2, %0" : "+v"(acc[1][1]) : "v"(a[2]), "v"(bb)); \
      }                                                                \
      {                                                                \
        u32x4 bq = X_.bv[1][3];                                        \
        const bf16x8 bb = __builtin_bit_cast(bf16x8, bq);              \
        __builtin_amdgcn_sched_barrier(0);                             \
        __builtin_amdgcn_sched_barrier(0);                             \
        asm volatile("s_nop 1\n\tv_mfma_f32_32x32x16_bf16 %0, %1, %2, %0" : "+v"(acc[1][0]) : "v"(a[5]), "v"(bb)); \
        __builtin_amdgcn_sched_barrier(0);                             \
        __builtin_amdgcn_sched_barrier(0);                             \
        asm volatile("s_nop 1\n\tv_mfma_f32_32x32x16_bf16 %0, %1, %2, %0" : "+v"(acc[1][1]) : "v"(a[3]), "v"(bb)); \
      }                                                                \
    }

#define HY_COMPUTE(X_)                                                \
    {                                                                  \
      bf16x8 a[6];                                                     \
      _Pragma("unroll") for (int q = 0; q < 6; ++q) {                  \
        const u32x4 t = {X_.wlo[q][0], X_.wlo[q][1], X_.whi[q][0], X_.whi[q][1]}; \
        a[q] = __builtin_bit_cast(bf16x8, t);                          \
      }                                                                \
      _Pragma("unroll") for (int nt = 0; nt < 2; ++nt) {               \
        _Pragma("unroll") for (int ks = 0; ks < 4; ++ks) {             \
          u32x4 bq = X_.bv[nt][ks];                                    \
          const bf16x8 bb = __builtin_bit_cast(bf16x8, bq);            \
          acc[nt][0] = __builtin_amdgcn_mfma_f32_32x32x16_bf16(a[ks + 2], bb, acc[nt][0], 0, 0, 0); \
          acc[nt][1] = __builtin_amdgcn_mfma_f32_32x32x16_bf16(a[ks], bb, acc[nt][1], 0, 0, 0);     \
        }                                                              \
      }                                                                \
    }
#define HY_WAIT(S_) asm volatile("s_waitcnt lgkmcnt(0)" : "+v"(S_.wlo[0]), "+v"(S_.whi[0]), "+v"(S_.wlo[1]), "+v"(S_.whi[1]), "+v"(S_.wlo[2]), "+v"(S_.whi[2]), "+v"(S_.wlo[3]), "+v"(S_.whi[3]), "+v"(S_.wlo[4]), "+v"(S_.whi[4]), "+v"(S_.wlo[5]), "+v"(S_.whi[5]), "+v"(S_.bv[0][0]), "+v"(S_.bv[0][1]), "+v"(S_.bv[0][2]), "+v"(S_.bv[0][3]), "+v"(S_.bv[1][0]), "+v"(S_.bv[1][1]), "+v"(S_.bv[1][2]), "+v"(S_.bv[1][3]) :: "memory")
    HySet s0, s1;
    HY_ISSUE0(s0, dlo);
    int dl = dlo;
    for (; dl + 1 <= dhi; dl += 2) {
      HY_WAIT(s0);
      HY_STEP(s0, s1, dl + 1);
      __builtin_amdgcn_sched_barrier(0);
      HY_WAIT(s1);
      {
        const int d2 = (dl + 2 <= dhi) ? dl + 2 : dhi;
        HY_STEP(s1, s0, d2);
      }
      __builtin_amdgcn_sched_barrier(0);
    }
    if (dl == dhi) {
      HY_WAIT(s0);
      HY_COMPUTE(s0);
    }
    asm volatile("s_waitcnt lgkmcnt(0)" ::: "memory");
#undef HY_PREP
#undef HY_ISSUE0
#undef HY_STEP
#undef HY_COMPUTE
#undef HY_WAIT
  }
  __syncthreads();
  {
    const float fbias = p.in[I_FBIAS][c];
#pragma unroll
    for (int nt = 0; nt < 2; ++nt)
#pragma unroll
      for (int mi = 0; mi < 2; ++mi)
#pragma unroll
        for (int rg = 0; rg < 4; ++rg) {
          const int col = colw + 32 * nt + n, i0 = 32 * mi + 8 * rg + 4 * hh;
          char* pv = Vl + col * VROW + i0 * 2;
          const uint2 w = *(const uint2*)pv;
          const float t0 = acc[nt][mi][4 * rg + 0] + bflo(w.x) * fbias;
          const float t1 = acc[nt][mi][4 * rg + 1] + bfhi(w.x) * fbias;
          const float t2 = acc[nt][mi][4 * rg + 2] + bflo(w.y) * fbias;
          const float t3 = acc[nt][mi][4 * rg + 3] + bfhi(w.y) * fbias;
          *(uint2*)pv = make_uint2(pack2(t0, t1), pack2(t2, t3));
        }
  }
  __syncthreads();
  {
    const float wx0_0 = cw[0 * 1536 + c], wx0_1 = cw[1 * 1536 + c], wx0_2 = cw[2 * 1536 + c], bx0 = cb[c];
    for (int e0 = tid; e0 < BG * L / 8; e0 += 256 * 4) {
      F8 x[4];
      uint4 y[4];
#pragma unroll
      for (int u = 0; u < 4; ++u) {
        const int e = e0 + 256 * u;
        const int bl = e / (L / 8), t = (e % (L / 8)) * 8;
        const int b = bgi * BG + bl;
        x[u] = conv8(UHY + ((size_t)b * 1536 + c) * L, t, L, wx0_0, wx0_1, wx0_2, bx0);
        y[u] = *(const uint4*)(Vl + ((t >> 6) * BG + bl) * VROW + (t & 63) * 2);
      }
#pragma unroll
      for (int u = 0; u < 4; ++u) {
        const int e = e0 + 256 * u;
        const int bl = e / (L / 8), t = (e % (L / 8)) * 8;
        const int b = bgi * BG + bl;
        *(uint4*)(UHY + ((size_t)b * 1536 + 1024 + c) * L + t) =
            make_uint4(pack2(bflo(y[u].x) * x[u].v[0], bfhi(y[u].x) * x[u].v[1]), pack2(bflo(y[u].y) * x[u].v[2], bfhi(y[u].y) * x[u].v[3]),
                       pack2(bflo(y[u].z) * x[u].v[4], bfhi(y[u].z) * x[u].v[5]), pack2(bflo(y[u].w) * x[u].v[6], bfhi(y[u].w) * x[u].v[7]));
      }
    }
  }
}

DEV void phase_p2_naive(const Params& p, int g, char* hsm) {
  __shared__ int s_item;
  const int nscan = g ? 128 : 256;
  const int nhy = 1024;
  unsigned* cnt = (unsigned*)(p.ws + OFF_CNT) + g;
  const int half = vhalf();
  if ((int)blockIdx.x * 2 < nscan) scan_item_mfma(p, g, blockIdx.x * 2 + half, hsm);
  for (;;) {
    __syncthreads();
    if (threadIdx.x == 0) s_item = (int)atomicAdd(cnt, 2u);
    __syncthreads();
    const int it = s_item + half;
    if (it >= nhy) break;
    if (g == 0) hyena_item_mfma<4>(p, g, it, hsm - half * HALF_BYTES, half);
    else hyena_item_mfma<2>(p, g, it, hsm - half * HALF_BYTES, half);
  }
  unsigned* cnt2 = (unsigned*)(p.ws + OFF_CNT) + 2 + g;
  const float* mod = (const float*)(p.ws + OFF_MOD);
  for (;;) {
    __syncthreads();
    if (threadIdx.x == 0) s_item = (int)atomicAdd(cnt2, 2u);
    __syncthreads();
    const int it = s_item + half;
    if (it >= 512) break;
    if (g == 0) norm_adaln_rows(p.in[I_XS], p.in[I_N1G], mod, 8, 8192, 0, 1024, (u16*)(p.out + (size_t)NTOK * D), it * 64);
    else final_norm_rows(p.out, p.in[I_FING], it * 64);
  }
}

DEV void phase_p2c(const Params& p, int g) {
  u16* PHG = (u16*)(p.ws + OFF_PHG);
  const float* gn = p.in[I_GNG];
  const int tid = tidx();
  const int wave = tid >> 6, lane = tid & 63;
  constexpr int RB = 4;
  const int stride = NVB * 4;
  const int c = lane * 8;
  for (int tok0 = VBID * 4 + wave; tok0 < NTOK; tok0 += stride * RB) {
    uint4 a[RB], bq[RB], og[RB];
#pragma unroll
    for (int j = 0; j < RB; ++j) {
      const int t_ = tok0 + j * stride;
      const size_t tok = (size_t)(t_ < NTOK ? t_ : tok0);
      a[j] = *(const uint4*)(PHG + tok * 2560 + c);
      bq[j] = *(const uint4*)(PHG + tok * 2560 + 1024 + c);
      og[j] = *(const uint4*)(PHG + tok * 2560 + 2048 + c);
    }
    const float4 g0 = *(const float4*)(gn + c), g1 = *(const float4*)(gn + c + 4);
#pragma unroll
    for (int j = 0; j < RB; ++j) {
      const int t_ = tok0 + j * stride;
      float o[8];
      o[0] = bflo(a[j].x) + bflo(bq[j].x); o[1] = bfhi(a[j].x) + bfhi(bq[j].x);
      o[2] = bflo(a[j].y) + bflo(bq[j].y); o[3] = bfhi(a[j].y) + bfhi(bq[j].y);
      o[4] = bflo(a[j].z) + bflo(bq[j].z); o[5] = bfhi(a[j].z) + bfhi(bq[j].z);
      o[6] = bflo(a[j].w) + bflo(bq[j].w); o[7] = bfhi(a[j].w) + bfhi(bq[j].w);
      float ss = 0.f;
#pragma unroll
      for (int i = 0; i < 8; ++i) ss += o[i] * o[i];
      ss += __shfl_xor(ss, 1);
      ss += __shfl_xor(ss, 2);
      ss += __shfl_xor(ss, 4);
      ss += __shfl_xor(ss, 8);
      const float rstd = rsqrtf(ss * (1.f / 128.f) + EPSF);
      const float y0 = o[0] * rstd * g0.x * bflo(og[j].x), y1 = o[1] * rstd * g0.y * bfhi(og[j].x);
      const float y2 = o[2] * rstd * g0.z * bflo(og[j].y), y3 = o[3] * rstd * g0.w * bfhi(og[j].y);
      const float y4 = o[4] * rstd * g1.x * bflo(og[j].z), y5 = o[5] * rstd * g1.y * bfhi(og[j].z);
      const float y6 = o[6] * rstd * g1.z * bflo(og[j].w), y7 = o[7] * rstd * g1.w * bfhi(og[j].w);
      if (t_ < NTOK)
        *(uint4*)(PHG + (size_t)t_ * 2560 + c) = make_uint4(pack2(y0, y1), pack2(y2, y3), pack2(y4, y5), pack2(y6, y7));
    }
  }
}

DEV void tile_order(int tile, int ntn, int& mt, int& nt) {
  const int grp = tile / (16 * ntn), rem = tile % (16 * ntn);
  mt = grp * 16 + (rem & 15);
  nt = rem >> 4;
}

DEV void phase_p3a(const Params& p, int g, char* smem) {
  const int L = g ? 8192 : 4096;
  u16* PHG = (u16*)(p.ws + OFF_PHG);
  const u16* GT = (const u16*)(p.ws + OFF_GT);
  const u16* UHY = (const u16*)(p.ws + OFF_UHY);
  const u16* WbrT = (const u16*)(p.ws + OFF_WBR);
  for (int iter = 0;; ++iter) {
    int mt, nt;
    if (!tile_map(iter, 128, 4, mt, nt)) break;
    const int m0 = mt * 256, n0 = nt * 256;
    Acc acc;
    acc_zero(acc);
    {
      TransLoader al{UHY, L};
      RowLoader bl{WbrT, 1024};
      gemm_mainloop(acc, al, bl, m0, n0, 0, 512, smem);
    }
    acc_foreach(acc, m0, n0, [&](int m, int n, float& v) {
      const float ga = bf2f(GT[(size_t)m * 2048 + n]);
      const float gb = bf2f(GT[(size_t)m * 2048 + 1024 + n]);
      v *= ga * __builtin_amdgcn_rcpf(fmaxf(gb, 1e-30f));
    });
    {
      RowLoader al{PHG - 512, 2560};
      RowLoader bl{WbrT, 1024};
      gemm_mainloop(acc, al, bl, m0, n0, 512, 1024, smem);
    }
    acc_foreach(acc, m0, n0, [&](int m, int n, float& v) {
      const float gb = bf2f(GT[(size_t)m * 2048 + 1024 + n]);
      PHG[(size_t)m * 2560 + 1024 + n] = f2bf(gb * v);
    });
  }
}

DEV void phase_p3b(const Params& p, int g, char* smem) {
  const int L = g ? 8192 : 4096;
  const int bg0 = g ? 8 : 0;
  const u16* PHG = (const u16*)(p.ws + OFF_PHG);
  const u16* WoutT = (const u16*)(p.ws + OFF_WOUT);
  const float* X = p.in[g ? I_XS : I_XP];
  const float* mod = (const float*)(p.ws + OFF_MOD);
  float* X1 = p.out + (size_t)g * NTOK * D;
  for (int iter = 0;; ++iter) {
    int mt, nt;
    if (!tile_map(iter, 128, 4, mt, nt)) break;
    const int m0 = mt * 256, n0 = nt * 256;
    Acc acc;
    acc_zero(acc);
    RowLoader al{PHG + 1024, 2560}, bl{WoutT, 1024};
    gemm_mainloop(acc, al, bl, m0, n0, 0, 1024, smem);
    const float* gt = mod + (size_t)(bg0 + m0 / L) * DIN + 2048;
    acc_foreach(acc, m0, n0, [&](int m, int n, float& v) {
      X1[(size_t)m * D + n] = X[(size_t)m * D + n] + gt[n] * v;
    });
  }
}

DEV void phase_ff1(const Params& p, int g, char* smem) {
  const u16* H2 = (const u16*)(p.ws + OFF_H2);
  const u16* W = (const u16*)(p.ws + OFF_WFF1);
  u16* AB = (u16*)(p.ws + OFF_ABUF);
  GemmPipe gp;
  gp.primed = false;
  for (int iter = 0;; ++iter) {
    int mt, nt, mtn, ntn;
    if (!tile_map(iter, 128, 16, mt, nt)) break;
    const bool more = tile_map(iter + 1, 128, 16, mtn, ntn);
    if (!more) { mtn = mt; ntn = nt; }
    const int m0 = mt * 256, n0 = nt * 256;
    Acc acc;
    acc_zero(acc);
    RowLoader al{H2, 1024}, bl{W, 1024};
    gemm_mainloop_p(acc, al, bl, m0, n0, mtn * 256, ntn * 256, 1024, smem, gp);
    gp.primed = more;
    acc_foreach(acc, m0, n0, [&](int m, int n, float& v) {
      const float r = fmaxf(v, 0.f);
      AB[(size_t)m * 4096 + n] = f2bf(r * r);
    });
  }
}

DEV void phase_ff2(const Params& p, int g, char* smem) {
  const int L = g ? 8192 : 4096;
  const int bg0 = g ? 8 : 0;
  const u16* AB = (const u16*)(p.ws + OFF_ABUF);
  const u16* W = (const u16*)(p.ws + OFF_WFF2);
  const float* mod = (const float*)(p.ws + OFF_MOD);
  float* X1 = p.out + (size_t)g * NTOK * D;
  for (int iter = 0;; ++iter) {
    int mt, nt;
    if (!tile_map(iter, 128, 4, mt, nt)) break;
    const int m0 = mt * 256, n0 = nt * 256;
    Acc acc;
    acc_zero(acc);
    RowLoader al{AB, 4096}, bl{W, 4096};
    gemm_mainloop(acc, al, bl, m0, n0, 0, 4096, smem);
    const float* gt = mod + (size_t)(bg0 + m0 / L) * DIN + 5120;
    acc_foreach(acc, m0, n0, [&](int m, int n, float& v) { X1[(size_t)m * D + n] += gt[n] * v; });
  }
}

__global__ void __launch_bounds__(512) mk(Params p) {
  cg::grid_group grid = cg::this_grid();
  __shared__ __attribute__((aligned(16))) char smem[SMEM_BYTES];
  __shared__ uint4 xb_words;
  if (threadIdx.x == 0) xb_words = make_uint4(0u, 0u, 0u, 0u);
  __syncthreads();
  const XcdBarrier xb = xcd_barrier_post((unsigned*)(p.ws + OFF_XBAR), (volatile LAS unsigned*)&xb_words);
  char* hsm = smem + vhalf() * HALF_BYTES;
  const float* mod = (const float*)(p.ws + OFF_MOD);
  phase_prep(p, hsm);
  phase_filter_mlp(p, hsm);
  xcd_barrier(xb);
  if (p.out == nullptr) grid.sync();
  phase_filter_norm(p, hsm);
  phase_norm_adaln(p.in[I_XP], p.in[I_N1G], mod, 0, 4096, 0, 1024, (u16*)p.out);
  xcd_barrier(xb);
#pragma unroll 1
  for (int gi = 0; gi < 2; ++gi) {
    int g = gi;
    asm volatile("" : "+s"(g));
    const int L = g ? 8192 : 4096;
    const int bg0 = g ? 8 : 0;
    float* OG = p.out + (size_t)g * NTOK * D;
    phase_p1(p, g, smem);
    xcd_barrier(xb);
    phase_p15(p, g);
    xcd_barrier(xb);
    phase_p2_naive(p, g, hsm);
    xcd_barrier(xb);
    phase_p2c(p, g);
    xcd_barrier(xb);
    phase_p3a(p, g, smem);
    xcd_barrier(xb);
    phase_p3b(p, g, smem);
    xcd_barrier(xb);
    phase_norm_adaln(OG, p.in[I_N2G], mod, bg0, L, 3072, 4096, (u16*)(p.ws + OFF_H2));
    xcd_barrier(xb);
    phase_ff1(p, g, smem);
    xcd_barrier(xb);
    phase_ff2(p, g, smem);
    xcd_barrier(xb);
  }
  phase_final_norm(p.out + (size_t)NTOK * D, p.in[I_FING]);
}

extern "C" void kernel_launch(void* const* d_in, const int* in_sizes, int n_in, void* d_out, int out_size,
                              void* d_ws, size_t ws_size, hipStream_t stream) {
  static int grid_blocks = 0;
  if (!grid_blocks) {
    int dev = 0, cus = 0, per_cu = 0;
    (void)hipGetDevice(&dev);
    (void)hipDeviceGetAttribute(&cus, hipDeviceAttributeMultiprocessorCount, dev);
    (void)hipOccupancyMaxActiveBlocksPerMultiprocessor(&per_cu, mk, 512, 0);
    if (per_cu > 1) per_cu = 1;
    if (per_cu < 1) per_cu = 1;
    grid_blocks = cus * per_cu;
  }
  if (ws_size < WS_NEED) fprintf(stderr, "workspace too small: %zu < %zu\n", ws_size, (size_t)WS_NEED);
  Params p{};
  for (int i = 0; i < 27; ++i) p.in[i] = (const float*)d_in[i];
  p.out = (float*)d_out;
  p.ws = (char*)d_ws;
  (void)hipMemsetAsync((char*)d_ws + OFF_XBAR, 0, 16384, stream);
  void* args[] = {&p};
  hipError_t e = hipLaunchCooperativeKernel((void*)mk, dim3(grid_blocks), dim3(512), args, 0, stream);
  if (e != hipSuccess) fprintf(stderr, "coop launch failed: %s (grid %d)\n", hipGetErrorString(e), grid_blocks);
}
```
